# Optimizing an MI355X kernel written in HIP

```python
import math
import jax
import jax.numpy as jnp
from jax import lax
import numpy as np

D_MODEL = 1024
BATCH = 16
SEQ = 2048
DEPTH = 4

MEM_LEN = 256
N_EVEN = (DEPTH + 1) // 2
N_ODD = DEPTH // 2
EPS = 1e-6

CONV_CH = D_MODEL // 2
CONV_TAPS = 3
RET_HEADS = 8
RET_DK = D_MODEL // 16
RET_DV = D_MODEL // 16
RET_QK = RET_HEADS * RET_DK
RET_V = RET_HEADS * RET_DV
RET_CHUNK = 128
RET_THETA = 10000.0
RET_MAX_RATE = 1.0 / 32.0
RET_MIN_RATE = 1.0 / 512.0
EVEN_SPLITS = (CONV_CH, CONV_CH, CONV_CH, RET_QK, RET_QK, RET_V, RET_V)
EVEN_IN = sum(EVEN_SPLITS)
EVEN_OUT = CONV_CH + RET_V
DIFF_HEADS = 8
DIFF_D = D_MODEL // 16
DIFF_QK = 2 * DIFF_HEADS * DIFF_D
DIFF_V = DIFF_HEADS * 2 * DIFF_D
ODD_SPLITS = (DIFF_QK, DIFF_QK, DIFF_V)
ODD_IN = sum(ODD_SPLITS)
ROPE_DIM = DIFF_D // 4
ROPE_THETA = 500000.0
Q_BLOCK = 128
XA_HEADS = 4
XA_HD = D_MODEL // XA_HEADS
D_FF = 2816
N_EXPERTS = 8
TOP_K = 2
D_FF_EXPERT = 3584

kernel_name = "hybrid_conv_retention_diffattn_moe_encoder"


def rms_norm(x, g):
    x32 = x.astype(jnp.float32)
    y = x32 * lax.rsqrt(jnp.mean(x32 * x32, axis=-1, keepdims=True) + EPS)
    return (y * g.astype(jnp.float32)).astype(x.dtype)


def group_rms_norm(x, g):
    H, d = x.shape[1], x.shape[3]
    x32 = x.astype(jnp.float32)
    y = x32 * lax.rsqrt(jnp.mean(x32 * x32, axis=-1, keepdims=True) + EPS)
    return y * g.astype(jnp.float32).reshape(1, H, 1, d)


def split_cols(x, sizes):
    out, start = [], 0
    for s in sizes:
        out.append(x[..., start:start + s])
        start += s
    return out


def rotary(x, positions, rot_dim, theta):
    half = rot_dim // 2
    inv_freq = jnp.exp(-math.log(theta) * jnp.arange(half, dtype=jnp.float32) * (2.0 / rot_dim))
    ang = positions.astype(jnp.float32)[:, None, :, None] * inv_freq
    cos, sin = jnp.cos(ang), jnp.sin(ang)
    x32 = x.astype(jnp.float32)
    x1, x2 = x32[..., :half], x32[..., half:rot_dim]
    out = jnp.concatenate([x1 * cos - x2 * sin, x1 * sin + x2 * cos, x32[..., rot_dim:]], axis=-1)
    return out.astype(x.dtype)


def short_conv_mixer(h, gate_b, gate_c, conv_w):
    u = gate_c * h
    L = u.shape[1]
    up = jnp.pad(u, ((0, 0), (1, 1), (0, 0)))
    conv = conv_w[0] * up[:, :L] + conv_w[1] * up[:, 1:L + 1] + conv_w[2] * up[:, 2:]
    return gate_b * conv


def retention_direction(q, k, v, log_gamma, strict):
    B, H, L, dk = q.shape
    dv = v.shape[-1]
    C = RET_CHUNK
    NC = L // C
    qc = q.astype(jnp.float32).reshape(B, H, NC, C, dk)
    kc = k.astype(jnp.float32).reshape(B, H, NC, C, dk)
    vc = v.astype(jnp.float32).reshape(B, H, NC, C, dv)
    idx = jnp.arange(C, dtype=jnp.float32)
    lg = log_gamma[:, None]
    dist = idx[:, None] - idx[None, :]
    mask = dist > 0 if strict else dist >= 0
    decay = jnp.where(mask, jnp.exp(lg[:, :, None] * jnp.where(mask, dist, 0.0)), 0.0)
    scores = jnp.einsum('bhnid,bhnjd->bhnij', qc, kc) * decay[None, :, None]
    intra = jnp.einsum('bhnij,bhnjv->bhniv', scores, vc)
    k_dec = jnp.exp(lg * (C - 1.0 - idx))
    kv = jnp.einsum('bhnjd,hj,bhnjv->nbhdv', kc, k_dec, vc)
    chunk_decay = jnp.exp(lg * C)[:, :, None]

    def step(state, kv_n):
        return chunk_decay * state + kv_n, state

    _, prev = lax.scan(step, jnp.zeros((B, H, dk, dv), jnp.float32), kv)
    q_dec = jnp.exp(lg * (idx + 1.0))
    inter = jnp.einsum('bhnid,hi,nbhdv->bhniv', qc, q_dec, prev)
    return (intra + inter).reshape(B, H, L, dv)


def bidirectional_retention(q, k, v, p_fwd, p_bwd):
    lg_f = -jnp.exp(p_fwd.astype(jnp.float32))
    lg_b = -jnp.exp(p_bwd.astype(jnp.float32))
    fwd = retention_direction(q, k, v, lg_f, False)
    bwd = retention_direction(jnp.flip(q, 2), jnp.flip(k, 2), jnp.flip(v, 2), lg_b, True)
    return fwd + jnp.flip(bwd, 2)


def even_token_mixer(h, positions, w_in, conv_w, p_fwd, p_bwd, gn_g, w_out):
    B, L, _ = h.shape
    gb, gc, hc, q, k, v, g = split_cols(h @ w_in, EVEN_SPLITS)
    a = short_conv_mixer(hc, gb, gc, conv_w)

    def to_heads(t, d):
        return t.reshape(B, L, RET_HEADS, d).transpose(0, 2, 1, 3)

    q = rotary(to_heads(q, RET_DK), positions, RET_DK, RET_THETA)
    k = rotary(to_heads(k, RET_DK), positions, RET_DK, RET_THETA) * (RET_DK ** -0.5)
    o = bidirectional_retention(q, k, to_heads(v, RET_DV), p_fwd, p_bwd)
    o = group_rms_norm(o, gn_g).transpose(0, 2, 1, 3).reshape(B, L, RET_V)
    r = (jax.nn.silu(g.astype(jnp.float32)) * o).astype(h.dtype)
    return jnp.concatenate([a, r], axis=-1) @ w_out


def diff_attention_mixer(h, positions, w_in, lam_q1, lam_k1, lam_q2, lam_k2, gn_g, w_out, lambda_init):
    B, L, _ = h.shape
    q, k, v = split_cols(h @ w_in, ODD_SPLITS)
    q = rotary(q.reshape(B, L, 2 * DIFF_HEADS, DIFF_D).transpose(0, 2, 1, 3), positions, ROPE_DIM, ROPE_THETA)
    k = rotary(k.reshape(B, L, 2 * DIFF_HEADS, DIFF_D).transpose(0, 2, 1, 3), positions, ROPE_DIM, ROPE_THETA)
    v = v.reshape(B, L, DIFF_HEADS, 2 * DIFF_D).transpose(0, 2, 1, 3).astype(jnp.float32)
    f32 = jnp.float32
    lam = (jnp.exp(jnp.sum(lam_q1.astype(f32) * lam_k1.astype(f32)))
           - jnp.exp(jnp.sum(lam_q2.astype(f32) * lam_k2.astype(f32))) + lambda_init)
    nb = L // Q_BLOCK
    q_blocks = q.reshape(B, 2 * DIFF_HEADS, nb, Q_BLOCK, DIFF_D).transpose(2, 0, 1, 3, 4)
    scale = DIFF_D ** -0.5

    def attend(qb):
        s = jnp.einsum('bgqd,bgkd->bgqk', qb, k).astype(f32) * scale
        p = jax.nn.softmax(s, axis=-1).reshape(B, DIFF_HEADS, 2, Q_BLOCK, L)
        return jnp.einsum('bhqk,bhkv->bhqv', p[:, :, 0] - lam * p[:, :, 1], v)

    o = lax.map(attend, q_blocks)
    o = o.transpose(1, 2, 0, 3, 4).reshape(B, DIFF_HEADS, L, 2 * DIFF_D)
    o = group_rms_norm(o, gn_g) * (1.0 - lambda_init)
    o = o.transpose(0, 2, 1, 3).reshape(B, L, DIFF_V).astype(h.dtype)
    return o @ w_out


def memory_cross_attention(h, mem_n, wq, wkv, wo):
    B, L, D = h.shape
    M = mem_n.shape[1]
    q = (h @ wq).reshape(B, L, XA_HEADS, XA_HD)
    k, v = split_cols(mem_n @ wkv, (D, D))
    k = k.reshape(B, M, XA_HEADS, XA_HD)
    v = v.reshape(B, M, XA_HEADS, XA_HD).astype(jnp.float32)
    s = jnp.einsum('blhd,bmhd->bhlm', q, k).astype(jnp.float32) * (XA_HD ** -0.5)
    p = jax.nn.softmax(s, axis=-1)
    o = jnp.einsum('bhlm,bmhd->blhd', p, v).reshape(B, L, D).astype(h.dtype)
    return o @ wo


def swiglu(h, w_gate, w_up, w_down):
    return (jax.nn.silu(h @ w_gate) * (h @ w_up)) @ w_down


def moe_swiglu(h, router_w, w_gate, w_up, w_down):
    B, L, D = h.shape
    t = h.reshape(B * L, D)
    logits = (t @ router_w).astype(jnp.float32)
    top_v, top_i = lax.top_k(logits, TOP_K)
    top_w = jax.nn.softmax(top_v, axis=-1)
    gates = jnp.sum(jax.nn.one_hot(top_i, N_EXPERTS, dtype=jnp.float32) * top_w[..., None], axis=1)
    out = jnp.zeros((B * L, D), jnp.float32)
    for e in range(N_EXPERTS):
        out = out + gates[:, e:e + 1] * swiglu(t, w_gate[e], w_up[e], w_down[e])
    return out.astype(h.dtype).reshape(B, L, D)


def setup_inputs(seed: int = 0) -> dict:
    key = jax.random.key(seed)
    ks = iter(jax.random.split(key, 48))
    f32 = jnp.float32

    def nrm(shape, fan_in):
        return jax.random.normal(next(ks), shape, f32) * (fan_in ** -0.5)

    def gain(shape):
        return 1.0 + 0.01 * jax.random.normal(next(ks), shape, f32)

    x = jax.random.normal(next(ks), (BATCH, SEQ, D_MODEL), f32)
    mem = jax.random.normal(next(ks), (BATCH, MEM_LEN, D_MODEL), f32)
    offsets = jax.random.randint(next(ks), (BATCH, 1), 0, SEQ, dtype=jnp.int32)
    positions = offsets + jnp.arange(SEQ, dtype=jnp.int32)[None, :]
    rates = jnp.exp(jnp.linspace(math.log(RET_MAX_RATE), math.log(RET_MIN_RATE), RET_HEADS)).astype(f32)
    base = jnp.log(-jnp.log1p(-rates))
    return {
        "x": x,
        "mem": mem,
        "positions": positions,
        "mem_norm_g": gain((D_MODEL,)),
        "final_norm_g": gain((D_MODEL,)),
        "mix_norm_g": gain((DEPTH, D_MODEL)),
        "xa_norm_g": gain((DEPTH, D_MODEL)),
        "ffn_norm_g": gain((DEPTH, D_MODEL)),
        "xa_wq": nrm((DEPTH, D_MODEL, D_MODEL), D_MODEL),
        "xa_wkv": nrm((DEPTH, D_MODEL, 2 * D_MODEL), D_MODEL),
        "xa_wo": nrm((DEPTH, D_MODEL, D_MODEL), D_MODEL),
        "ev_w_in": nrm((N_EVEN, D_MODEL, EVEN_IN), D_MODEL),
        "ev_conv_w": nrm((N_EVEN, CONV_TAPS, CONV_CH), CONV_TAPS),
        "ev_ret_decay_f": base[None, :] + 0.05 * jax.random.normal(next(ks), (N_EVEN, RET_HEADS), f32),
        "ev_ret_decay_b": base[None, :] + 0.05 * jax.random.normal(next(ks), (N_EVEN, RET_HEADS), f32),
        "ev_ret_gn_g": gain((N_EVEN, RET_V)),
        "ev_w_out": nrm((N_EVEN, EVEN_OUT, D_MODEL), EVEN_OUT),
        "ffd_w_gate": nrm((N_EVEN, D_MODEL, D_FF), D_MODEL),
        "ffd_w_up": nrm((N_EVEN, D_MODEL, D_FF), D_MODEL),
        "ffd_w_down": nrm((N_EVEN, D_FF, D_MODEL), D_FF),
        "od_w_in": nrm((N_ODD, D_MODEL, ODD_IN), D_MODEL),
        "od_lam_q1": 0.1 * jax.random.normal(next(ks), (N_ODD, DIFF_D), f32),
        "od_lam_k1": 0.1 * jax.random.normal(next(ks), (N_ODD, DIFF_D), f32),
        "od_lam_q2": 0.1 * jax.random.normal(next(ks), (N_ODD, DIFF_D), f32),
        "od_lam_k2": 0.1 * jax.random.normal(next(ks), (N_ODD, DIFF_D), f32),
        "od_gn_g": gain((N_ODD, DIFF_V)),
        "od_w_out": nrm((N_ODD, DIFF_V, D_MODEL), DIFF_V),
        "moe_router": nrm((N_ODD, D_MODEL, N_EXPERTS), D_MODEL),
        "moe_w_gate": nrm((N_ODD, N_EXPERTS, D_MODEL, D_FF_EXPERT), D_MODEL),
        "moe_w_up": nrm((N_ODD, N_EXPERTS, D_MODEL, D_FF_EXPERT), D_MODEL),
        "moe_w_down": nrm((N_ODD, N_EXPERTS, D_FF_EXPERT, D_MODEL), D_FF_EXPERT),
    }


def reference(x, mem, positions, mem_norm_g, final_norm_g, mix_norm_g, xa_norm_g, ffn_norm_g,
              xa_wq, xa_wkv, xa_wo, ev_w_in, ev_conv_w, ev_ret_decay_f, ev_ret_decay_b, ev_ret_gn_g,
              ev_w_out, ffd_w_gate, ffd_w_up, ffd_w_down, od_w_in, od_lam_q1, od_lam_k1, od_lam_q2,
              od_lam_k2, od_gn_g, od_w_out, moe_router, moe_w_gate, moe_w_up, moe_w_down):
    mem_n = rms_norm(mem, mem_norm_g)
    for i in range(DEPTH):
        j = i // 2
        h = rms_norm(x, mix_norm_g[i])
        if i % 2 == 0:
            x = x + even_token_mixer(h, positions, ev_w_in[j], ev_conv_w[j], ev_ret_decay_f[j],
                                     ev_ret_decay_b[j], ev_ret_gn_g[j], ev_w_out[j])
        else:
            lambda_init = 0.8 - 0.6 * math.exp(-0.3 * i)
            x = x + diff_attention_mixer(h, positions, od_w_in[j], od_lam_q1[j], od_lam_k1[j],
                                         od_lam_q2[j], od_lam_k2[j], od_gn_g[j], od_w_out[j], lambda_init)
        x = x + memory_cross_attention(rms_norm(x, xa_norm_g[i]), mem_n, xa_wq[i], xa_wkv[i], xa_wo[i])
        h = rms_norm(x, ffn_norm_g[i])
        if i % 2 == 0:
            x = x + swiglu(h, ffd_w_gate[j], ffd_w_up[j], ffd_w_down[j])
        else:
            x = x + moe_swiglu(h, moe_router[j], moe_w_gate[j], moe_w_up[j], moe_w_down[j])
    return rms_norm(x, final_norm_g)
```

```cpp
#include <hip/hip_runtime.h>
#include <cstdio>
#include <cstdint>
#define DBG 0
namespace pg8 {
#define PG8_LAS __attribute__((address_space(3)))
typedef unsigned short bf16_t;
typedef short bf16x8 __attribute__((ext_vector_type(8)));
typedef float f32x4 __attribute__((ext_vector_type(4)));
typedef unsigned u32x4 __attribute__((ext_vector_type(4)));
constexpr int BM = 256, BK = 64, HALF = 128, HTB = HALF * BK * 2  , STAGE_BYTES = 8 * HTB, NXCD = 8, WGM = 8;

__host__ __device__ __forceinline__ int lds_byte(int r, int c) { const int st = (r >> 4) * 2 + (c >> 5), rr = r & 15, cc = c & 31, ob = rr * 64 + cc * 2; return st * 1024 + (ob ^ (((ob >> 9) & 1) << 5)); }
__host__ __device__ __forceinline__ void stage_rc(int b, int& R, int& C) { const int st = b / 1024, sb = b % 1024, swz = sb ^ (((sb >> 9) & 1) << 5); R = (st >> 1) * 16 + swz / 64; C = (st & 1) * 32 + (swz % 64) / 2; }
__host__ __device__ __forceinline__ int perm32(int rho) { const int n = rho >> 4, i = rho & 15; return 8 * (i >> 2) + 4 * n + (i & 3); }

struct Unit { int pm, pn; };
#ifdef GPROBE_ID
__device__ unsigned gp_buf[4];
#endif
struct Gemm { const bf16_t* A; const bf16_t* Bt; int M, N, K; };

struct StaticOrder {
    int nM, nN, nwg, G, c;
    __host__ __device__ void init(int M, int N, int G_, int c_) { nM = M / BM; nN = N / BM; nwg = nM * nN; G = G_; c = c_; }
    __host__ __device__ bool next(int i, Unit& u) const {
        const long L = (long)i * G + c; if (L >= nwg) return false;
        int wgid = (int)L; { const int q = nwg / NXCD, r = nwg % NXCD, xcd = wgid % NXCD, off = wgid / NXCD; wgid = (xcd < r ? xcd * (q + 1) : r * (q + 1) + (xcd - r) * q) + off; }
        const int nig = WGM * nN, gid = wgid / nig, fm = gid * WGM, gsz = (nM - fm) < WGM ? (nM - fm) : WGM;
        u.pm = fm + ((wgid % nig) % gsz); u.pn = (wgid % nig) / gsz; return true;
    }
    __device__ __forceinline__ void a_ready(const Unit&) const {}
    __device__ __forceinline__ void done(const Unit&) const {}
};

typedef float f32x2 __attribute__((ext_vector_type(2)));
typedef int v4i_t __attribute__((ext_vector_type(4)));
typedef int v8i_t __attribute__((ext_vector_type(8)));
__device__ __forceinline__ v8i_t cat8(bf16x8 a, bf16x8 b) { const v4i_t x = __builtin_bit_cast(v4i_t, a), y = __builtin_bit_cast(v4i_t, b); return __builtin_shufflevector(x, y, 0, 1, 2, 3, 4, 5, 6, 7); }
__device__ __forceinline__ unsigned pack_fp8x4(float a, float b, float c, float d) {
    a = fminf(fmaxf(a, -440.f), 440.f); b = fminf(fmaxf(b, -440.f), 440.f); c = fminf(fmaxf(c, -440.f), 440.f); d = fminf(fmaxf(d, -440.f), 440.f);
    int w = 0; w = __builtin_amdgcn_cvt_pk_fp8_f32(a, b, w, false); w = __builtin_amdgcn_cvt_pk_fp8_f32(c, d, w, true); return (unsigned)w; }
__device__ __forceinline__ unsigned cvt_pk_bf16(float lo, float hi) { unsigned r; asm volatile("v_cvt_pk_bf16_f32 %0, %1, %2" : "=v"(r) : "v"(lo), "v"(hi)); return r; }
__device__ __forceinline__ u32x4 pack8(const f32x4 a, const f32x4 b) { u32x4 w; w.x = cvt_pk_bf16(a[0], a[1]); w.y = cvt_pk_bf16(a[2], a[3]); w.z = cvt_pk_bf16(b[0], b[1]); w.w = cvt_pk_bf16(b[2], b[3]); return w; }
constexpr float RMS_EPS = 1e-6f, INV_D = 1.f / 1024.f, INV_2PI = 0.15915494309189535f, LOG2E = 1.4426950408889634f;
constexpr float L2_RET_THETA_32 = 13.287712379549449f / 32.f;
constexpr float L2_ROPE_THETA_8 = 18.931568569324174f / 8.f;
__device__ __forceinline__ float rs_row4(const float* ssq, int row, int fq) {
    const f32x4 p = *(const f32x4*)(ssq + (size_t)row * 16 + 4 * fq);
    float s = (p[0] + p[1]) + (p[2] + p[3]);
    s += __shfl_xor(s, 16); s += __shfl_xor(s, 32);
    return rsqrtf(s * INV_D + RMS_EPS);
}
__device__ __forceinline__ void sincos_rev(float rev, float& sn, float& cs) { rev -= floorf(rev); sn = __builtin_amdgcn_sinf(rev); cs = __builtin_amdgcn_cosf(rev); }

template <int MODE> struct EpiRow {
    static constexpr bool PERM = true, AFTER_DRAIN = false;
    bf16_t* O; int ldc; const float* ssq; const int* pos; float sc; const float* decf; const float* decb;
    __device__ __forceinline__ void operator()(const f32x4 (&acc)[2][2][4][2], const Unit& u, int wr, int wc, int fr, int fq) const {
        const int row0 = u.pm * BM + wr * 64 + fr, col0 = u.pn * BM + wc * 32 + 8 * fq;
        bool rope = false; float cf[4] = {0.f, 0.f, 0.f, 0.f}; float csc = sc;
        float lgf[2] = {0.f, 0.f}, lgb[2] = {0.f, 0.f};
        if (MODE == 1) { rope = (u.pn >= 6 && u.pn < 10); csc = (u.pn == 8 || u.pn == 9) ? 0.125f : 1.f; const int g = (wc & 1) * 4 + fq;
#pragma unroll
            for (int j = 0; j < 4; ++j) cf[j] = __builtin_amdgcn_exp2f(-(float)(4 * g + j) * L2_RET_THETA_32) * INV_2PI;
            if (rope) {
#pragma unroll
                for (int bj = 0; bj < 2; ++bj) { const int head = 4 * (u.pn & 1) + 2 * bj + (wc >> 1); lgf[bj] = -__expf(decf[head]) * LOG2E; lgb[bj] = -__expf(decb[head]) * LOG2E; } } }
        if (MODE == 2) { rope = ((wc & 1) == 0) && (fq < 2); csc = (u.pn < 4) ? 0.125f * LOG2E : 1.f;
#pragma unroll
            for (int j = 0; j < 4; ++j) cf[j] = __builtin_amdgcn_exp2f(-(float)(4 * fq + j) * L2_ROPE_THETA_8) * INV_2PI; }
        float rsv[8], posv[8];
#pragma unroll
        for (int k = 0; k < 8; ++k) { const int row = row0 + (k >> 2) * HALF + (k & 3) * 16; rsv[k] = ssq ? rs_row4(ssq, row, fq) : 1.f; posv[k] = (MODE != 0) ? (float)pos[row] : 0.f; }
#pragma unroll
        for (int k = 0; k < 8; ++k) asm volatile("" : "+v"(rsv[k]), "+v"(posv[k]));
#pragma unroll
        for (int ai = 0; ai < 2; ++ai)
#pragma unroll
            for (int m = 0; m < 4; ++m) { const int row = row0 + ai * HALF + m * 16;
                const float s = rsv[ai * 4 + m] * csc;
                float sn[4], cs[4];
                if (MODE == 2 || (MODE == 1 && rope)) { const float posf = posv[ai * 4 + m];
#pragma unroll
                    for (int j = 0; j < 4; ++j) sincos_rev(posf * cf[j], sn[j], cs[j]); }
                else {
#pragma unroll
                    for (int j = 0; j < 4; ++j) { sn[j] = 0.f; cs[j] = 1.f; } }
#pragma unroll
                for (int bj = 0; bj < 2; ++bj) { f32x4 v0 = acc[ai][bj][m][0] * s, v1 = acc[ai][bj][m][1] * s;
                    if (MODE != 0) { if (rope) {
#pragma unroll
                        for (int j = 0; j < 4; ++j) { const float x1 = v0[j], x2 = v1[j]; v0[j] = x1 * cs[j] - x2 * sn[j]; v1[j] = x1 * sn[j] + x2 * cs[j]; } } }
                    if (MODE == 1 && rope) {
                        const bool isk = u.pn >= 8; const int lm = isk ? (row & 63) : (row & 31);
                        const float ff = __builtin_amdgcn_exp2f(lgf[bj] * (float)(isk ? -lm : lm)), fb = __builtin_amdgcn_exp2f(lgb[bj] * (float)(isk ? lm : -lm));
                        *(u32x4*)(O + (size_t)row * ldc + col0 + bj * HALF) = pack8(v0 * ff, v1 * ff);
                        *(u32x4*)(O + (size_t)row * ldc + col0 + bj * HALF + 1536) = pack8(v0 * fb, v1 * fb); }
                    else *(u32x4*)(O + (size_t)row * ldc + col0 + bj * HALF) = pack8(v0, v1); } }
    }
};

template <int MODE> struct EpiCol {
    static constexpr bool PERM = true, AFTER_DRAIN = false;
    bf16_t* O; bf16_t* KF; bf16_t* KB; size_t ldc; const float* ssq; const int* pos; const float* decf; const float* decb;
    __device__ __forceinline__ float rs_tok(int tok, int fr) const { float p = ssq[(size_t)tok * 16 + fr]; p += __shfl_xor(p, 1); p += __shfl_xor(p, 2); p += __shfl_xor(p, 4); p += __shfl_xor(p, 8); return rsqrtf(p * INV_D + RMS_EPS); }
    __device__ __forceinline__ void operator()(const f32x4 (&acc)[2][2][4][2], const Unit& u, int wr, int wc, int fr, int fq) const {
        const int R0 = u.pm * BM + wr * 64 + fr, tok0 = u.pn * BM + wc * 32 + 8 * fq;
        typedef unsigned u32x2v __attribute__((ext_vector_type(2)));
        float rs16[16];
        if (ssq) { const int tkm = tok0 + (fr >> 3) * HALF + (fr & 7); const f32x4* sp = (const f32x4*)(ssq + (size_t)tkm * 16); const f32x4 s0 = sp[0], s1 = sp[1], s2 = sp[2], s3 = sp[3];
            const float pp = ((s0[0] + s0[1]) + (s0[2] + s0[3])) + ((s1[0] + s1[1]) + (s1[2] + s1[3])) + ((s2[0] + s2[1]) + (s2[2] + s2[3])) + ((s3[0] + s3[1]) + (s3[2] + s3[3]));
            const float myrs = rsqrtf(pp * INV_D + RMS_EPS); const int lb = (fq << 4);
#pragma unroll
            for (int t = 0; t < 16; ++t) rs16[t] = __shfl(myrs, lb + t); }
        else {
#pragma unroll
            for (int t = 0; t < 16; ++t) rs16[t] = 1.f; }
#pragma unroll
        for (int bj = 0; bj < 2; ++bj)
#pragma unroll
            for (int n = 0; n < 2; ++n) { const int tk = tok0 + bj * HALF + 4 * n;
                f32x4 rs;
#pragma unroll
                for (int j = 0; j < 4; ++j) rs[j] = rs16[bj * 8 + n * 4 + j];
                if (MODE == 1 && u.pm < 2) {
                    f32x4 posf;
#pragma unroll
                    for (int j = 0; j < 4; ++j) posf[j] = (float)pos[tk + j];
#pragma unroll
                    for (int mm = 0; mm < 2; ++mm) { const float cfm = __builtin_amdgcn_exp2f(-(float)(16 * mm + fr) * L2_RET_THETA_32) * INV_2PI;
                        f32x4 sn, cs;
#pragma unroll
                        for (int j = 0; j < 4; ++j) { float a, b; sincos_rev(posf[j] * cfm, a, b); sn[j] = a; cs[j] = b; }
#pragma unroll
                        for (int ai = 0; ai < 2; ++ai) { const int head = u.pm * 4 + ai * 2 + wr;
                            const float lgf = -__expf(decf[head]) * LOG2E, lgb = -__expf(decb[head]) * LOG2E;
                            const f32x4 x1 = acc[ai][bj][mm][n] * (rs * 0.125f), x2 = acc[ai][bj][mm + 2][n] * (rs * 0.125f);
                            const f32x4 y1 = x1 * cs - x2 * sn, y2 = x1 * sn + x2 * cs;
                            f32x4 wf, wb;
#pragma unroll
                            for (int j = 0; j < 4; ++j) { const int ci = (tk + j) & 127; wf[j] = __builtin_amdgcn_exp2f(lgf * (float)(127 - ci)); wb[j] = __builtin_amdgcn_exp2f(lgb * (float)ci); }
                            const size_t o1 = (size_t)(R0 + ai * HALF + mm * 16) * ldc + tk, o2 = o1 + (size_t)32 * ldc;
                            f32x4 t; u32x2v w;
                            t = y1 * wf; w.x = cvt_pk_bf16(t[0], t[1]); w.y = cvt_pk_bf16(t[2], t[3]); *(u32x2v*)(KF + o1) = w;
                            t = y2 * wf; w.x = cvt_pk_bf16(t[0], t[1]); w.y = cvt_pk_bf16(t[2], t[3]); *(u32x2v*)(KF + o2) = w;
                            t = y1 * wb; w.x = cvt_pk_bf16(t[0], t[1]); w.y = cvt_pk_bf16(t[2], t[3]); *(u32x2v*)(KB + o1) = w;
                            t = y2 * wb; w.x = cvt_pk_bf16(t[0], t[1]); w.y = cvt_pk_bf16(t[2], t[3]); *(u32x2v*)(KB + o2) = w; } }
                } else {
                    const int Roff = (MODE == 1) ? -512 : 0;
#pragma unroll
                    for (int ai = 0; ai < 2; ++ai)
#pragma unroll
                        for (int m = 0; m < 4; ++m) { const f32x4 t = acc[ai][bj][m][n] * rs; u32x2v w; w.x = cvt_pk_bf16(t[0], t[1]); w.y = cvt_pk_bf16(t[2], t[3]);
                            *(u32x2v*)(O + (size_t)(R0 + Roff + ai * HALF + m * 16) * ldc + tk) = w; }
                } }
    }
};

template <long long X8OFF = 0> struct EpiResT {
    static constexpr bool PERM = true, AFTER_DRAIN = false;
    bf16_t* XB; float* ssq; float sc;
    __device__ __forceinline__ void operator()(const f32x4 (&acc)[2][2][4][2], const Unit& u, int wr, int wc, int fr, int fq) const {
        const int row0 = u.pm * BM + wr * 64 + fr, col0 = u.pn * BM + wc * 32 + 8 * fq;
        u32x4 xv[4][2];
#pragma unroll
        for (int m = 0; m < 4; ++m)
#pragma unroll
            for (int bj = 0; bj < 2; ++bj) xv[m][bj] = *(const u32x4*)(XB + (size_t)(row0 + m * 16) * 1024 + col0 + bj * HALF);
#pragma unroll
        for (int ai = 0; ai < 2; ++ai) {
            float ss[4];
#pragma unroll
            for (int m = 0; m < 4; ++m) { bf16_t* xr = XB + (size_t)(row0 + ai * HALF + m * 16) * 1024 + col0; ss[m] = 0.f;
#pragma unroll
                for (int bj = 0; bj < 2; ++bj) { const u32x4 x = xv[m][bj]; f32x4 a, b;
                    if (ai == 0) xv[m][bj] = *(const u32x4*)(XB + (size_t)(row0 + HALF + m * 16) * 1024 + col0 + bj * HALF);
                    a[0] = __builtin_bit_cast(float, x.x << 16); a[1] = __builtin_bit_cast(float, x.x & 0xffff0000u); a[2] = __builtin_bit_cast(float, x.y << 16); a[3] = __builtin_bit_cast(float, x.y & 0xffff0000u);
                    b[0] = __builtin_bit_cast(float, x.z << 16); b[1] = __builtin_bit_cast(float, x.z & 0xffff0000u); b[2] = __builtin_bit_cast(float, x.w << 16); b[3] = __builtin_bit_cast(float, x.w & 0xffff0000u);
                    a = a + acc[ai][bj][m][0] * sc; b = b + acc[ai][bj][m][1] * sc;
                    const u32x4 w = pack8(a, b); *(u32x4*)(xr + bj * HALF) = w;
                    a[0] = __builtin_bit_cast(float, w.x << 16); a[1] = __builtin_bit_cast(float, w.x & 0xffff0000u); a[2] = __builtin_bit_cast(float, w.y << 16); a[3] = __builtin_bit_cast(float, w.y & 0xffff0000u);
                    b[0] = __builtin_bit_cast(float, w.z << 16); b[1] = __builtin_bit_cast(float, w.z & 0xffff0000u); b[2] = __builtin_bit_cast(float, w.w << 16); b[3] = __builtin_bit_cast(float, w.w & 0xffff0000u);
                    if constexpr (X8OFF != 0) { typedef unsigned u32x2v __attribute__((ext_vector_type(2))); u32x2v o; o.x = pack_fp8x4(a[0], a[1], a[2], a[3]); o.y = pack_fp8x4(b[0], b[1], b[2], b[3]);
                        *(u32x2v*)((unsigned char*)XB + X8OFF + (size_t)(row0 + ai * HALF + m * 16) * 1024 + col0 + bj * HALF) = o; }
                    ss[m] += (a[0] * a[0] + a[1] * a[1]) + (a[2] * a[2] + a[3] * a[3]) + (b[0] * b[0] + b[1] * b[1]) + (b[2] * b[2] + b[3] * b[3]); } }
#pragma unroll
            for (int m = 0; m < 4; ++m) ss[m] += __shfl_xor(ss[m], 16);
#pragma unroll
            for (int m = 0; m < 4; ++m) ss[m] += __shfl_xor(ss[m], 32);
            if (fq == 0) {
#pragma unroll
                for (int m = 0; m < 4; ++m) ssq[(size_t)(row0 + ai * HALF + m * 16) * 16 + u.pn * 4 + wc] = ss[m]; }
        }
    }
};

typedef EpiResT<0> EpiRes;

template <bool F8OUT> struct EpiSwiT {
    static constexpr bool PERM = true, AFTER_DRAIN = false;
    void* O; int ldc; const float* ssq; int nN; float asc, osc;
    __device__ __forceinline__ void operator()(const f32x4 (&acc)[2][2][4][2], const Unit& u, int wr, int wc, int fr, int fq) const {
        const int row0 = u.pm * BM + wr * 64 + fr, col0 = (u.pn % nN) * HALF + wc * 32 + 8 * fq;
        float rsv[8];
#pragma unroll
        for (int k = 0; k < 8; ++k) { const int row = row0 + (k >> 2) * HALF + (k & 3) * 16; rsv[k] = F8OUT ? (ssq ? rs_row4(ssq, row, fq) * asc : asc) : rs_row4(ssq, row, fq); }
        if (ssq) {
#pragma unroll
            for (int k = 0; k < 8; ++k) asm volatile("" : "+v"(rsv[k])); }
#pragma unroll
        for (int ai = 0; ai < 2; ++ai)
#pragma unroll
            for (int m = 0; m < 4; ++m) { const int row = row0 + ai * HALF + m * 16;
                const float rs = rsv[ai * 4 + m], kneg = -rs * LOG2E, c2 = rs * rs * (F8OUT ? osc : 1.f);
                f32x4 h[2];
#pragma unroll
                for (int n = 0; n < 2; ++n) { const f32x4 a = acc[ai][0][m][n], b = acc[ai][1][m][n]; const f32x4 t = a * kneg; f32x4 d;
#pragma unroll
                    for (int j = 0; j < 4; ++j) d[j] = __builtin_amdgcn_exp2f(t[j]);
                    d = d + 1.f;
#pragma unroll
                    for (int j = 0; j < 4; ++j) d[j] = __builtin_amdgcn_rcpf(d[j]);
                    h[n] = ((a * b) * c2) * d; }
                if (F8OUT) { typedef unsigned u32x2v __attribute__((ext_vector_type(2))); u32x2v w; w.x = pack_fp8x4(h[0][0], h[0][1], h[0][2], h[0][3]); w.y = pack_fp8x4(h[1][0], h[1][1], h[1][2], h[1][3]);
                    *(u32x2v*)((unsigned char*)O + (size_t)row * ldc + col0) = w; }
                else *(u32x4*)((bf16_t*)O + (size_t)row * ldc + col0) = pack8(h[0], h[1]); }
    }
};
typedef EpiSwiT<false> EpiSwi;

struct EpiY {
    static constexpr bool PERM = true, AFTER_DRAIN = false;
    bf16_t* O; int ldc; int nN; float sc;
    __device__ __forceinline__ void operator()(const f32x4 (&acc)[2][2][4][2], const Unit& u, int wr, int wc, int fr, int fq) const {
        const int row0 = u.pm * BM + wr * 64 + fr, col0 = (u.pn % nN) * BM + wc * 32 + 8 * fq;
#pragma unroll
        for (int ai = 0; ai < 2; ++ai)
#pragma unroll
            for (int m = 0; m < 4; ++m)
#pragma unroll
                for (int bj = 0; bj < 2; ++bj)
                    *(u32x4*)(O + (size_t)(row0 + ai * HALF + m * 16) * ldc + col0 + bj * HALF) = pack8(acc[ai][bj][m][0] * sc, acc[ai][bj][m][1] * sc);
    }
};

struct MoeOrder {
    int nM, nN, nwg, G, c, lo; int tb[9];
    __device__ __forceinline__ bool next(int i, Unit& u) const {
        const long L = (long)i * G + c; if (L >= nwg) return false;
        int wgid = (int)L; { const int q = nwg / NXCD, r = nwg % NXCD, xcd = wgid % NXCD, off = wgid / NXCD; wgid = (xcd < r ? xcd * (q + 1) : r * (q + 1) + (xcd - r) * q) + off; }
        const int nig = WGM * nN, gid = wgid / nig, fm = gid * WGM, gsz = (nM - fm) < WGM ? (nM - fm) : WGM;
        u.pm = fm + ((wgid % nig) % gsz); const int pn = (wgid % nig) / gsz; const int gt = lo + u.pm; int e = 0;
#pragma unroll
        for (int k = 1; k < 8; ++k) e += (gt >= tb[k]) ? 1 : 0;
        u.pn = e * nN + pn; return true;
    }
    __device__ __forceinline__ void a_ready(const Unit&) const {}
    __device__ __forceinline__ void done(const Unit&) const {}
};
template <class Epi, class Sched, bool ALIGN_EPI = false, bool SP2 = false, bool F8 = false>
__device__ __forceinline__ void gemm_phase(PG8_LAS unsigned char* lds, const Gemm g, const Sched& S, const Epi& E, int tid_in) {
    int tid_ = tid_in; asm volatile("" : "+v"(tid_));
    const int tid = tid_, wid = __builtin_amdgcn_readfirstlane(tid >> 6), lane = tid & 63, wr = wid >> 2, wc = wid & 3, fr = lane & 15, fq = lane >> 4;
    int Kv_ = g.K; asm volatile("" : "+v"(Kv_)); const int K = __builtin_amdgcn_readfirstlane(Kv_), nt = K / BK;
    unsigned voffA[2], voffB[2];
#pragma unroll
    for (int i = 0; i < 2; ++i) { int R, C; stage_rc(tid * 16 + i * 8192, R, C); const int Rb = Epi::PERM ? ((R & ~31) + perm32(R & 31)) : R;
        voffA[i] = (unsigned)(R * K + C) * 2u; voffB[i] = (unsigned)(Rb * K + C) * 2u; }
    const size_t kstep = (size_t)(BK * 2);
    const size_t hstep = (size_t)HALF * K * 2;
    const size_t tstep = 2 * hstep;
    const unsigned ldsw = (unsigned)wid * 1024u;
    const int aoff = lds_byte(wr * 64 + fr, fq * 8), boff = lds_byte(wc * 32 + fr, fq * 8);
#define PG8_SA(b, h) (((b) * 2 + (h)) * HTB)
#define PG8_SB(b, h) ((4 + (b) * 2 + (h)) * HTB)
#define PG8_STAGE(bufoff, gbase, voff) do { _Pragma("unroll") for (int _i = 0; _i < 2; ++_i) \
        __builtin_amdgcn_global_load_lds((const unsigned*)((const char*)(gbase) + (voff)[_i]), (PG8_LAS unsigned*)(lds + (bufoff) + ldsw + _i * 8192), 16, 0, 0); } while (0)
#define PG8_LDA(dst, b, h) do { _Pragma("unroll") for (int m = 0; m < 4; ++m) _Pragma("unroll") for (int k = 0; k < 2; ++k) dst[m][k] = *(const PG8_LAS bf16x8*)(lds + PG8_SA(b, h) + aoff + m * 2048 + k * 1024); } while (0)
#define PG8_LDB(dst, b, h) do { _Pragma("unroll") for (int n = 0; n < 2; ++n) _Pragma("unroll") for (int k = 0; k < 2; ++k) dst[n][k] = *(const PG8_LAS bf16x8*)(lds + PG8_SB(b, h) + boff + n * 2048 + k * 1024); } while (0)
#define PG8_MMA(ai, bj, At, Bt) do { __builtin_amdgcn_s_setprio(1); if constexpr (F8) { _Pragma("unroll") for (int m = 0; m < 4; ++m) _Pragma("unroll") for (int n = 0; n < 2; ++n) \
        asm volatile("v_mfma_scale_f32_16x16x128_f8f6f4 %0, %1, %2, %0, %3, %3 op_sel_hi:[0,0,0]" : "+v"(acc[ai][bj][m][n]) : "v"(cat8(Bt[n][0], Bt[n][1])), "v"(cat8(At[m][0], At[m][1])), "v"(f8scale)); } \
        else { _Pragma("unroll") for (int m = 0; m < 4; ++m) _Pragma("unroll") for (int n = 0; n < 2; ++n) _Pragma("unroll") for (int k = 0; k < 2; ++k) \
        acc[ai][bj][m][n] = __builtin_amdgcn_mfma_f32_16x16x32_bf16(Bt[n][k], At[m][k], acc[ai][bj][m][n], 0, 0, 0); } __builtin_amdgcn_s_setprio(0); } while (0)
#define PG8_WAIT_V(n) asm volatile("s_waitcnt vmcnt(" #n ")" ::: "memory")
#define PG8_WAIT_L(n) asm volatile("s_waitcnt lgkmcnt(" #n ")" ::: "memory")
#define PG8_BAR __builtin_amdgcn_s_barrier()
#define PG8_SCHED __builtin_amdgcn_sched_barrier(0)
    const int f8scale = 0x7f7f7f7f;
    Unit cur, nxt; int ui = 0;
    if (!S.next(0, cur)) return;
    f32x4 acc[2][2][4][2];
#pragma unroll
    for (int a = 0; a < 2; ++a)
#pragma unroll
        for (int b = 0; b < 2; ++b)
#pragma unroll
            for (int m = 0; m < 4; ++m)
#pragma unroll
                for (int n = 0; n < 2; ++n) { acc[a][b][m][n] = (f32x4){0.f, 0.f, 0.f, 0.f}; if constexpr (F8) asm volatile("" : "+v"(acc[a][b][m][n])); }
    bf16x8 At[4][2], B0[2][2], B1[2][2];
    const char* cA = (const char*)g.A + (size_t)cur.pm * tstep; const char* cB = (const char*)g.Bt + (size_t)cur.pn * tstep;
    S.a_ready(cur);
    if constexpr (SP2) {
        PG8_STAGE(PG8_SB(0, 0), cB, voffB); PG8_STAGE(PG8_SB(0, 1), cB + hstep, voffB); PG8_STAGE(PG8_SA(0, 0), cA, voffA); PG8_STAGE(PG8_SA(0, 1), cA + hstep, voffA);
        if (wr == 1) PG8_BAR;
        PG8_WAIT_V(2); PG8_BAR;
        PG8_STAGE(PG8_SB(1, 0), cB + kstep, voffB); PG8_STAGE(PG8_SA(1, 0), cA + kstep, voffA); PG8_STAGE(PG8_SB(1, 1), cB + hstep + kstep, voffB);
        PG8_WAIT_V(6); PG8_BAR;
    } else {
        PG8_STAGE(PG8_SB(0, 0), cB, voffB); PG8_STAGE(PG8_SA(0, 0), cA, voffA); PG8_STAGE(PG8_SB(0, 1), cB + hstep, voffB); PG8_STAGE(PG8_SA(0, 1), cA + hstep, voffA);
        if (wr == 1) PG8_BAR;
        PG8_WAIT_V(4); PG8_BAR;
        PG8_STAGE(PG8_SB(1, 0), cB + kstep, voffB); PG8_STAGE(PG8_SA(1, 0), cA + kstep, voffA); PG8_STAGE(PG8_SB(1, 1), cB + hstep + kstep, voffB);
        PG8_WAIT_V(6); PG8_BAR;
    }
    for (;;) {
        const bool has_next = S.next(ui + 1, nxt);
        const char* nA = has_next ? (const char*)g.A + (size_t)nxt.pm * tstep : cA; const char* nB = has_next ? (const char*)g.Bt + (size_t)nxt.pn * tstep : cB;
        int t = 0;
#pragma unroll 1
        do {
            const bool last = (t == nt - 2);
            const char* a1 = cA + (size_t)(t + 1) * kstep;
            const char* a2 = last ? nA : cA + (size_t)(t + 2) * kstep; const char* b2 = last ? nB : cB + (size_t)(t + 2) * kstep;
            const char* a3 = a2 + kstep; const char* b3 = b2 + kstep;
            if (last && has_next) S.a_ready(nxt);
            if constexpr (SP2) {
            PG8_LDB(B0, 0, 0); PG8_LDB(B1, 0, 1); PG8_SCHED; PG8_LDA(At, 0, 0); PG8_STAGE(PG8_SA(1, 1), a1 + hstep, voffA);
            PG8_WAIT_V(8); PG8_WAIT_L(0); PG8_BAR; PG8_MMA(0, 0, At, B0); PG8_MMA(0, 1, At, B1); PG8_BAR; PG8_SCHED;
            PG8_LDA(At, 0, 1); PG8_STAGE(PG8_SB(0, 0), b2, voffB); PG8_STAGE(PG8_SB(0, 1), b2 + hstep, voffB); PG8_STAGE(PG8_SA(0, 0), a2, voffA);
            PG8_WAIT_V(8); PG8_WAIT_L(0); PG8_BAR; PG8_MMA(1, 0, At, B0); PG8_MMA(1, 1, At, B1); PG8_BAR; PG8_SCHED;
            PG8_LDB(B0, 1, 0); PG8_LDB(B1, 1, 1); PG8_SCHED; PG8_LDA(At, 1, 0); PG8_STAGE(PG8_SA(0, 1), a2 + hstep, voffA);
            PG8_WAIT_V(8); PG8_WAIT_L(0); PG8_BAR; PG8_MMA(0, 0, At, B0); PG8_MMA(0, 1, At, B1); PG8_BAR; PG8_SCHED;
            PG8_LDA(At, 1, 1); PG8_STAGE(PG8_SB(1, 0), b3, voffB); PG8_STAGE(PG8_SB(1, 1), b3 + hstep, voffB); PG8_STAGE(PG8_SA(1, 0), a3, voffA);
            PG8_WAIT_V(8); PG8_WAIT_L(0); PG8_BAR; PG8_MMA(1, 0, At, B0); PG8_MMA(1, 1, At, B1); PG8_BAR; PG8_SCHED;
            } else {
            PG8_LDB(B0, 0, 0); PG8_SCHED; PG8_LDA(At, 0, 0); PG8_STAGE(PG8_SA(1, 1), a1 + hstep, voffA);
            PG8_WAIT_L(8); PG8_BAR; PG8_WAIT_L(0); PG8_MMA(0, 0, At, B0); PG8_BAR; PG8_SCHED;
            PG8_LDB(B1, 0, 1); PG8_STAGE(PG8_SB(0, 0), b2, voffB);
            PG8_BAR; PG8_WAIT_L(0); PG8_MMA(0, 1, At, B1); PG8_BAR;
            PG8_LDA(At, 0, 1); PG8_STAGE(PG8_SA(0, 0), a2, voffA);
            PG8_BAR; PG8_WAIT_L(0); PG8_MMA(1, 0, At, B0); PG8_BAR; PG8_SCHED;
            PG8_STAGE(PG8_SB(0, 1), b2 + hstep, voffB);
            PG8_WAIT_V(6); PG8_BAR; PG8_MMA(1, 1, At, B1); PG8_BAR;
            PG8_LDB(B0, 1, 0); PG8_SCHED; PG8_LDA(At, 1, 0); PG8_STAGE(PG8_SA(0, 1), a2 + hstep, voffA);
            PG8_WAIT_L(8); PG8_BAR; PG8_WAIT_L(0); PG8_MMA(0, 0, At, B0); PG8_BAR; PG8_SCHED;
            PG8_LDB(B1, 1, 1); PG8_STAGE(PG8_SB(1, 0), b3, voffB);
            PG8_BAR; PG8_WAIT_L(0); PG8_MMA(0, 1, At, B1); PG8_BAR;
            PG8_LDA(At, 1, 1); PG8_STAGE(PG8_SA(1, 0), a3, voffA);
            PG8_BAR; PG8_WAIT_L(0); PG8_MMA(1, 0, At, B0); PG8_BAR; PG8_SCHED;
            PG8_STAGE(PG8_SB(1, 1), b3 + hstep, voffB);
            PG8_WAIT_V(6); PG8_BAR; PG8_MMA(1, 1, At, B1); PG8_BAR;
            }
            t += 2;
        } while (t < nt);
        if constexpr (ALIGN_EPI) { if (wr == 0) PG8_BAR; }
        if constexpr (F8) asm volatile("s_nop 15\n\ts_nop 15" ::: "memory");
        if constexpr (!Epi::AFTER_DRAIN) { E(acc, cur, wr, wc, fr, fq); S.done(cur); }
        if (!has_next) break;
#pragma unroll
        for (int a = 0; a < 2; ++a)
#pragma unroll
            for (int b = 0; b < 2; ++b)
#pragma unroll
                for (int m = 0; m < 4; ++m)
#pragma unroll
                    for (int n = 0; n < 2; ++n) { acc[a][b][m][n] = (f32x4){0.f, 0.f, 0.f, 0.f}; if constexpr (F8) asm volatile("" : "+v"(acc[a][b][m][n])); }
        cur = nxt; cA = nA; cB = nB; ++ui;
        if constexpr (ALIGN_EPI) { if (wr == 1) PG8_BAR; }
    }
    PG8_WAIT_V(0);
    if constexpr (!ALIGN_EPI) { if (wr == 0) PG8_BAR; }
    PG8_BAR;
    if constexpr (Epi::AFTER_DRAIN) { E.fused(acc, cur, wr, wc, fr, fq, lds, wid, lane); S.done(cur); }
#undef PG8_SA
#undef PG8_SB
#undef PG8_STAGE
#undef PG8_LDA
#undef PG8_LDB
#undef PG8_MMA
#undef PG8_WAIT_V
#undef PG8_WAIT_L
#undef PG8_BAR
#undef PG8_SCHED
}
}

#define GAS __attribute__((address_space(1)))
#define LAS __attribute__((address_space(3)))
typedef unsigned short bf16;
typedef unsigned u32x4 __attribute__((ext_vector_type(4)));
typedef unsigned u32x2 __attribute__((ext_vector_type(2)));
typedef float f32x4 __attribute__((ext_vector_type(4)));
typedef float f32x16 __attribute__((ext_vector_type(16)));
typedef short bf16x8 __attribute__((ext_vector_type(8)));
typedef GAS unsigned gu32;
#define RLX_AGENT __ATOMIC_RELAXED, __HIP_MEMORY_SCOPE_AGENT

#ifndef DBG
#define DBG 0
#endif
#ifndef N_LAUNCH_SPLIT
#define N_LAUNCH_SPLIT 0
#endif

constexpr int NB = 16, SL = 2048, T = NB * SL, D = 1024, ML = 256, MT = NB * ML;
constexpr int FF = 2816, FE = 3584, NE = 8, RMAXT = 264;
constexpr float EPS = 1e-6f, LOG2E = 1.4426950408889634f, INV_2PI = 0.15915494309189535f;
constexpr int NWAVES = 8, NTHR = 512;

constexpr size_t MiB = 1u << 20;
constexpr size_t WS_CTL = 0, CTL_BYTES = 1 * MiB;
constexpr size_t WS_WQ = 1 * MiB;
constexpr size_t WS_WO = WS_WQ + 8 * MiB;
constexpr size_t WS_WK = WS_WO + 8 * MiB;
constexpr size_t WS_WV = WS_WK + 8 * MiB;
constexpr size_t WS_EV = WS_WV + 8 * MiB;
constexpr size_t EV_STRIDE = 27 * MiB, EV_INN = 0, EV_INS = 6 * MiB, EV_OUT = 8 * MiB, EV_GU = 10 * MiB, EV_DN = 21 * MiB;
constexpr size_t WS_OD = WS_EV + 2 * EV_STRIDE;
constexpr size_t OD_STRIDE = 8 * MiB, OD_INN = 0, OD_INS = 4 * MiB, OD_OUT = 6 * MiB;
constexpr size_t WS_MOE = WS_OD + 2 * OD_STRIDE;
constexpr size_t MOE_STRIDE = 84 * MiB, MOE_DN = 56 * MiB;
constexpr float MOE_WSCALE = 64.f, MOE_HSCALE = 4.f;
constexpr size_t WS_XB = WS_MOE + 168 * MiB;
constexpr size_t WS_SSQ = WS_XB + 64 * MiB;
constexpr size_t WS_MEMN = WS_SSQ + 2 * MiB;
constexpr size_t WS_KX = WS_MEMN + 8 * MiB;
constexpr size_t WS_VTX = WS_KX + 32 * MiB;
constexpr size_t WS_MISC = WS_VTX + 32 * MiB;
constexpr size_t MISC_LIST = 0, MISC_YROW = 1 * MiB, MISC_GATE = MISC_YROW + 256 * 1024, MISC_EPOS = MISC_GATE + 256 * 1024, MISC_RSS = MISC_EPOS + 256 * 1024;
constexpr size_t WS_ACT = WS_MISC + 3 * MiB;
constexpr size_t A_PE = 0, A_VTE = 256 * MiB, A_R = 352 * MiB;
constexpr int PEW = 4096;
constexpr size_t A_QK = 0, A_VTD = 128 * MiB, A_AO = 192 * MiB;
constexpr int QKP = 2048, VTP = T;
constexpr size_t A_QX = 0, A_OX = 64 * MiB;
constexpr size_t A_H = 0, A_XB8 = 432 * MiB;
constexpr size_t A_XS = 0, A_HID = 66 * MiB, A_Y = 297 * MiB;
constexpr size_t ACT_BYTES = 495 * MiB, WS_END = WS_ACT + ACT_BYTES;
constexpr int CW_TMO = 0, CW_BAR = 4096, CW_CNT = 8192  , CW_CHK = 16384  , CHK_NSTAGE = 96;
constexpr int PH_BYTES = 135168, LDSCTL_OFF = PH_BYTES, LDS_BYTES = PH_BYTES + 1024;

__device__ __forceinline__ float bf2f(bf16 b) { return __builtin_bit_cast(float, (unsigned)b << 16); }
__device__ __forceinline__ unsigned f2bf(float f) { unsigned u = __builtin_bit_cast(unsigned, f); return (u + 0x7fffu + ((u >> 16) & 1u)) >> 16; }
__device__ __forceinline__ unsigned pk2(float lo, float hi) { return f2bf(lo) | (f2bf(hi) << 16); }
__device__ __forceinline__ int crow(int r, int hi) { return (r & 3) + 8 * (r >> 2) + 4 * hi; }
#define LDS_WAIT() asm volatile("s_waitcnt lgkmcnt(0)" ::: "memory")
#define VM_WAIT() asm volatile("s_waitcnt vmcnt(0)" ::: "memory")
__device__ __forceinline__ float wave_sum(float v) {
#pragma unroll
    for (int o = 1; o < 64; o <<= 1) v += __shfl_xor(v, o);
    return v;
}
__device__ __forceinline__ float wave_max(float v) {
#pragma unroll
    for (int o = 1; o < 64; o <<= 1) v = fmaxf(v, __shfl_xor(v, o));
    return v;
}
#define MFMA32(a, b, c) __builtin_amdgcn_mfma_f32_32x32x16_bf16((a), (b), (c), 0, 0, 0)
__device__ __forceinline__ bf16x8 pack_frag(float a0, float a1, float a2, float a3, float a4, float a5, float a6, float a7) {
    u32x4 w; w.x = pg8::cvt_pk_bf16(a0, a1); w.y = pg8::cvt_pk_bf16(a2, a3); w.z = pg8::cvt_pk_bf16(a4, a5); w.w = pg8::cvt_pk_bf16(a6, a7); return __builtin_bit_cast(bf16x8, w);
}
__device__ __forceinline__ bf16x8 join8(u32x2 lo, u32x2 hi) { u32x4 w; w.x = lo.x; w.y = lo.y; w.z = hi.x; w.w = hi.y; return __builtin_bit_cast(bf16x8, w); }

struct Args {
    const float* x; const float* mem; const int* pos; const float* mem_g; const float* fin_g; const float* mix_g; const float* xa_g; const float* ffn_g;
    const float* xa_wq; const float* xa_wkv; const float* xa_wo; const float* ev_w_in; const float* ev_conv; const float* ev_df; const float* ev_db; const float* ev_gn;
    const float* ev_w_out; const float* ffd_g; const float* ffd_u; const float* ffd_d; const float* od_w_in; const float* lq1; const float* lk1; const float* lq2; const float* lk2;
    const float* od_gn; const float* od_w_out; const float* router; const float* moe_g; const float* moe_u; const float* moe_d;
    float* out; unsigned char* ws; int ph_lo, ph_hi;
};
struct Frame {
    LAS unsigned char* lds; gu32* ctl; unsigned char* ws; int tid, lane, wave, G, bid;
};
#define XB_TMO      128
#define XB_XCNT(j)  (256  + 64 * (j))
#define XB_XSUB(j)  (1280 + 64 * (j))
#define XB_XGEN(j)  (2304 + 64 * (j))
#define XB_TOP      3328
#define XB_TOPGEN   3392
#define XCD_BAR_WORDS 3456
#define XB_SPIN_CAP (1u << 18)

__device__ __forceinline__ unsigned xb_ld(unsigned* p)              { return __hip_atomic_load(p, __ATOMIC_RELAXED, __HIP_MEMORY_SCOPE_AGENT); }
__device__ __forceinline__ unsigned xb_add(unsigned* p, unsigned v) { return __hip_atomic_fetch_add(p, v, __ATOMIC_RELAXED, __HIP_MEMORY_SCOPE_AGENT); }
__device__ __forceinline__ unsigned xb_xcc_id() { return (unsigned)__builtin_amdgcn_s_getreg((3 << 11) | 20) & 0xFu; }
#define XB_SPIN(cond, bar) do { unsigned _sp = 0; while (cond) { __builtin_amdgcn_s_sleep(1); \
    if ((++_sp & 255u) == 0u) { if (xb_ld(&(bar)[XB_TMO])) break; if (_sp > XB_SPIN_CAP) { atomicAdd(&(bar)[XB_TMO], 1u); break; } } } } while (0)

struct XcdBarrier {
    unsigned* bar; unsigned x;
    bool t0;
    volatile LAS unsigned* st;
};

__device__ __forceinline__ XcdBarrier xcd_barrier_post(unsigned* bar, volatile LAS unsigned* st) {
    XcdBarrier b; b.bar = bar; b.x = xb_xcc_id(); b.st = st; b.t0 = (threadIdx.x == 0);
    if (threadIdx.x == 0) (void)xb_add(&bar[XB_XCNT(b.x)], 1u);
    return b;
}
__device__ __forceinline__ void xcd_barrier_complete(unsigned* bar, unsigned x, unsigned& nloc, unsigned& nx) {
    const unsigned G = gridDim.x * gridDim.y * gridDim.z;
    unsigned sum, cnt, mine, sp = 0u;
    for (;;) {
        sum = 0u; cnt = 0u; mine = 0u;
#pragma unroll
        for (unsigned j = 0; j < 16; ++j) { const unsigned c = xb_ld(&bar[XB_XCNT(j)]); sum += c; cnt += (c > 0u) ? 1u : 0u; mine = (j == x) ? c : mine; }
        if (sum == G) break;
        __builtin_amdgcn_s_sleep(1);
        if ((++sp & 255u) == 0u) { if (xb_ld(&bar[XB_TMO])) break; if (sp > XB_SPIN_CAP) { atomicAdd(&bar[XB_TMO], 1u); break; } }
    }
    nloc = mine > 0u ? mine : 1u; nx = cnt > 0u ? cnt : 1u;
}

__device__ __forceinline__ void xcd_barrier(const XcdBarrier& b) {
    asm volatile("s_waitcnt vmcnt(0)" ::: "memory");
    __syncthreads();
    if (b.t0) {
        unsigned* bar = b.bar;
        __builtin_amdgcn_s_waitcnt(0);
        unsigned nloc = b.st[0], nx = b.st[1];
        if (nloc == 0u) { xcd_barrier_complete(bar, b.x, nloc, nx); b.st[0] = nloc; b.st[1] = nx; }
        const unsigned old = xb_add(&bar[XB_XSUB(b.x)], 1u);
        const unsigned gen = old / nloc;
        if (old + 1u == (gen + 1u) * nloc) {
            __builtin_amdgcn_fence(__ATOMIC_RELEASE, "agent");
            asm volatile("s_waitcnt vmcnt(0)" ::: "memory");
            const unsigned og = xb_add(&bar[XB_TOP], 1u);
            const unsigned tg = og / nx;
            if (og + 1u == (tg + 1u) * nx) xb_add(&bar[XB_TOPGEN], 1u);
            else XB_SPIN(xb_ld(&bar[XB_TOPGEN]) == tg, bar);
            __builtin_amdgcn_fence(__ATOMIC_ACQUIRE, "agent");
            xb_add(&bar[XB_XGEN(b.x)], 1u);
            asm volatile("s_waitcnt vmcnt(0)" ::: "memory");
        } else {
            XB_SPIN(xb_ld(&bar[XB_XGEN(b.x)]) == gen, bar);
            __builtin_amdgcn_fence(__ATOMIC_ACQUIRE, "agent");
            asm volatile("s_waitcnt vmcnt(0)" ::: "memory");
        }
    }
    __syncthreads();
}

template <bool F8W = false> __device__ __forceinline__ void tr_item(const float* W0, const float* W1, int ldw, int K, int cm, int coff, const float* gk, bf16* WT, int item, int nblk, LAS float* scr, int lane, float wsc = 1.f) {
    const int kb = item / nblk, nb = item % nblk, k0 = 64 * kb, n0 = 64 * nb;
    const int np = n0 + 4 * (lane & 15);
    const float* W = W0; int sc;
    if (cm == 0) sc = np + coff;
    else if (cm == 1) { if (np < 1536) sc = np; else if (np < 2560) { const int c = np & 63, g = c >> 3, s = c & 7; sc = (np & ~63) + ((s < 4) ? 4 * g + s : 32 + 4 * g + (s - 4)); } else sc = np + 512; }
    else if (cm == 2) { const int c = np & 63; if (c < 16) { const int g = c >> 3, s = c & 7; sc = (np & ~63) + ((s < 4) ? 4 * g + s : 8 + 4 * g + (s - 4)); } else sc = np; }
    else { const int t = np >> 8, r = np & 255; if (r < 128) sc = 128 * t + r; else { sc = 128 * t + r - 128; W = W1; } }
#pragma unroll 4
    for (int i = 0; i < 16; ++i) { const int kk = 4 * i + (lane >> 4); const f32x4 v = *(const f32x4*)(W + (size_t)(k0 + kk) * ldw + sc); const float g = (gk ? gk[k0 + kk] : 1.f) * wsc;
        LAS float* d = scr + kk * 65 + 4 * (lane & 15); d[0] = v[0] * g; d[1] = v[1] * g; d[2] = v[2] * g; d[3] = v[3] * g; }
    LDS_WAIT(); asm volatile("" ::: "memory");
    const int c = lane & 7;
#pragma unroll
    for (int j = 0; j < 8; ++j) { const int n = (lane >> 3) + 8 * j; const LAS float* s = scr + (8 * c) * 65 + n;
        if constexpr (F8W) { u32x2 o; o.x = pg8::pack_fp8x4(s[0 * 65], s[1 * 65], s[2 * 65], s[3 * 65]); o.y = pg8::pack_fp8x4(s[4 * 65], s[5 * 65], s[6 * 65], s[7 * 65]);
            *(u32x2*)((unsigned char*)WT + (size_t)(n0 + n) * K + k0 + 8 * c) = o; }
        else { u32x4 o; o.x = pk2(s[0 * 65], s[1 * 65]); o.y = pk2(s[2 * 65], s[3 * 65]); o.z = pk2(s[4 * 65], s[5 * 65]); o.w = pk2(s[6 * 65], s[7 * 65]);
            *(u32x4*)(WT + (size_t)(n0 + n) * K + k0 + 8 * c) = o; } }
    LDS_WAIT(); asm volatile("" ::: "memory");
}
#define TRMAT(W0_, W1_, ldw_, K_, N_, cm_, coff_, gk_, WT_) do { const int nblk_ = (N_) / 64, ni_ = ((K_) / 64) * nblk_; \
    for (int it_ = (int)(((long)gw - ib + (long)NGW * 1024) % NGW); it_ < ni_; it_ += NGW) tr_item((W0_), (W1_), (ldw_), (K_), (cm_), (coff_), (gk_), (WT_), it_, nblk_, scr, F.lane); \
    ib = (ib + ni_) % NGW; } while (0)
#define TRMAT8(W0_, W1_, ldw_, K_, N_, cm_, coff_, gk_, WT_) do { const int nblk_ = (N_) / 64, ni_ = ((K_) / 64) * nblk_; \
    for (int it_ = (int)(((long)gw - ib + (long)NGW * 1024) % NGW); it_ < ni_; it_ += NGW) tr_item<true>((W0_), (W1_), (ldw_), (K_), (cm_), (coff_), (gk_), (bf16*)(WT_), it_, nblk_, scr, F.lane, MOE_WSCALE); \
    ib = (ib + ni_) % NGW; } while (0)

__device__ __forceinline__ void moe_convert(Frame& F, const Args& A, int j) {
    LAS float* scr = (LAS float*)(F.lds) + F.wave * (64 * 65);
    const int gw = F.bid * NWAVES + F.wave, NGW = F.G * NWAVES; long ib = 0;
    unsigned char* gu = F.ws + WS_MOE + (size_t)j * MOE_STRIDE; unsigned char* dn = gu + MOE_DN;
    for (int e = 0; e < NE; ++e) {
        const size_t wo = ((size_t)j * NE + e) * (size_t)D * FE;
        TRMAT8(A.moe_g + wo, A.moe_u + wo, FE, D, 2 * FE, 3, 0, A.ffn_g + (2 * j + 1) * D, gu + (size_t)e * 2 * FE * D);
        TRMAT8(A.moe_d + wo, nullptr, D, FE, D, 0, 0, nullptr, dn + (size_t)e * D * FE);
    }
}

__device__ __forceinline__ void prologue_phase(Frame& F, const Args& A) {
    LAS float* scr = (LAS float*)(F.lds) + F.wave * (64 * 65);
    const int gw = F.bid * NWAVES + F.wave, NGW = F.G * NWAVES; long ib = 0;
    { const bool h5 = (F.lane & 32) != 0, h4 = (F.lane & 16) != 0;
      for (int m0 = 4 * gw; m0 < T; m0 += 4 * NGW) {
        f32x4 v[4][4]; float sq[4];
#pragma unroll
        for (int s = 0; s < 4; ++s) { const f32x4* xr = (const f32x4*)(A.x + (size_t)(m0 + s) * D) + F.lane;
#pragma unroll
            for (int q = 0; q < 4; ++q) v[s][q] = xr[64 * q]; }
#pragma unroll
        for (int s = 0; s < 4; ++s) { sq[s] = 0.f;
#pragma unroll
            for (int q = 0; q < 4; ++q) {
#pragma unroll
                for (int e = 0; e < 4; ++e) v[s][q][e] = bf2f((bf16)f2bf(v[s][q][e]));
                sq[s] += (v[s][q][0] * v[s][q][0] + v[s][q][1] * v[s][q][1]) + (v[s][q][2] * v[s][q][2] + v[s][q][3] * v[s][q][3]); } }
        const float t0 = (h5 ? sq[2] : sq[0]) + __shfl_xor(h5 ? sq[0] : sq[2], 32), t1 = (h5 ? sq[3] : sq[1]) + __shfl_xor(h5 ? sq[1] : sq[3], 32);
        float tt = (h4 ? t1 : t0) + __shfl_xor(h4 ? t0 : t1, 16);
        tt += __shfl_xor(tt, 8); tt += __shfl_xor(tt, 4); tt += __shfl_xor(tt, 2); tt += __shfl_xor(tt, 1);
#pragma unroll
        for (int s = 0; s < 4; ++s) { const int m = m0 + s; const float ssum = __builtin_bit_cast(float, __builtin_amdgcn_readlane(__builtin_bit_cast(int, tt), 16 * s));
            u32x2* brow = (u32x2*)((bf16*)(F.ws + WS_XB) + (size_t)m * D) + F.lane;
#pragma unroll
            for (int q = 0; q < 4; ++q) { u32x2 w; w.x = pk2(v[s][q][0], v[s][q][1]); w.y = pk2(v[s][q][2], v[s][q][3]); brow[64 * q] = w; }
            if (F.lane < 16) ((float*)(F.ws + WS_SSQ))[(size_t)m * 16 + F.lane] = (F.lane == 0) ? ssum : 0.f; }
      } }
    for (int m = gw; m < MT; m += NGW) {
        const f32x4* xr = (const f32x4*)(A.mem + (size_t)m * D) + F.lane; const f32x4* gr = (const f32x4*)A.mem_g + F.lane; f32x4 v[4]; float s = 0.f;
#pragma unroll
        for (int q = 0; q < 4; ++q) { v[q] = xr[64 * q]; s += (v[q][0] * v[q][0] + v[q][1] * v[q][1]) + (v[q][2] * v[q][2] + v[q][3] * v[q][3]); }
        const float rs = rsqrtf(wave_sum(s) * (1.f / D) + EPS);
        u32x2* brow = (u32x2*)((bf16*)(F.ws + WS_MEMN) + (size_t)m * D) + F.lane;
#pragma unroll
        for (int q = 0; q < 4; ++q) { const f32x4 g = gr[64 * q]; u32x2 w; w.x = pk2(v[q][0] * rs * g[0], v[q][1] * rs * g[1]); w.y = pk2(v[q][2] * rs * g[2], v[q][3] * rs * g[3]); brow[64 * q] = w; }
    }
    for (int l = 0; l < 4; ++l) {
        TRMAT8(A.xa_wq + (size_t)l * D * D, nullptr, D, D, D, 0, 0, A.xa_g + l * D, F.ws + WS_WQ + (size_t)l * D * D);
        TRMAT8(A.xa_wo + (size_t)l * D * D, nullptr, D, D, D, 0, 0, nullptr, F.ws + WS_WO + (size_t)l * D * D);
        TRMAT(A.xa_wkv + (size_t)l * D * 2 * D, nullptr, 2 * D, D, D, 0, 0, nullptr, (bf16*)(F.ws + WS_WK) + (size_t)l * D * D);
        TRMAT(A.xa_wkv + (size_t)l * D * 2 * D, nullptr, 2 * D, D, D, 0, D, nullptr, (bf16*)(F.ws + WS_WV) + (size_t)l * D * D);
    }
    for (int j = 0; j < 2; ++j) {
        unsigned char* eb = F.ws + WS_EV + j * EV_STRIDE; const float* win = A.ev_w_in + (size_t)j * D * 3584;
        TRMAT(win, nullptr, 3584, D, 3072, 1, 0, A.mix_g + (2 * j) * D, (bf16*)(eb + EV_INN));
        TRMAT(win, nullptr, 3584, D, 512, 0, 2560, A.mix_g + (2 * j) * D, (bf16*)(eb + EV_INS));
        TRMAT(A.ev_w_out + (size_t)j * D * D, nullptr, D, D, D, 0, 0, nullptr, (bf16*)(eb + EV_OUT));
        TRMAT8(A.ffd_g + (size_t)j * D * FF, A.ffd_u + (size_t)j * D * FF, FF, D, 2 * FF, 3, 0, A.ffn_g + (2 * j) * D, eb + EV_GU);
        TRMAT8(A.ffd_d + (size_t)j * FF * D, nullptr, D, FF, D, 0, 0, nullptr, eb + EV_DN);
        unsigned char* ob = F.ws + WS_OD + j * OD_STRIDE; const float* oin = A.od_w_in + (size_t)j * D * 3072;
        TRMAT(oin, nullptr, 3072, D, 2048, 2, 0, A.mix_g + (2 * j + 1) * D, (bf16*)(ob + OD_INN));
        TRMAT(oin, nullptr, 3072, D, 1024, 0, 2048, A.mix_g + (2 * j + 1) * D, (bf16*)(ob + OD_INS));
        TRMAT(A.od_w_out + (size_t)j * D * D, nullptr, D, D, D, 0, 0, nullptr, (bf16*)(ob + OD_OUT));
    }
}

__device__ __forceinline__ void fret_phase(Frame& F, const Args& A, int j) {
    const bf16* PE = (const bf16*)(F.ws + WS_ACT + A_PE); bf16* R = (bf16*)(F.ws + WS_ACT + A_R); const bf16* VT = (const bf16*)(F.ws + WS_ACT + A_VTE);
    { const float* cw = A.ev_conv + (size_t)j * 3 * 512;
      const int c0 = (F.tid & 63) * 8;
      float cwv[3][8];
#pragma unroll
      for (int d = 0; d < 3; ++d) { const f32x4 a = *(const f32x4*)(cw + d * 512 + c0), bq = *(const f32x4*)(cw + d * 512 + c0 + 4);
#pragma unroll
          for (int e = 0; e < 4; ++e) { cwv[d][e] = a[e]; cwv[d][4 + e] = bq[e]; } }
      const int tstr = (F.G * NTHR) >> 6;
      for (int t0 = (F.bid * NTHR + F.tid) >> 6; t0 < T; t0 += 4 * tstr) {
        bf16x8 gcv[4][3], hcv[4][3], gbv[4];
#pragma unroll
        for (int s = 0; s < 4; ++s) { const int t = t0 + s * tstr; const bool tv = t < T; const int l = t & (SL - 1); const bf16* row = PE + (size_t)(tv ? t : 0) * PEW;
#pragma unroll
            for (int d = 0; d < 3; ++d) { const bool ok = tv && ((d == 0) ? (l > 0) : (d == 2) ? (l < SL - 1) : true); const bf16* rr = row + (ok ? (d - 1) * PEW : 0);
                gcv[s][d] = *(const bf16x8*)(rr + 512 + c0); hcv[s][d] = *(const bf16x8*)(rr + 1024 + c0); }
            gbv[s] = *(const bf16x8*)(row + c0); }
#pragma unroll
        for (int s = 0; s < 4; ++s) { const int t = t0 + s * tstr; if (t < T) { const int l = t & (SL - 1); float o[8];
#pragma unroll
            for (int e = 0; e < 8; ++e) { float acc = cwv[1][e] * (bf2f((bf16)gcv[s][1][e]) * bf2f((bf16)hcv[s][1][e]));
                if (l > 0) acc += cwv[0][e] * (bf2f((bf16)gcv[s][0][e]) * bf2f((bf16)hcv[s][0][e]));
                if (l < SL - 1) acc += cwv[2][e] * (bf2f((bf16)gcv[s][2][e]) * bf2f((bf16)hcv[s][2][e]));
                o[e] = bf2f((bf16)gbv[s][e]) * acc; }
            u32x4 wq; wq.x = pk2(o[0], o[1]); wq.y = pk2(o[2], o[3]); wq.z = pk2(o[4], o[5]); wq.w = pk2(o[6], o[7]);
            *(u32x4*)(R + (size_t)t * 1024 + c0) = wq; } } } }
    const int w = F.wave, lane = F.lane, r = lane & 31, hh = lane >> 5, tid = F.tid;
    LAS unsigned char* lds = F.lds;
    const float* gng = A.ev_gn + j * 512;
    const int srow = tid >> 3, sch = tid & 7;
    const int kfo = r * 144 + 16 * hh;
    const int vfo = 36864 + r * 144 + 16 * hh;
    const int sto = srow * 144 + sch * 16;
    const int stv = 36864 + srow * 144 + (sch >> 1) * 32 + (sch & 1) * 8;
    LAS float* gnl = (LAS float*)(lds + 57344);
    if (tid < 128) *(LAS f32x4*)(gnl + 4 * tid) = *(const f32x4*)(gng + 4 * tid);
    const unsigned kof = (unsigned)(srow * PEW + sch * 8) * 2u, vof = (unsigned)(srow * T + sch * 8) * 2u;
    int u = F.bid; if (u >= 1024) { __syncthreads(); return; }
    int b = u >> 6, h = (u >> 3) & 7, qt = u & 7; size_t tok0 = (size_t)b * SL + 256 * qt, kb = (size_t)b * SL;
    bf16x8 qff[4], qfb[4]; u32x4 rk0, rk1, rv0, rk2, rk3, rv1;
    const char* kbase = (const char*)(PE + kb * PEW + 2048 + h * 64); const char* vbase = (const char*)(VT + (size_t)(h * 64) * T + kb);
    { const bf16* qp = PE + (tok0 + 32 * w + r) * PEW + h * 64 + 8 * hh;
#pragma unroll
      for (int s = 0; s < 4; ++s) { qff[s] = *(const bf16x8*)(qp + 1536 + 16 * s); qfb[s] = *(const bf16x8*)(qp + 3072 + 16 * s); }
      rk0 = *(const u32x4*)(kbase + kof); rk1 = *(const u32x4*)(kbase + kof + 3072); rv0 = *(const u32x4*)(vbase + vof);
      rk2 = *(const u32x4*)(kbase + (size_t)(64 * PEW * 2) + kof); rk3 = *(const u32x4*)(kbase + (size_t)(64 * PEW * 2) + kof + 3072); rv1 = *(const u32x4*)(vbase + 128 + vof); }
    for (;;) {
        const float lgf = __builtin_bit_cast(float, __builtin_amdgcn_readfirstlane(__builtin_bit_cast(int, -__expf(A.ev_df[j * 8 + h]) * LOG2E))), lgb = __builtin_bit_cast(float, __builtin_amdgcn_readfirstlane(__builtin_bit_cast(int, -__expf(A.ev_db[j * 8 + h]) * LOG2E)));
        const int nw0 = 256 * qt + 32 * w, tmix = nw0 >> 6;
#define FR_LDK(t) do { const char* kt_ = kbase + (size_t)(t) * (64 * PEW * 2); rk0 = *(const u32x4*)(kt_ + kof); rk1 = *(const u32x4*)(kt_ + kof + 3072); } while (0)
#define FR_LDV(t) do { rv0 = *(const u32x4*)(vbase + (size_t)(t) * 128 + vof); } while (0)
#define FR_STK(bf) do { *(LAS u32x4*)(lds + (bf) * 18432 + sto) = rk0; *(LAS u32x4*)(lds + (bf) * 18432 + 9216 + sto) = rk1; } while (0)
#define FR_STV(bf) do { LAS unsigned char* vd_ = lds + (bf) * 9216 + stv; *(LAS u32x2*)(vd_) = (u32x2){rv0.x, rv0.y}; *(LAS u32x2*)(vd_ + 16) = (u32x2){rv0.z, rv0.w}; } while (0)
#define FR_KF(kbn, cb, kt2, s) (*(const LAS bf16x8*)(lds + (kbn) * 18432 + (cb) * 9216 + kfo + (kt2) * 4608 + 32 * (s)))
#define FR_VF(vbc, dvt, k2, s2) (*(const LAS bf16x8*)(lds + (vbc) * 9216 + vfo + 4608 * (dvt) + 64 * (k2) + 32 * (s2)))
#define FR_QKH(N, NC, tt, kbn, kt2) do { const int m0_ = 64 * (tt); N = zero16; \
        if ((tt) < tmix) { _Pragma("unroll") for (int s = 0; s < 4; ++s) N = MFMA32(FR_KF(kbn, 0, kt2, s), qff[s], N); NC = __builtin_amdgcn_exp2f(lgf * (float)(nw0 - m0_)); } \
        else if ((tt) > tmix) { _Pragma("unroll") for (int s = 0; s < 4; ++s) N = MFMA32(FR_KF(kbn, 1, kt2, s), qfb[s], N); NC = __builtin_amdgcn_exp2f(lgb * (float)(m0_ - nw0)); } \
        else { f32x16 b_ = zero16; \
            _Pragma("unroll") for (int s = 0; s < 4; ++s) { N = MFMA32(FR_KF(kbn, 0, kt2, s), qff[s], N); b_ = MFMA32(FR_KF(kbn, 1, kt2, s), qfb[s], b_); } \
            const float cf_ = __builtin_amdgcn_exp2f(lgf * (float)(nw0 - m0_)), cb_ = __builtin_amdgcn_exp2f(lgb * (float)(m0_ - nw0)); const int n_ = nw0 + r; \
            _Pragma("unroll") for (int q = 0; q < 16; ++q) { const int m_ = m0_ + 32 * (kt2) + crow(q, hh); N[q] = (m_ <= n_) ? N[q] * cf_ : b_[q] * cb_; } \
            NC = 1.f; } } while (0)
#define FR_PACK(P, B, c) pack_frag(P[B] * (c), P[B + 1] * (c), P[B + 2] * (c), P[B + 3] * (c), P[B + 4] * (c), P[B + 5] * (c), P[B + 6] * (c), P[B + 7] * (c))
        FR_STK(0); FR_STV(0); rk0 = rk2; rk1 = rk3; rv0 = rv1;
        __syncthreads();
        const f32x16 zero16 = {};
        f32x16 o[2] = {{}, {}};
#pragma unroll 1
        for (int t = 0; t < 32; ++t) { const int bc = t & 1;
            if (t + 1 < 32) { FR_STK(bc ^ 1); FR_STV(bc ^ 1); }
            if (t + 2 < 32) { FR_LDK(t + 2); FR_LDV(t + 2); }
            f32x16 s0_, s1_; float c0_, c1_;
            if (__builtin_expect(t != tmix, 1)) { const bool below_ = t < tmix; const int cbo_ = below_ ? 0 : 9216; s0_ = zero16; s1_ = zero16;
#pragma unroll
                for (int s = 0; s < 4; ++s) { const bf16x8 qs_ = below_ ? qff[s] : qfb[s];
                    s0_ = MFMA32(*(const LAS bf16x8*)(lds + bc * 18432 + cbo_ + kfo + 32 * s), qs_, s0_); s1_ = MFMA32(*(const LAS bf16x8*)(lds + bc * 18432 + cbo_ + kfo + 4608 + 32 * s), qs_, s1_); }
                c0_ = below_ ? __builtin_amdgcn_exp2f(lgf * (float)(nw0 - 64 * t)) : __builtin_amdgcn_exp2f(lgb * (float)(64 * t - nw0)); c1_ = c0_; }
            else { FR_QKH(s0_, c0_, t, bc, 0); FR_QKH(s1_, c1_, t, bc, 1); }
            const bf16x8 p0l = FR_PACK(s0_, 0, c0_), p0h = FR_PACK(s0_, 8, c0_), p1l = FR_PACK(s1_, 0, c1_), p1h = FR_PACK(s1_, 8, c1_);
            o[0] = MFMA32(FR_VF(bc, 0, 0, 0), p0l, o[0]); o[1] = MFMA32(FR_VF(bc, 1, 0, 0), p0l, o[1]); o[0] = MFMA32(FR_VF(bc, 0, 0, 1), p0h, o[0]); o[1] = MFMA32(FR_VF(bc, 1, 0, 1), p0h, o[1]);
            o[0] = MFMA32(FR_VF(bc, 0, 1, 0), p1l, o[0]); o[1] = MFMA32(FR_VF(bc, 1, 1, 0), p1l, o[1]); o[0] = MFMA32(FR_VF(bc, 0, 1, 1), p1h, o[0]); o[1] = MFMA32(FR_VF(bc, 1, 1, 1), p1h, o[1]);
            __syncthreads(); }
#undef FR_QKH
#undef FR_PACK
#undef FR_VF
#undef FR_KF
#undef FR_STV
#undef FR_STK
#undef FR_LDV
#undef FR_LDK
        const size_t tok = tok0 + 32 * w + r;
        u32x2 gwl[2][4];
#pragma unroll
        for (int dvt = 0; dvt < 2; ++dvt)
#pragma unroll
            for (int q4 = 0; q4 < 4; ++q4) gwl[dvt][q4] = *(const u32x2*)(PE + tok * PEW + 2560 + h * 64 + 32 * dvt + 8 * q4 + 4 * hh);
        const int un = u + F.G; const bool has_next = un < 1024;
        const int nb = un >> 6, nh = (un >> 3) & 7, nqt = un & 7; const size_t ntok0 = (size_t)nb * SL + 256 * nqt, nkb = (size_t)nb * SL;
        const char* nkbase = (const char*)(PE + nkb * PEW + 2048 + nh * 64); const char* nvbase = (const char*)(VT + (size_t)(nh * 64) * T + nkb);
        if (has_next) { const bf16* qp = PE + (ntok0 + 32 * w + r) * PEW + nh * 64 + 8 * hh;
#pragma unroll
            for (int s = 0; s < 4; ++s) { qff[s] = *(const bf16x8*)(qp + 1536 + 16 * s); qfb[s] = *(const bf16x8*)(qp + 3072 + 16 * s); }
            rk0 = *(const u32x4*)(nkbase + kof); rk1 = *(const u32x4*)(nkbase + kof + 3072); rv0 = *(const u32x4*)(nvbase + vof);
            rk2 = *(const u32x4*)(nkbase + (size_t)(64 * PEW * 2) + kof); rk3 = *(const u32x4*)(nkbase + (size_t)(64 * PEW * 2) + kof + 3072); rv1 = *(const u32x4*)(nvbase + 128 + vof); }
        float ss = 0.f;
#pragma unroll
        for (int dvt = 0; dvt < 2; ++dvt)
#pragma unroll
            for (int q = 0; q < 16; ++q) ss += o[dvt][q] * o[dvt][q];
        ss += __shfl_xor(ss, 32); const float rms = rsqrtf(ss * (1.f / 64.f) + EPS);
#pragma unroll
        for (int dvt = 0; dvt < 2; ++dvt)
#pragma unroll
            for (int q4 = 0; q4 < 4; ++q4) { const int dv0 = 32 * dvt + 8 * q4 + 4 * hh;
                const u32x2 gwv = gwl[dvt][q4]; const f32x4 gn = *(const LAS f32x4*)(gnl + h * 64 + dv0);
                const float gg[4] = {__builtin_bit_cast(float, gwv.x << 16), __builtin_bit_cast(float, gwv.x & 0xffff0000u), __builtin_bit_cast(float, gwv.y << 16), __builtin_bit_cast(float, gwv.y & 0xffff0000u)}; float ov[4];
#pragma unroll
                for (int e = 0; e < 4; ++e) ov[e] = o[dvt][4 * q4 + e] * rms * gn[e] * gg[e] * __builtin_amdgcn_rcpf(1.f + __builtin_amdgcn_exp2f(-gg[e] * LOG2E));
                u32x2 wv; wv.x = pk2(ov[0], ov[1]); wv.y = pk2(ov[2], ov[3]); *(u32x2*)(R + tok * 1024 + 512 + h * 64 + dv0) = wv; }
        if (!has_next) break;
        u = un; b = nb; h = nh; qt = nqt; tok0 = ntok0; kb = nkb; kbase = nkbase; vbase = nvbase;
    }
}

__device__ __forceinline__ void xattn_phase(Frame& F, int l) {
    const bf16* Q = (const bf16*)(F.ws + WS_ACT + A_QX); bf16* OX = (bf16*)(F.ws + WS_ACT + A_OX);
    const bf16* KX = (const bf16*)(F.ws + WS_KX); const bf16* VTX = (const bf16*)(F.ws + WS_VTX);
    const int w = F.wave, lane = F.lane, r = lane & 31, hh = lane >> 5, tid = F.tid;
    LAS unsigned char* lds = F.lds;
    for (int u = F.bid; u < 512; u += F.G) { const int b = u >> 5, hd = (u >> 3) & 3, qt = u & 7; const size_t tok0 = (size_t)b * SL + 256 * qt;
        { const bf16* src = KX + (size_t)(b * 256) * 4096 + l * 1024 + hd * 256;
          u32x4 stg[16];
#pragma unroll
          for (int i = 0; i < 16; ++i) { const int idx = tid + 512 * i, m = idx >> 5, ch = idx & 31; stg[i] = *(const u32x4*)(src + (size_t)m * 4096 + ch * 8); }
#pragma unroll
          for (int i = 0; i < 16; ++i) { const int idx = tid + 512 * i, m = idx >> 5, ch = idx & 31; *(LAS u32x4*)(lds + m * 528 + ch * 16) = stg[i]; } }
        const bf16* qp = Q + (tok0 + 32 * w + r) * 1024 + hd * 256 + 8 * hh; bf16x8 qa[4], qb[4];
#pragma unroll
        for (int s = 0; s < 4; ++s) qa[s] = *(const bf16x8*)(qp + 16 * s);
        __syncthreads();
        f32x16 st[8];
#pragma unroll
        for (int mt = 0; mt < 8; ++mt) st[mt] = (f32x16){};
#pragma unroll
        for (int sg = 0; sg < 4; ++sg) {
            if (sg < 3) {
#pragma unroll
                for (int s = 0; s < 4; ++s) qb[s] = *(const bf16x8*)(qp + 16 * (4 * (sg + 1) + s)); }
#pragma unroll
            for (int s = 0; s < 4; ++s)
#pragma unroll
                for (int mt = 0; mt < 8; ++mt) st[mt] = MFMA32(*(const LAS bf16x8*)(lds + (32 * mt + r) * 528 + (16 * (4 * sg + s) + 8 * hh) * 2), qa[s], st[mt]);
#pragma unroll
            for (int s = 0; s < 4; ++s) qa[s] = qb[s];
        }
        float mx = -3.0e38f;
#pragma unroll
        for (int mt = 0; mt < 8; ++mt)
#pragma unroll
            for (int q = 0; q < 16; ++q) mx = fmaxf(mx, st[mt][q]);
        mx = fmaxf(mx, __shfl_xor(mx, 32)); float sum = 0.f;
#pragma unroll
        for (int mt = 0; mt < 8; ++mt)
#pragma unroll
            for (int q = 0; q < 16; ++q) { st[mt][q] = __builtin_amdgcn_exp2f(st[mt][q] - mx); sum += st[mt][q]; }
        sum += __shfl_xor(sum, 32); const float inv = __builtin_amdgcn_rcpf(sum);
        bf16x8 pf[8][2];
#pragma unroll
        for (int mt = 0; mt < 8; ++mt)
#pragma unroll
            for (int s2 = 0; s2 < 2; ++s2) pf[mt][s2] = pack_frag(st[mt][8 * s2 + 0], st[mt][8 * s2 + 1], st[mt][8 * s2 + 2], st[mt][8 * s2 + 3], st[mt][8 * s2 + 4], st[mt][8 * s2 + 5], st[mt][8 * s2 + 6], st[mt][8 * s2 + 7]);
        __syncthreads();
        { const bf16* src = VTX + (size_t)(l * 1024 + hd * 256) * 4096 + b * 256;
#pragma unroll 1
          for (int hb = 0; hb < 2; ++hb) { u32x4 stg[8];
#pragma unroll
            for (int i = 0; i < 8; ++i) { const int idx = tid + 512 * (8 * hb + i), d = idx >> 5, ch = idx & 31; stg[i] = *(const u32x4*)(src + (size_t)d * 4096 + ch * 8); }
#pragma unroll
            for (int i = 0; i < 8; ++i) { const int idx = tid + 512 * (8 * hb + i), d = idx >> 5, ch = idx & 31;
                LAS unsigned char* vd_ = lds + d * 528 + (ch >> 1) * 32 + (ch & 1) * 8; *(LAS u32x2*)(vd_) = (u32x2){stg[i].x, stg[i].y}; *(LAS u32x2*)(vd_ + 16) = (u32x2){stg[i].z, stg[i].w}; } } }
        __syncthreads();
        unsigned char* op = (unsigned char*)OX + (tok0 + 32 * w + r) * 1024 + hd * 256; const float inv4 = inv * 4.f;
#pragma unroll 1
        for (int dp = 0; dp < 4; ++dp) { f32x16 o0 = {}, o1 = {};
#pragma unroll
            for (int mt = 0; mt < 8; ++mt)
#pragma unroll
                for (int s2 = 0; s2 < 2; ++s2) { const int mo = (32 * mt + 16 * s2) * 2 + 16 * hh;
                    const LAS unsigned char* a0 = lds + (64 * dp + r) * 528 + mo; const LAS unsigned char* a1 = a0 + 32 * 528;
                    o0 = MFMA32(*(const LAS bf16x8*)a0, pf[mt][s2], o0);
                    o1 = MFMA32(*(const LAS bf16x8*)a1, pf[mt][s2], o1); }
#pragma unroll
            for (int q4 = 0; q4 < 4; ++q4) {
                const unsigned w0 = pg8::pack_fp8x4(o0[4 * q4] * inv4, o0[4 * q4 + 1] * inv4, o0[4 * q4 + 2] * inv4, o0[4 * q4 + 3] * inv4);
                const unsigned w1 = pg8::pack_fp8x4(o1[4 * q4] * inv4, o1[4 * q4 + 1] * inv4, o1[4 * q4 + 2] * inv4, o1[4 * q4 + 3] * inv4);
                *(unsigned*)(op + 64 * dp + 8 * q4 + 4 * hh) = w0; *(unsigned*)(op + 64 * dp + 32 + 8 * q4 + 4 * hh) = w1; } }
        __syncthreads();
    }
}

#define DA_SB() __builtin_amdgcn_sched_barrier(0)
__device__ __forceinline__ float da_max3(float a, float b, float c) { return fmaxf(fmaxf(a, b), c); }
__device__ __forceinline__ void dattn_phase(Frame& F, const Args& A, int j, float lambda_init) {
    const bf16* QK = (const bf16*)(F.ws + WS_ACT + A_QK); const bf16* VT = (const bf16*)(F.ws + WS_ACT + A_VTD); bf16* AO = (bf16*)(F.ws + WS_ACT + A_AO);
    const int w = F.wave, lane = F.lane, r = lane & 31, hh = lane >> 5, tid = F.tid, mp = w & 1, ig = w >> 1;
    LAS unsigned char* lds = F.lds;
    LAS float* xb = (LAS float*)(lds) + ig * 4096;
    float lam; { float s1 = 0.f, s2 = 0.f; for (int e = 0; e < 64; ++e) { s1 += A.lq1[j * 64 + e] * A.lk1[j * 64 + e]; s2 += A.lq2[j * 64 + e] * A.lk2[j * 64 + e]; } lam = __expf(s1) - __expf(s2) + lambda_init; }
    lam = __builtin_bit_cast(float, __builtin_amdgcn_readfirstlane(__builtin_bit_cast(int, lam)));
    const int li_s = __builtin_amdgcn_readfirstlane(__builtin_bit_cast(int, lambda_init)); const float* gng = A.od_gn + j * 1024;
    const int srow = tid >> 3, sch = tid & 7;
    const int kfo = mp * 9216 + r * 144 + 16 * hh;
    const int vfo = 36864 + r * 144 + 16 * hh;
    const int stv = srow * 144 + (sch >> 1) * 32 + (sch & 1) * 8;
    const int sto = srow * 144 + sch * 16;
    LAS float* gnl = (LAS float*)(lds + 77824);
    if (tid < 256) *(LAS f32x4*)(gnl + 4 * tid) = *(const f32x4*)(gng + 4 * tid);
    int u = F.bid; if (u >= 2048) { __syncthreads(); return; }
    int b = u >> 7, h = (u >> 4) & 7, qt = u & 15; size_t tok0 = (size_t)b * SL + 128 * qt, kb = (size_t)b * SL;
    bf16x8 qf[4]; u32x4 rk0, rk1, rv0, rv1, rk2, rk3;
    const bf16* k0s = QK + (kb + srow) * 2048 + 1024 + (2 * h) * 64 + sch * 8; const bf16* k1s = k0s + 64;
    const bf16* v0s = VT + (size_t)(h * 128 + srow) * T + kb + sch * 8; const bf16* v1s = v0s + (size_t)64 * T;
    { const bf16* qp = QK + (tok0 + 32 * ig + r) * 2048 + (2 * h + mp) * 64 + 8 * hh;
#pragma unroll
      for (int s = 0; s < 4; ++s) qf[s] = *(const bf16x8*)(qp + 16 * s);
      rk0 = *(const u32x4*)(k0s); rk1 = *(const u32x4*)(k1s); rv0 = *(const u32x4*)(v0s); rv1 = *(const u32x4*)(v1s); rk2 = *(const u32x4*)(k0s + (size_t)64 * 2048); rk3 = *(const u32x4*)(k1s + (size_t)64 * 2048); }
    for (;;) {
#define DA_LDK(t) do { const size_t ko_ = (size_t)(t) * 64 * 2048; rk0 = *(const u32x4*)(k0s + ko_); rk1 = *(const u32x4*)(k1s + ko_); } while (0)
#define DA_LDV(t) do { const size_t vo_ = (size_t)(t) * 64; rv0 = *(const u32x4*)(v0s + vo_); rv1 = *(const u32x4*)(v1s + vo_); } while (0)
#define DA_STK(bf) do { *(LAS u32x4*)(lds + (bf) * 18432 + sto) = rk0; *(LAS u32x4*)(lds + (bf) * 18432 + 9216 + sto) = rk1; } while (0)
#define DA_STV(bf) do { LAS unsigned char* vd_ = lds + 36864 + (bf) * 18432 + stv; *(LAS u32x2*)(vd_) = (u32x2){rv0.x, rv0.y}; *(LAS u32x2*)(vd_ + 16) = (u32x2){rv0.z, rv0.w}; \
        *(LAS u32x2*)(vd_ + 9216) = (u32x2){rv1.x, rv1.y}; *(LAS u32x2*)(vd_ + 9216 + 16) = (u32x2){rv1.z, rv1.w}; } while (0)
        DA_STK(0); DA_STV(0); *(LAS u32x4*)(lds + 18432 + sto) = rk2; *(LAS u32x4*)(lds + 18432 + 9216 + sto) = rk3; DA_LDK(2); DA_LDV(1);
        __syncthreads();
        const f32x16 zero16 = {};
        f32x16 pA0, pA1, pB0, pB1; f32x16 o[4] = {{}, {}, {}, {}}; float m_ref = 0.f, l_run = 0.f;
        { pA0 = zero16; pA1 = zero16;
#pragma unroll
          for (int s = 0; s < 4; ++s) { pA0 = MFMA32(*(const LAS bf16x8*)(lds + kfo + 32 * s), qf[s], pA0); pA1 = MFMA32(*(const LAS bf16x8*)(lds + kfo + 4608 + 32 * s), qf[s], pA1); }
          float rm = -3.0e38f;
#pragma unroll
          for (int q = 0; q < 16; ++q) rm = da_max3(rm, pA0[q], pA1[q]);
          rm = fmaxf(rm, __shfl_xor(rm, 32)); m_ref = rm; }
        __syncthreads();
        bf16x8 pb0, pb1, pb2, pb3;
#define DA_EXP4(P, B) do { P[B] = __builtin_amdgcn_exp2f(P[B] - m_ref); P[B + 1] = __builtin_amdgcn_exp2f(P[B + 1] - m_ref); P[B + 2] = __builtin_amdgcn_exp2f(P[B + 2] - m_ref); P[B + 3] = __builtin_amdgcn_exp2f(P[B + 3] - m_ref); \
        sacc += (P[B] + P[B + 1]) + (P[B + 2] + P[B + 3]); } while (0)
#define DA_PACK(P, B) pack_frag(P[B], P[B + 1], P[B + 2], P[B + 3], P[B + 4], P[B + 5], P[B + 6], P[B + 7])
#define DA_KF(kbn, kt2, s) (*(const LAS bf16x8*)(lds + (kbn) * 18432 + kfo + (kt2) * 4608 + 32 * (s)))
#define DA_VF(vbc, dvt, k2, s2) (*(const LAS bf16x8*)(lds + (vbc) * 18432 + vfo + 4608 * (dvt) + 64 * (k2) + 32 * (s2)))
#define DA_EXP2(P, B) do { P[B] = __builtin_amdgcn_exp2f(P[B] - m_ref); P[B + 1] = __builtin_amdgcn_exp2f(P[B + 1] - m_ref); sacc += P[B] + P[B + 1]; } while (0)
#define DA_STEP(C0, C1, N0, N1, t, HASN) do { const int kbn_ = ((t) + 1) & 1, vbc_ = (t) & 1; float sacc = 0.f; bf16x8 fa_, fb_; \
        if (HASN) fa_ = DA_KF(kbn_, 0, 0); else fa_ = DA_VF(vbc_, 0, 0, 0); \
        DA_SB(); \
        if (HASN) { fb_ = DA_KF(kbn_, 1, 0); N0 = MFMA32(fa_, qf[0], zero16); } DA_EXP2(C0, 0);  DA_SB(); \
        if (HASN) { fa_ = DA_KF(kbn_, 0, 1); N1 = MFMA32(fb_, qf[0], zero16); } DA_EXP2(C0, 2);  DA_SB(); \
        if (HASN) { fb_ = DA_KF(kbn_, 1, 1); N0 = MFMA32(fa_, qf[1], N0); }   DA_EXP2(C0, 4);  DA_SB(); \
        if (HASN) { fa_ = DA_KF(kbn_, 0, 2); N1 = MFMA32(fb_, qf[1], N1); }   DA_EXP2(C0, 6);  pb0 = DA_PACK(C0, 0); DA_SB(); \
        if (HASN) { fb_ = DA_KF(kbn_, 1, 2); N0 = MFMA32(fa_, qf[2], N0); }   DA_EXP2(C0, 8);  DA_SB(); \
        if (HASN) { fa_ = DA_KF(kbn_, 0, 3); N1 = MFMA32(fb_, qf[2], N1); }   DA_EXP2(C0, 10); DA_SB(); \
        if (HASN) { fb_ = DA_KF(kbn_, 1, 3); N0 = MFMA32(fa_, qf[3], N0); }   DA_EXP2(C0, 12); DA_SB(); \
        if (HASN) { fa_ = DA_VF(vbc_, 0, 0, 0); N1 = MFMA32(fb_, qf[3], N1); } DA_EXP2(C0, 14); pb1 = DA_PACK(C0, 8); DA_SB(); \
        float rm0 = -3.0e38f, rm1 = -3.0e38f; \
        fb_ = DA_VF(vbc_, 1, 0, 0); o[0] = MFMA32(fa_, pb0, o[0]); DA_EXP2(C1, 0);  if ((t) + 2 < 32) { DA_STK((t) & 1); } DA_SB(); \
        fa_ = DA_VF(vbc_, 2, 0, 0); o[1] = MFMA32(fb_, pb0, o[1]); DA_EXP2(C1, 2);  if ((t) + 3 < 32) { DA_LDK((t) + 3); } DA_SB(); \
        fb_ = DA_VF(vbc_, 3, 0, 0); o[2] = MFMA32(fa_, pb0, o[2]); DA_EXP2(C1, 4);  DA_SB(); \
        fa_ = DA_VF(vbc_, 0, 0, 1); o[3] = MFMA32(fb_, pb0, o[3]); DA_EXP2(C1, 6);  pb2 = DA_PACK(C1, 0); DA_SB(); \
        fb_ = DA_VF(vbc_, 1, 0, 1); o[0] = MFMA32(fa_, pb1, o[0]); DA_EXP2(C1, 8);  DA_SB(); \
        fa_ = DA_VF(vbc_, 2, 0, 1); o[1] = MFMA32(fb_, pb1, o[1]); DA_EXP2(C1, 10); DA_SB(); \
        fb_ = DA_VF(vbc_, 3, 0, 1); o[2] = MFMA32(fa_, pb1, o[2]); DA_EXP2(C1, 12); DA_SB(); \
        fa_ = DA_VF(vbc_, 0, 1, 0); o[3] = MFMA32(fb_, pb1, o[3]); DA_EXP2(C1, 14); pb3 = DA_PACK(C1, 8); DA_SB(); \
        l_run += sacc; \
        fb_ = DA_VF(vbc_, 1, 1, 0); o[0] = MFMA32(fa_, pb2, o[0]); if (HASN) { rm0 = da_max3(rm0, N0[0], N0[1]); rm1 = da_max3(rm1, N0[2], N0[3]); }     if ((t) + 1 < 32) { DA_STV(((t) + 1) & 1); } DA_SB(); \
        fa_ = DA_VF(vbc_, 2, 1, 0); o[1] = MFMA32(fb_, pb2, o[1]); if (HASN) { rm0 = da_max3(rm0, N0[4], N0[5]); rm1 = da_max3(rm1, N0[6], N0[7]); }     if ((t) + 2 < 32) { DA_LDV((t) + 2); } DA_SB(); \
        fb_ = DA_VF(vbc_, 3, 1, 0); o[2] = MFMA32(fa_, pb2, o[2]); if (HASN) { rm0 = da_max3(rm0, N0[8], N0[9]); rm1 = da_max3(rm1, N0[10], N0[11]); }   DA_SB(); \
        fa_ = DA_VF(vbc_, 0, 1, 1); o[3] = MFMA32(fb_, pb2, o[3]); if (HASN) { rm0 = da_max3(rm0, N0[12], N0[13]); rm1 = da_max3(rm1, N0[14], N0[15]); } DA_SB(); \
        fb_ = DA_VF(vbc_, 1, 1, 1); o[0] = MFMA32(fa_, pb3, o[0]); if (HASN) { rm0 = da_max3(rm0, N1[0], N1[1]); rm1 = da_max3(rm1, N1[2], N1[3]); }     DA_SB(); \
        fa_ = DA_VF(vbc_, 2, 1, 1); o[1] = MFMA32(fb_, pb3, o[1]); if (HASN) { rm0 = da_max3(rm0, N1[4], N1[5]); rm1 = da_max3(rm1, N1[6], N1[7]); }     DA_SB(); \
        fb_ = DA_VF(vbc_, 3, 1, 1); o[2] = MFMA32(fa_, pb3, o[2]); if (HASN) { rm0 = da_max3(rm0, N1[8], N1[9]); rm1 = da_max3(rm1, N1[10], N1[11]); }   DA_SB(); \
        o[3] = MFMA32(fb_, pb3, o[3]); if (HASN) { rm0 = da_max3(rm0, N1[12], N1[13]); rm1 = da_max3(rm1, N1[14], N1[15]); } DA_SB(); \
        if (HASN) { float rm = fmaxf(rm0, rm1); rm = fmaxf(rm, __shfl_xor(rm, 32)) - m_ref; \
            if (__builtin_expect(__any(rm > 8.f), 0)) { const float dl = fmaxf(rm, 0.f), f = __builtin_amdgcn_exp2f(-dl); m_ref += dl; l_run *= f; \
                _Pragma("unroll") for (int d_ = 0; d_ < 4; ++d_) _Pragma("unroll") for (int q = 0; q < 16; ++q) o[d_][q] *= f; } } \
        __syncthreads(); } while (0)
#pragma unroll 1
        for (int t = 0; t < 30; t += 2) { DA_STEP(pA0, pA1, pB0, pB1, t, true); DA_STEP(pB0, pB1, pA0, pA1, t + 1, true); }
        DA_STEP(pA0, pA1, pB0, pB1, 30, true); DA_STEP(pB0, pB1, pA0, pA1, 31, false);
#undef DA_STEP
#undef DA_VF
#undef DA_KF
#undef DA_PACK
#undef DA_EXP4
#undef DA_EXP2
#undef DA_LDK
#undef DA_LDV
#undef DA_STK
#undef DA_STV
        asm volatile("" ::: "memory");
        const int un = u + F.G; const bool has_next = un < 2048;
        const int nb = un >> 7, nh = (un >> 4) & 7, nqt = un & 15; const size_t ntok0 = (size_t)nb * SL + 128 * nqt, nkb = (size_t)nb * SL;
        const bf16* nk0s = QK + (nkb + srow) * 2048 + 1024 + (2 * nh) * 64 + sch * 8; const bf16* nv0s = VT + (size_t)(nh * 128 + srow) * T + nkb + sch * 8;
        if (has_next) { const bf16* qp = QK + (ntok0 + 32 * ig + r) * 2048 + (2 * nh + mp) * 64 + 8 * hh;
#pragma unroll
            for (int s = 0; s < 4; ++s) qf[s] = *(const bf16x8*)(qp + 16 * s);
            rk0 = *(const u32x4*)(nk0s); rk1 = *(const u32x4*)(nk0s + 64); rv0 = *(const u32x4*)(nv0s); rv1 = *(const u32x4*)(nv0s + (size_t)64 * T);
            rk2 = *(const u32x4*)(nk0s + (size_t)64 * 2048); rk3 = *(const u32x4*)(nk0s + 64 + (size_t)64 * 2048); }
        l_run += __shfl_xor(l_run, 32); const float inv = __builtin_amdgcn_rcpf(l_run);
        if (mp == 1) {
#pragma unroll
            for (int dvt = 0; dvt < 4; ++dvt)
#pragma unroll
                for (int q = 0; q < 16; ++q) xb[(dvt * 16 + q) * 64 + lane] = o[dvt][q] * inv; }
        __syncthreads();
        if (mp == 0) { float ss = 0.f;
#pragma unroll
            for (int dvt = 0; dvt < 4; ++dvt)
#pragma unroll
                for (int q = 0; q < 16; ++q) { o[dvt][q] = o[dvt][q] * inv - lam * xb[(dvt * 16 + q) * 64 + lane]; ss += o[dvt][q] * o[dvt][q]; }
            int lt_ = li_s; asm volatile("" : "+s"(lt_)); const float li_ = __builtin_bit_cast(float, lt_);
            ss += __shfl_xor(ss, 32); const float rms = rsqrtf(ss * (1.f / 128.f) + EPS) * (1.f - li_);
            bf16* op = AO + (tok0 + 32 * ig + r) * 1024 + h * 128;
#pragma unroll
            for (int dvt = 0; dvt < 4; ++dvt)
#pragma unroll
                for (int q4 = 0; q4 < 4; ++q4) { const int dv0 = 32 * dvt + 8 * q4 + 4 * hh; const f32x4 gn = *(const LAS f32x4*)(gnl + h * 128 + dv0);
                    u32x2 wv; wv.x = pk2(o[dvt][4 * q4] * rms * gn[0], o[dvt][4 * q4 + 1] * rms * gn[1]); wv.y = pk2(o[dvt][4 * q4 + 2] * rms * gn[2], o[dvt][4 * q4 + 3] * rms * gn[3]);
                    *(u32x2*)(op + dv0) = wv; } }
        __syncthreads();
        if (!has_next) break;
        u = un; b = nb; h = nh; qt = nqt; tok0 = ntok0; kb = nkb; k0s = nk0s; k1s = nk0s + 64; v0s = nv0s; v1s = nv0s + (size_t)64 * T;
    }
}
#undef DA_SB

__device__ __forceinline__ void router_phase(Frame& F, const Args& A, int i  , int j, int jc) {
    LAS int* lcnt = (LAS int*)(F.lds); LAS int* lbase = lcnt + 8;
    LAS f32x4* wl = (LAS f32x4*)(F.lds + 1024);
    const bf16* X = (const bf16*)(F.ws + WS_XB); const float* ssq = (const float*)(F.ws + WS_SSQ); const float* Wr = A.router + (size_t)j * D * NE; const float* gf = A.ffn_g + i * D;
    int* list = (int*)(F.ws + WS_MISC + MISC_LIST); float* gate = (float*)(F.ws + WS_MISC + MISC_GATE); int* epos = (int*)(F.ws + WS_MISC + MISC_EPOS);
    for (int idx = F.tid; idx < 2048; idx += NTHR) { const int ln = idx & 63, kk2 = idx >> 6, k = 4 * ln + 256 * (kk2 >> 3) + ((kk2 >> 1) & 3);
        wl[idx] = *(const f32x4*)(Wr + (size_t)k * 8 + 4 * (kk2 & 1)) * gf[k]; }
    if (F.tid < 8) lcnt[F.tid] = 0;
    __syncthreads();
    const bool h5 = (F.lane & 32) != 0, h4 = (F.lane & 16) != 0, h3 = (F.lane & 8) != 0, h2 = (F.lane & 4) != 0, h1 = (F.lane & 2) != 0, h0 = (F.lane & 1) != 0;
    for (int grp = F.bid; grp < T / 128; grp += F.G) {
        int my_e0 = 0, my_e1 = 0; float my_g0 = 0.f, my_g1 = 0.f;
#pragma unroll 1
        for (int bt = 0; bt < 2; ++bt) {
            const int tok0 = grp * 128 + F.wave * 16 + bt * 8;
            asm volatile("" ::: "memory");
            u32x2 xw[8][4];
#pragma unroll
            for (int s = 0; s < 8; ++s)
#pragma unroll
                for (int q = 0; q < 4; ++q) xw[s][q] = *(const u32x2*)(X + (size_t)(tok0 + s) * D + 4 * F.lane + 256 * q);
            const u32x2 spw = *(const u32x2*)(ssq + (size_t)(tok0 + (F.lane >> 3)) * 16 + 2 * (F.lane & 7));
            f32x4 acc[8][2];
#pragma unroll
            for (int s = 0; s < 8; ++s) { acc[s][0] = f32x4{0.f, 0.f, 0.f, 0.f}; acc[s][1] = f32x4{0.f, 0.f, 0.f, 0.f}; }
#pragma unroll
            for (int q = 0; q < 4; ++q)
#pragma unroll
                for (int e4 = 0; e4 < 4; ++e4) { const f32x4 w0 = wl[((q * 4 + e4) * 2 + 0) * 64 + F.lane], w1 = wl[((q * 4 + e4) * 2 + 1) * 64 + F.lane];
#pragma unroll
                    for (int s = 0; s < 8; ++s) { const unsigned wd = (e4 < 2) ? xw[s][q].x : xw[s][q].y; const float xv = __builtin_bit_cast(float, (e4 & 1) ? (wd & 0xffff0000u) : (wd << 16));
                        acc[s][0] += w0 * xv; acc[s][1] += w1 * xv; } }
            float v32[32], v16[16], v8[8], v4[4], v2[2];
#pragma unroll
            for (int v = 0; v < 32; ++v) { const float lo = acc[v >> 3][(v >> 2) & 1][v & 3], hi = acc[(v >> 3) + 4][(v >> 2) & 1][v & 3]; v32[v] = (h5 ? hi : lo) + __shfl_xor(h5 ? lo : hi, 32); }
#pragma unroll
            for (int v = 0; v < 16; ++v) v16[v] = (h4 ? v32[v + 16] : v32[v]) + __shfl_xor(h4 ? v32[v] : v32[v + 16], 16);
#pragma unroll
            for (int v = 0; v < 8; ++v) v8[v] = (h3 ? v16[v + 8] : v16[v]) + __shfl_xor(h3 ? v16[v] : v16[v + 8], 8);
#pragma unroll
            for (int v = 0; v < 4; ++v) v4[v] = (h2 ? v8[v + 4] : v8[v]) + __shfl_xor(h2 ? v8[v] : v8[v + 4], 4);
#pragma unroll
            for (int v = 0; v < 2; ++v) v2[v] = (h1 ? v4[v + 2] : v4[v]) + __shfl_xor(h1 ? v4[v] : v4[v + 2], 2);
            const float tot = (h0 ? v2[1] : v2[0]) + __shfl_xor(h0 ? v2[0] : v2[1], 1);
            float p = __builtin_bit_cast(float, spw.x) + __builtin_bit_cast(float, spw.y); p += __shfl_xor(p, 1); p += __shfl_xor(p, 2); p += __shfl_xor(p, 4);
            float m1 = tot * rsqrtf(p * (1.f / D) + EPS), m2 = -3.0e38f; int i1 = F.lane & 7, i2 = -1;
#pragma unroll
            for (int M = 1; M < 8; M <<= 1) {
                const float pm1 = __shfl_xor(m1, M), pm2 = __shfl_xor(m2, M); const int pi1 = __shfl_xor(i1, M), pi2 = __shfl_xor(i2, M);
                const bool ab = (m1 > pm1) || (m1 == pm1 && i1 < pi1);
                const float wm = ab ? m1 : pm1, lm = ab ? pm1 : m1, sm = ab ? m2 : pm2; const int wi = ab ? i1 : pi1, li = ab ? pi1 : i1, si = ab ? i2 : pi2;
                const bool ls = (lm > sm) || (lm == sm && li < si);
                m1 = wm; i1 = wi; m2 = ls ? lm : sm; i2 = ls ? li : si; }
            const float w1 = 1.f / (1.f + __expf(m2 - m1));
            const int src = 8 * (F.lane & 7); const int ri1 = __shfl(i1, src), ri2 = __shfl(i2, src); const float rw = __shfl(w1, src);
            if ((F.lane >> 3) == bt) { my_e0 = ri1; my_e1 = ri2; my_g0 = rw; my_g1 = 1.f - rw; } }
        int p0 = 0, p1 = 0;
        if (F.lane < 16) { p0 = atomicAdd((int*)&lcnt[my_e0], 1); p1 = atomicAdd((int*)&lcnt[my_e1], 1); }
        __syncthreads();
        if (F.tid < 8) lbase[F.tid] = (int)__hip_atomic_fetch_add((unsigned*)(F.ctl + CW_CNT + jc * 1024 + 64 * F.tid), (unsigned)lcnt[F.tid], RLX_AGENT);
        __syncthreads();
        if (F.lane < 16) { const int tok = grp * 128 + F.wave * 16 + F.lane; const int q0 = lbase[my_e0] + p0, q1 = lbase[my_e1] + p1;
            list[(size_t)my_e0 * T + q0] = tok * 2; list[(size_t)my_e1 * T + q1] = tok * 2 + 1;
            epos[tok * 2] = (my_e0 << 20) | q0; epos[tok * 2 + 1] = (my_e1 << 20) | q1; gate[tok * 2] = my_g0; gate[tok * 2 + 1] = my_g1; }
        __syncthreads();
        if (F.tid < 8) lcnt[F.tid] = 0;
        __syncthreads();
    }
}
struct TileBase { int tb[9]; int cnt[8]; };
__device__ __forceinline__ void load_tilebase(Frame& F, int j, TileBase& B) {
    int run = 0;
#pragma unroll
    for (int e = 0; e < 8; ++e) { const int c = (int)__hip_atomic_load((unsigned*)(F.ctl + CW_CNT + j * 1024 + 64 * e), RLX_AGENT); B.cnt[e] = c; B.tb[e] = run; run += (c + 255) >> 8; }
    B.tb[8] = run;
}
__device__ __forceinline__ void gather_phase(Frame& F, int j) {
    TileBase B; load_tilebase(F, j, B);
    const bf16* XB = (const bf16*)(F.ws + WS_XB); unsigned char* XS = F.ws + WS_ACT + A_XS; const float* ssq = (const float*)(F.ws + WS_SSQ);
    const int* list = (const int*)(F.ws + WS_MISC + MISC_LIST); int* yrow = (int*)(F.ws + WS_MISC + MISC_YROW);
    const int gw = F.bid * NWAVES + F.wave, NGW = F.G * NWAVES, nrows = B.tb[8] * 256;
    const int my_rr = 2 * gw + 2 * NGW * (F.lane >> 1) + (F.lane & 1); int my_tk = -1; float my_rs = 0.f;
    if (my_rr < nrows) { const int gt = my_rr >> 8; int e = 0, tbe = 0, ce = B.cnt[0];
#pragma unroll
        for (int k = 1; k < 8; ++k) if (gt >= B.tb[k]) { e = k; tbe = B.tb[k]; ce = B.cnt[k]; }
        const int posr = my_rr - tbe * 256;
        if (posr < ce) { my_tk = list[(size_t)e * T + posr]; const f32x4* sp = (const f32x4*)(ssq + (size_t)(my_tk >> 1) * 16);
            const f32x4 s0 = sp[0], s1 = sp[1], s2 = sp[2], s3 = sp[3];
            const float pp = ((s0[0] + s0[1]) + (s0[2] + s0[3])) + ((s1[0] + s1[1]) + (s1[2] + s1[3])) + ((s2[0] + s2[1]) + (s2[2] + s2[3])) + ((s3[0] + s3[1]) + (s3[2] + s3[3]));
            my_rs = rsqrtf(pp * (1.f / D) + EPS); yrow[my_tk] = my_rr; } }
#define GA_LOAD(V0, V1, RS, k_) do { _Pragma("unroll") for (int s = 0; s < 4; ++s) { const int li = 2 * (k_) + s; const int tks = __builtin_amdgcn_readlane(my_tk, li & 63); \
            RS[s] = __builtin_bit_cast(float, __builtin_amdgcn_readlane(__builtin_bit_cast(int, my_rs), li & 63)); \
            const u32x4* src = (const u32x4*)(XB + (size_t)((tks < 0 ? 0 : tks) >> 1) * D) + F.lane; V0[s] = src[0]; V1[s] = src[64]; } } while (0)
#define BFLO(w) (__builtin_bit_cast(float, (w) << 16) * rsx)
#define BFHI(w) (__builtin_bit_cast(float, (w) & 0xffff0000u) * rsx)
#define GA_PROC(V0, V1, RS, k_) do { _Pragma("unroll") for (int s = 0; s < 4; ++s) { const int rr = 2 * gw + 2 * NGW * ((k_) + (s >> 1)) + (s & 1); if (rr < nrows) { const float rsx = RS[s]; u32x2 o0, o1; \
                o0.x = pg8::pack_fp8x4(BFLO(V0[s].x), BFHI(V0[s].x), BFLO(V0[s].y), BFHI(V0[s].y)); o0.y = pg8::pack_fp8x4(BFLO(V0[s].z), BFHI(V0[s].z), BFLO(V0[s].w), BFHI(V0[s].w)); \
                o1.x = pg8::pack_fp8x4(BFLO(V1[s].x), BFHI(V1[s].x), BFLO(V1[s].y), BFHI(V1[s].y)); o1.y = pg8::pack_fp8x4(BFLO(V1[s].z), BFHI(V1[s].z), BFLO(V1[s].w), BFHI(V1[s].w)); \
                u32x2* dst = (u32x2*)(XS + (size_t)rr * D) + F.lane; dst[0] = o0; dst[64] = o1; } } } while (0)
    { u32x4 a0[4], a1[4], b0[4], b1[4]; float ars[4], brs[4];
      GA_LOAD(a0, a1, ars, 0);
#pragma unroll 1
      for (int k = 0; 2 * gw + 2 * NGW * k < nrows; k += 4) {
        GA_LOAD(b0, b1, brs, k + 2);
        GA_PROC(a0, a1, ars, k);
        GA_LOAD(a0, a1, ars, k + 4);
        GA_PROC(b0, b1, brs, k + 2); } }
#undef GA_PROC
#undef GA_LOAD
#undef BFHI
#undef BFLO
}
__device__ __forceinline__ void combine_phase(Frame& F, const Args& A, bool last, int dry = 0) {
    const bf16* Y = (const bf16*)(F.ws + WS_ACT + A_Y); const int* yrow = (const int*)(F.ws + WS_MISC + MISC_YROW); const float* gate = (const float*)(F.ws + WS_MISC + MISC_GATE);
    const int gw = F.bid * NWAVES + F.wave, NGW = F.G * NWAVES;
    const bool h5 = (F.lane & 32) != 0, h4 = (F.lane & 16) != 0;
    for (int base = gw * 16; base < T; base += NGW * 16) {
        u32x2 yr = {0u, 0u}, gg = {0u, 0u};
        if (F.lane < 16) { yr = *(const u32x2*)(yrow + 2 * (base + F.lane)); gg = *(const u32x2*)(gate + 2 * (base + F.lane)); }
#pragma unroll 1
        for (int b4 = 0; b4 < 4; ++b4) { const int m0 = base + b4 * 4;
            u32x2 xw[4][4], ya[4][4], yb[4][4]; float g0[4], g1[4];
#pragma unroll
            for (int s = 0; s < 4; ++s) { const int tl = b4 * 4 + s; const int r0 = __builtin_amdgcn_readlane((int)yr.x, tl), r1 = __builtin_amdgcn_readlane((int)yr.y, tl);
                g0[s] = __builtin_bit_cast(float, __builtin_amdgcn_readlane((int)gg.x, tl)); g1[s] = __builtin_bit_cast(float, __builtin_amdgcn_readlane((int)gg.y, tl));
                const u32x2* xr = (const u32x2*)((const bf16*)(F.ws + WS_XB) + (size_t)(m0 + s) * D) + F.lane; const u32x2* y0 = (const u32x2*)(Y + (size_t)r0 * D) + F.lane; const u32x2* y1 = (const u32x2*)(Y + (size_t)r1 * D) + F.lane;
#pragma unroll
                for (int q = 0; q < 4; ++q) { xw[s][q] = xr[64 * q]; ya[s][q] = y0[64 * q]; yb[s][q] = y1[64 * q]; } }
            f32x4 v[4][4]; float sq[4];
#pragma unroll
            for (int s = 0; s < 4; ++s) { sq[s] = 0.f;
#pragma unroll
                for (int q = 0; q < 4; ++q) { const u32x2 x = xw[s][q], a = ya[s][q], b = yb[s][q];
                    v[s][q][0] = __builtin_bit_cast(float, x.x << 16) + g0[s] * __builtin_bit_cast(float, a.x << 16) + g1[s] * __builtin_bit_cast(float, b.x << 16);
                    v[s][q][1] = __builtin_bit_cast(float, x.x & 0xffff0000u) + g0[s] * __builtin_bit_cast(float, a.x & 0xffff0000u) + g1[s] * __builtin_bit_cast(float, b.x & 0xffff0000u);
                    v[s][q][2] = __builtin_bit_cast(float, x.y << 16) + g0[s] * __builtin_bit_cast(float, a.y << 16) + g1[s] * __builtin_bit_cast(float, b.y << 16);
                    v[s][q][3] = __builtin_bit_cast(float, x.y & 0xffff0000u) + g0[s] * __builtin_bit_cast(float, a.y & 0xffff0000u) + g1[s] * __builtin_bit_cast(float, b.y & 0xffff0000u);
                    if (!last) {
#pragma unroll
                        for (int e = 0; e < 4; ++e) v[s][q][e] = bf2f((bf16)f2bf(v[s][q][e])); }
                    sq[s] += (v[s][q][0] * v[s][q][0] + v[s][q][1] * v[s][q][1]) + (v[s][q][2] * v[s][q][2] + v[s][q][3] * v[s][q][3]); } }
            const float t0 = (h5 ? sq[2] : sq[0]) + __shfl_xor(h5 ? sq[0] : sq[2], 32), t1 = (h5 ? sq[3] : sq[1]) + __shfl_xor(h5 ? sq[1] : sq[3], 32);
            float tt = (h4 ? t1 : t0) + __shfl_xor(h4 ? t0 : t1, 16);
            tt += __shfl_xor(tt, 8); tt += __shfl_xor(tt, 4); tt += __shfl_xor(tt, 2); tt += __shfl_xor(tt, 1);
#pragma unroll
            for (int s = 0; s < 4; ++s) { const int m = m0 + s; const float ssum = __builtin_bit_cast(float, __builtin_amdgcn_readlane(__builtin_bit_cast(int, tt), 16 * s));
                if (last && !dry) { const float rs = rsqrtf(ssum * (1.f / D) + EPS); const f32x4* gr = (const f32x4*)A.fin_g + F.lane;
                    f32x4* orow = (f32x4*)(A.out + (size_t)m * D) + F.lane;
#pragma unroll
                    for (int q = 0; q < 4; ++q) { const f32x4 g = gr[64 * q]; f32x4 o; o[0] = v[s][q][0] * rs * g[0]; o[1] = v[s][q][1] * rs * g[1]; o[2] = v[s][q][2] * rs * g[2]; o[3] = v[s][q][3] * rs * g[3]; orow[64 * q] = o; } }
                else { u32x2* xo = dry ? (u32x2*)((bf16*)(F.ws + WS_ACT) + (size_t)m * D) + F.lane : (u32x2*)((bf16*)(F.ws + WS_XB) + (size_t)m * D) + F.lane; float* sw = dry ? (float*)(F.ws + WS_ACT + 64 * MiB) : (float*)(F.ws + WS_SSQ);
#pragma unroll
                    for (int q = 0; q < 4; ++q) { u32x2 wv; wv.x = pk2(v[s][q][0], v[s][q][1]); wv.y = pk2(v[s][q][2], v[s][q][3]); xo[64 * q] = wv; }
                    if (F.lane < 16) sw[(size_t)m * 16 + F.lane] = (F.lane == 0) ? ssum : 0.f; } }
        }
    }
}

#if DBG
struct Ck { float num, den; };
__device__ __forceinline__ float f8tof(unsigned char b) { const int s = b >> 7, e = (b >> 3) & 15, m = b & 7; float v = (e == 0) ? (float)m * 0.001953125f : (1.f + (float)m * 0.125f) * exp2f((float)(e - 7)); return s ? -v : v; }
__device__ __forceinline__ unsigned hsh(unsigned x) { x ^= x >> 16; x *= 0x7feb352dU; x ^= x >> 15; x *= 0x846ca68bU; x ^= x >> 16; return x; }
__device__ __forceinline__ void ck_acc(Ck& c, float got, float ref) { const float d = got - ref; c.num += (d == d && fabsf(d) < 1e18f) ? d * d : 1e30f; c.den += ref * ref; }
__device__ __forceinline__ void ck_flush(Frame& F, int stage, Ck c) { const float n = wave_sum(c.num), d = wave_sum(c.den);
    if (F.lane == 0) { atomicAdd((float*)(F.ctl + CW_CHK) + stage * 2, n); atomicAdd((float*)(F.ctl + CW_CHK) + stage * 2 + 1, d); } }
__device__ __forceinline__ float rs_naive(const bf16* X, int t) { float s = 0.f; for (int k = 0; k < D; ++k) { const float v = bf2f(X[(size_t)t * D + k]); s += v * v; } return rsqrtf(s * (1.f / D) + EPS); }
__device__ __forceinline__ float dotx(const bf16* X, int t, const float* gk, const float* W, int ldw, int wc) { float s = 0.f; for (int k = 0; k < D; ++k) s += bf2f(X[(size_t)t * D + k]) * gk[k] * W[(size_t)k * ldw + wc]; return s; }
__device__ __forceinline__ void sc_acc(int pos, float invf, float& sn, float& cs) { double rv = (double)pos * (double)invf * 0.15915494309189535; rv -= floor(rv); sn = __builtin_amdgcn_sinf((float)rv); cs = __builtin_amdgcn_cosf((float)rv); }
#define CK_LOOP(NS) for (unsigned s_ = (unsigned)(F.bid * NTHR + F.tid); s_ < (unsigned)(NS); s_ += (unsigned)(F.G * NTHR))

__device__ __forceinline__ void ck_proj(Frame& F, const Args& A, int stage, int mode, int i, int j) {
    Ck c = {0.f, 0.f}; const bf16* X = (const bf16*)(F.ws + WS_XB);
    CK_LOOP(4096) { const unsigned h1 = hsh(s_ * 2u + 1u + 977u * (unsigned)stage), h2 = hsh(h1 + 12345u); const int t = (int)(h1 % T); float got, ref;
        const float rs = rs_naive(X, t); const int pos = A.pos[t];
        if (mode == 1) { const int cn = (int)(h2 % 4096); const float* W = A.ev_w_in + (size_t)j * D * 3584; const float* g = A.mix_g + i * D; got = bf2f(((const bf16*)(F.ws + WS_ACT + A_PE))[(size_t)t * PEW + cn]);
            if (cn < 1536) ref = rs * dotx(X, t, g, W, 3584, cn);
            else if (cn >= 2560 && cn < 3072) ref = rs * dotx(X, t, g, W, 3584, cn + 512);
            else { const bool bcopy = cn >= 3072; const int cf_ = bcopy ? cn - 1536 : cn; const int base = cf_ & ~63, cp = cf_ & 63, gg = cp >> 3, s = cp & 7, jj = 4 * gg + (s & 3);
                const float x1 = rs * dotx(X, t, g, W, 3584, base + jj), x2 = rs * dotx(X, t, g, W, 3584, base + 32 + jj); float sn, cs; sc_acc(pos, exp2f(-(float)jj * (13.287712379549449f / 32.f)), sn, cs);
                const bool isk = cf_ >= 2048; const int head = (cf_ & 511) >> 6, l = t & (SL - 1), lm = isk ? (l & 63) : (l & 31);
                const float lgf = -__expf(A.ev_df[j * 8 + head]), lgb = -__expf(A.ev_db[j * 8 + head]);
                const float dec = bcopy ? __expf(lgb * (float)(isk ? lm : -lm)) : __expf(lgf * (float)(isk ? -lm : lm));
                ref = ((s < 4) ? x1 * cs - x2 * sn : x1 * sn + x2 * cs) * (isk ? 0.125f : 1.f) * dec; } }
        else if (mode == 2) { const int cn = (int)(h2 % 2048); const float* W = A.od_w_in + (size_t)j * D * 3072; const float* g = A.mix_g + i * D; got = bf2f(((const bf16*)(F.ws + WS_ACT + A_QK))[(size_t)t * QKP + cn]);
            const int base = cn & ~63, cp = cn & 63; const float sc = (cn < 1024) ? 0.125f * LOG2E : 1.f;
            if (cp < 16) { const int gg = cp >> 3, s = cp & 7, jj = 4 * gg + (s & 3);
                const float x1 = rs * dotx(X, t, g, W, 3072, base + jj), x2 = rs * dotx(X, t, g, W, 3072, base + 8 + jj); float sn, cs; sc_acc(pos, exp2f(-(float)jj * (18.931568569324174f / 8.f)), sn, cs);
                ref = ((s < 4) ? x1 * cs - x2 * sn : x1 * sn + x2 * cs) * sc; }
            else ref = rs * dotx(X, t, g, W, 3072, cn) * sc; }
        else if (mode == 3) { const int cn = (int)(h2 % 1024); got = bf2f(((const bf16*)(F.ws + WS_ACT + A_QX))[(size_t)t * 1024 + cn]);
            ref = rs * dotx(X, t, A.xa_g + i * D, A.xa_wq + (size_t)i * D * D, D, cn) * (LOG2E / 16.f); }
        else { const int cn = (int)(h2 % FF); got = f8tof((F.ws + WS_ACT + A_H)[(size_t)t * FF + cn]) * (1.f / MOE_HSCALE); const float* g = A.ffn_g + i * D;
            const float a = rs * dotx(X, t, g, A.ffd_g + (size_t)j * D * FF, FF, cn), b = rs * dotx(X, t, g, A.ffd_u + (size_t)j * D * FF, FF, cn); ref = a / (1.f + __expf(-a)) * b; }
        ck_acc(c, got, ref); }
    ck_flush(F, stage, c);
}
__device__ __forceinline__ void ck_swapped(Frame& F, const Args& A, int stage, int mode, int i, int j) {
    Ck c = {0.f, 0.f}; const bf16* X = (const bf16*)(F.ws + WS_XB);
    CK_LOOP(4096) { const unsigned h1 = hsh(s_ * 2u + 7u + 977u * (unsigned)stage), h2 = hsh(h1 + 999u); const int t = (int)(h1 % T), R = (int)(h2 % 1024);
        const float rs = rs_naive(X, t); const float* g = A.mix_g + i * D;
        if (mode == 0) { const float ref = rs * dotx(X, t, g, A.od_w_in + (size_t)j * D * 3072, 3072, 2048 + R); ck_acc(c, bf2f(((const bf16*)(F.ws + WS_ACT + A_VTD))[(size_t)R * VTP + t]), ref); }
        else { const float* W = A.ev_w_in + (size_t)j * D * 3584; const int Rv = R & 511;
            const float ref = rs * dotx(X, t, g, W, 3584, 2560 + Rv); ck_acc(c, bf2f(((const bf16*)(F.ws + WS_ACT + A_VTE))[(size_t)Rv * T + t]), ref); } }
    ck_flush(F, stage, c);
}
__device__ __forceinline__ void ck_res(Frame& F, const Args& A, int stage, const bf16* act, int K, const float* W, const bf16* xprev, bool f8act = false) {
    Ck c = {0.f, 0.f}, c2 = {0.f, 0.f};
    CK_LOOP(4096) { const unsigned h1 = hsh(s_ * 2u + 3u + 977u * (unsigned)stage), h2 = hsh(h1 + 4242u); const int t = (int)(h1 % T), cn = (int)(h2 % D);
        float s = 0.f; for (int k = 0; k < K; ++k) s += (f8act ? f8tof(((const unsigned char*)act)[(size_t)t * K + k]) * (1.f / MOE_HSCALE) : bf2f(act[(size_t)t * K + k])) * W[(size_t)k * D + cn];
        const float ref = bf2f(xprev[(size_t)t * D + cn]) + s, got = bf2f(((const bf16*)(F.ws + WS_XB))[(size_t)t * D + cn]); ck_acc(c, got, ref);
        float ss = 0.f; for (int k = 0; k < D; ++k) { const float v = bf2f(((const bf16*)(F.ws + WS_XB))[(size_t)t * D + k]); ss += v * v; }
        float sp = 0.f; for (int k = 0; k < 16; ++k) sp += ((const float*)(F.ws + WS_SSQ))[(size_t)t * 16 + k];
        ck_acc(c2, sp, ss); }
    ck_flush(F, stage, c); ck_flush(F, stage + 1, c2);
}
__device__ __forceinline__ void ck_memkv(Frame& F, const Args& A, int stage) {
    Ck c = {0.f, 0.f};
    CK_LOOP(4096) { const unsigned h1 = hsh(s_ * 2u + 5u), h2 = hsh(h1 + 77u); const int r = (int)(h1 % MT), cn = (int)(h2 % 4096), l = cn >> 10, n = cn & 1023; const int which = (int)((h2 >> 16) & 1);
        float ss = 0.f; for (int k = 0; k < D; ++k) { const float v = A.mem[(size_t)r * D + k]; ss += v * v; } const float rs = rsqrtf(ss * (1.f / D) + EPS);
        float s = 0.f; for (int k = 0; k < D; ++k) s += A.mem[(size_t)r * D + k] * rs * A.mem_g[k] * A.xa_wkv[((size_t)l * D + k) * 2 * D + which * D + n];
        const float got = which ? bf2f(((const bf16*)(F.ws + WS_VTX))[(size_t)cn * 4096 + r]) : bf2f(((const bf16*)(F.ws + WS_KX))[(size_t)r * 4096 + cn]);
        ck_acc(c, got, s); }
    ck_flush(F, stage, c);
}
__device__ __forceinline__ void ck_xattn(Frame& F, const Args& A, int stage, int l) {
    Ck c = {0.f, 0.f}; const bf16* Q = (const bf16*)(F.ws + WS_ACT + A_QX); const bf16* KX = (const bf16*)(F.ws + WS_KX); const bf16* VTX = (const bf16*)(F.ws + WS_VTX);
    CK_LOOP(2048) { const unsigned h1 = hsh(s_ * 2u + 9u + 977u * (unsigned)stage), h2 = hsh(h1 + 31u); const int t = (int)(h1 % T), cn = (int)(h2 % D), hd = cn >> 8, b = t >> 11;
        float m = -3e38f, lsum = 0.f, o = 0.f;
        for (int mm = 0; mm < 256; ++mm) { float s = 0.f; for (int d = 0; d < 256; ++d) s += bf2f(Q[(size_t)t * D + hd * 256 + d]) * bf2f(KX[(size_t)(b * 256 + mm) * 4096 + l * 1024 + hd * 256 + d]);
            const float mn = fmaxf(m, s), al = exp2f(m - mn), p = exp2f(s - mn); lsum = lsum * al + p; o = o * al + p * bf2f(VTX[(size_t)(l * 1024 + cn) * 4096 + b * 256 + mm]); m = mn; }
        ck_acc(c, bf2f(((const bf16*)(F.ws + WS_ACT + A_OX))[(size_t)t * D + cn]), o / lsum); }
    ck_flush(F, stage, c);
}
__device__ __forceinline__ void ck_dattn(Frame& F, const Args& A, int stage, int j, float lambda_init) {
    Ck c = {0.f, 0.f}; const bf16* QK = (const bf16*)(F.ws + WS_ACT + A_QK); const bf16* VT = (const bf16*)(F.ws + WS_ACT + A_VTD); const bf16* AO = (const bf16*)(F.ws + WS_ACT + A_AO);
    LAS float* sc = (LAS float*)(F.lds) + F.wave * 4096;
    float lam; { float s1 = 0.f, s2 = 0.f; for (int e = 0; e < 64; ++e) { s1 += A.lq1[j * 64 + e] * A.lk1[j * 64 + e]; s2 += A.lq2[j * 64 + e] * A.lk2[j * 64 + e]; } lam = __expf(s1) - __expf(s2) + lambda_init; }
    const int gw = F.bid * NWAVES + F.wave;
    for (int smp = gw; smp < 512; smp += F.G * NWAVES) { const unsigned h1 = hsh((unsigned)smp * 2u + 11u + 977u * (unsigned)stage); const int t = (int)(h1 % T), h = (int)((h1 >> 20) & 7), b = t >> 11; const size_t kb = (size_t)b * SL;
        float mx[2] = {-3e38f, -3e38f};
        for (int kk = 0; kk < 32; ++kk) { const int key = F.lane + 64 * kk;
#pragma unroll
            for (int mp = 0; mp < 2; ++mp) { float s = 0.f; for (int d = 0; d < 64; ++d) s += bf2f(QK[(size_t)t * QKP + (2 * h + mp) * 64 + d]) * bf2f(QK[(kb + key) * QKP + 1024 + (2 * h + mp) * 64 + d]);
                sc[mp * 2048 + key] = s; mx[mp] = fmaxf(mx[mp], s); } }
        LDS_WAIT(); const float m0 = wave_max(mx[0]), m1 = wave_max(mx[1]); float l0 = 0.f, l1 = 0.f;
        for (int kk = 0; kk < 32; ++kk) { const int key = F.lane + 64 * kk; const float p0 = exp2f(sc[key] - m0), p1 = exp2f(sc[2048 + key] - m1); sc[key] = p0; sc[2048 + key] = p1; l0 += p0; l1 += p1; }
        LDS_WAIT(); l0 = wave_sum(l0); l1 = wave_sum(l1);
        float v[2], ss = 0.f;
#pragma unroll
        for (int e = 0; e < 2; ++e) { const int dv = F.lane + 64 * e; float o0 = 0.f, o1 = 0.f;
            for (int key = 0; key < 2048; ++key) { const float vv = bf2f(VT[(size_t)(h * 128 + dv) * VTP + kb + key]); o0 += sc[key] * vv; o1 += sc[2048 + key] * vv; }
            v[e] = o0 / l0 - lam * o1 / l1; ss += v[e] * v[e]; }
        ss = wave_sum(ss); const float rms = rsqrtf(ss * (1.f / 128.f) + EPS) * (1.f - lambda_init);
#pragma unroll
        for (int e = 0; e < 2; ++e) { const int dv = F.lane + 64 * e; ck_acc(c, bf2f(AO[(size_t)t * D + h * 128 + dv]), v[e] * rms * A.od_gn[j * 1024 + h * 128 + dv]); }
        LDS_WAIT(); }
    ck_flush(F, stage, c);
}
__device__ __forceinline__ void ck_ret(Frame& F, const Args& A, int stage, int j) {
    Ck c = {0.f, 0.f}, c2 = {0.f, 0.f}; const bf16* PE = (const bf16*)(F.ws + WS_ACT + A_PE); const bf16* VT = (const bf16*)(F.ws + WS_ACT + A_VTE); const bf16* R = (const bf16*)(F.ws + WS_ACT + A_R);
    LAS float* sc = (LAS float*)(F.lds) + F.wave * 2048;
    const int gw = F.bid * NWAVES + F.wave;
    for (int smp = gw; smp < 1024; smp += F.G * NWAVES) { const unsigned h1 = hsh((unsigned)smp * 2u + 13u + 977u * (unsigned)stage); const int t = (int)(h1 % T), h = (int)((h1 >> 20) & 7), b = t >> 11, n = t & (SL - 1); const size_t kb = (size_t)b * SL;
        const float lgf = -__expf(A.ev_df[j * 8 + h]), lgb = -__expf(A.ev_db[j * 8 + h]);
        for (int kk = 0; kk < 32; ++kk) { const int m = F.lane + 64 * kk; float s = 0.f; for (int d = 0; d < 64; ++d) s += bf2f(PE[(size_t)t * PEW + 1536 + h * 64 + d]) * bf2f(PE[(kb + m) * PEW + 2048 + h * 64 + d]);
            s *= __expf(-lgf * (float)(n & 31)) * __expf(lgf * (float)(m & 63));
            sc[m] = s * ((m <= n) ? __expf(lgf * (float)(n - m)) : __expf(lgb * (float)(m - n))); }
        LDS_WAIT(); const int dv = F.lane; float o = 0.f; for (int m = 0; m < 2048; ++m) o += sc[m] * bf2f(VT[(size_t)(h * 64 + dv) * T + kb + m]);
        const float ss = wave_sum(o * o), rms = rsqrtf(ss * (1.f / 64.f) + EPS); const float g = bf2f(PE[(size_t)t * PEW + 2560 + h * 64 + dv]);
        ck_acc(c, bf2f(R[(size_t)t * D + 512 + h * 64 + dv]), o * rms * A.ev_gn[j * 512 + h * 64 + dv] * g / (1.f + __expf(-g)));
        LDS_WAIT(); }
    CK_LOOP(4096) { const unsigned h1 = hsh(s_ * 2u + 15u + 977u * (unsigned)stage), h2 = hsh(h1 + 5u); const int t = (int)(h1 % T), cc = (int)(h2 % 512), l = t & (SL - 1); const float* cw = A.ev_conv + (size_t)j * 1536;
        float acc = 0.f; for (int d = 0; d < 3; ++d) { const int tt = t + d - 1; const bool ok = (d == 0) ? (l > 0) : (d == 2) ? (l < SL - 1) : true;
            if (ok) acc += cw[d * 512 + cc] * bf2f(PE[(size_t)tt * PEW + 512 + cc]) * bf2f(PE[(size_t)tt * PEW + 1024 + cc]); }
        ck_acc(c2, bf2f(R[(size_t)t * D + cc]), acc * bf2f(PE[(size_t)t * PEW + cc])); }
    ck_flush(F, stage, c); ck_flush(F, stage + 1, c2);
}
__device__ __forceinline__ void ck_route(Frame& F, const Args& A, int stage, int i, int j) {
    Ck c = {0.f, 0.f}, c2 = {0.f, 0.f}; const bf16* X = (const bf16*)(F.ws + WS_XB); TileBase B; load_tilebase(F, j, B);
    const int* epos = (const int*)(F.ws + WS_MISC + MISC_EPOS); const float* gate = (const float*)(F.ws + WS_MISC + MISC_GATE); const int* yrow = (const int*)(F.ws + WS_MISC + MISC_YROW);
    CK_LOOP(2048) { const unsigned h1 = hsh(s_ * 2u + 17u + 977u * (unsigned)stage); const int t = (int)(h1 % T); const float rs = rs_naive(X, t);
        float lg[8];
#pragma unroll
        for (int e = 0; e < 8; ++e) lg[e] = rs * dotx(X, t, A.ffn_g + i * D, A.router + (size_t)j * D * NE, NE, e);
        int i1 = 0; float m1 = lg[0];
#pragma unroll
        for (int e = 1; e < 8; ++e) if (lg[e] > m1) { m1 = lg[e]; i1 = e; }
        int i2 = -1; float m2 = -3e38f;
#pragma unroll
        for (int e = 0; e < 8; ++e) if (e != i1 && lg[e] > m2) { m2 = lg[e]; i2 = e; }
        const float w1 = 1.f / (1.f + __expf(m2 - m1));
        const int e0 = epos[2 * t] >> 20, e1 = epos[2 * t + 1] >> 20;
        ck_acc(c, (e0 == i1 && e1 == i2) ? 1.f : 0.f, 1.f); ck_acc(c, gate[2 * t], w1); ck_acc(c, gate[2 * t + 1], 1.f - w1);
        const int r0 = yrow[2 * t]; int tbe = 0;
#pragma unroll
        for (int k = 0; k < 8; ++k) if (k == e0) tbe = B.tb[k];
        ck_acc(c2, (float)r0, (float)(tbe * 256 + (epos[2 * t] & 0xfffff)));
        const int cc = (int)(hsh(h1) % D); ck_acc(c2, f8tof((F.ws + WS_ACT + A_XS)[(size_t)r0 * D + cc]) + 8.f, bf2f(((const bf16*)(F.ws + WS_XB))[(size_t)t * D + cc]) * rs + 8.f); }
    ck_flush(F, stage, c); ck_flush(F, stage + 1, c2);
}
__device__ __forceinline__ void ck_moe(Frame& F, const Args& A, int stage, int which, int i, int j, int lo, int hi) {
    Ck c = {0.f, 0.f}; const bf16* X = (const bf16*)(F.ws + WS_XB); const int* epos = (const int*)(F.ws + WS_MISC + MISC_EPOS); const int* yrow = (const int*)(F.ws + WS_MISC + MISC_YROW);
    const unsigned char* HID = F.ws + WS_ACT + A_HID; const bf16* Y = (const bf16*)(F.ws + WS_ACT + A_Y);
    CK_LOOP(4096) { const unsigned h1 = hsh(s_ * 2u + 19u + 977u * (unsigned)stage), h2 = hsh(h1 + 3u); const int tk = (int)(h1 % (2 * T)), t = tk >> 1, e = epos[tk] >> 20, r = yrow[tk];
        if (r < lo * 256 || r >= hi * 256) continue;
        const size_t wo = ((size_t)j * NE + e) * (size_t)D * FE;
        if (which == 0) { const int cc = (int)(h2 % FE); const float rs = rs_naive(X, t); const float a = rs * dotx(X, t, A.ffn_g + i * D, A.moe_g + wo, FE, cc), b = rs * dotx(X, t, A.ffn_g + i * D, A.moe_u + wo, FE, cc);
            ck_acc(c, f8tof(HID[(size_t)(r - lo * 256) * FE + cc]) * (1.f / MOE_HSCALE), a / (1.f + __expf(-a)) * b); }
        else { const int cc = (int)(h2 % D); float s = 0.f; for (int k = 0; k < FE; ++k) s += f8tof(HID[(size_t)(r - lo * 256) * FE + k]) * (1.f / MOE_HSCALE) * A.moe_d[wo + (size_t)k * D + cc];
            ck_acc(c, bf2f(Y[(size_t)r * D + cc]), s); } }
    ck_flush(F, stage, c);
}
__device__ __forceinline__ void ck_comb(Frame& F, const Args& A, int stage, const bf16* xprev, bool last) {
    Ck c = {0.f, 0.f}; const bf16* Y = (const bf16*)(F.ws + WS_ACT + A_Y); const int* yrow = (const int*)(F.ws + WS_MISC + MISC_YROW); const float* gate = (const float*)(F.ws + WS_MISC + MISC_GATE);
    CK_LOOP(2048) { const unsigned h1 = hsh(s_ * 2u + 23u + 977u * (unsigned)stage), h2 = hsh(h1 + 1u); const int t = (int)(h1 % T), cc = (int)(h2 % D); const int r0 = yrow[2 * t], r1 = yrow[2 * t + 1]; const float g0 = gate[2 * t], g1 = gate[2 * t + 1];
        float ss = 0.f, vc = 0.f; for (int k = 0; k < D; ++k) { const float v = bf2f(xprev[(size_t)t * D + k]) + g0 * bf2f(Y[(size_t)r0 * D + k]) + g1 * bf2f(Y[(size_t)r1 * D + k]); ss += v * v; if (k == cc) vc = v; }
        const float ref = last ? vc * rsqrtf(ss * (1.f / D) + EPS) * A.fin_g[cc] : vc; ck_acc(c, last ? A.out[(size_t)t * D + cc] : bf2f(((const bf16*)(F.ws + WS_XB))[(size_t)t * D + cc]), ref); }
    ck_flush(F, stage, c);
}
__device__ __forceinline__ void copy_x(Frame& F, const Args& A, float* dst) {
    for (size_t it = (size_t)F.bid * NTHR + F.tid; it < (size_t)T * D / 4; it += (size_t)F.G * NTHR) ((f32x4*)dst)[it] = ((const f32x4*)A.out)[it];
}
#endif

enum { PH_PRO = 0, PH_MEMKV, PH_E1, PH_RETKV, PH_RETSCAN, PH_RETOUT, PH_D1, PH_DATTN, PH_OUTRES, PH_X1, PH_XATTN, PH_X3, PH_F1, PH_F2, PH_ROUTER, PH_GATHER, PH_M1, PH_M2, PH_COMB, PH_COUNT };
#define XB ((bf16*)(F.ws + WS_XB))
#define SSQ ((float*)(F.ws + WS_SSQ))
#define ACT (F.ws + WS_ACT)
__device__ __forceinline__ float lambda_init_of(int i) { return 0.8f - 0.6f * __expf(-0.3f * (float)i); }
template <int PH> __device__ __forceinline__ void run_phase(Frame& F, const Args& A, int i, int half, int vcu) {
    const int j = i >> 1; PG8_LAS unsigned char* const ring = (PG8_LAS unsigned char*)F.lds;
    if constexpr (PH == PH_PRO) { prologue_phase(F, A); moe_convert(F, A, 0); moe_convert(F, A, 1); }
    if constexpr (PH == PH_MEMKV) {
        { pg8::Gemm g{(const bf16*)(F.ws + WS_MEMN), (const bf16*)(F.ws + WS_WK), MT, 4096, D}; pg8::StaticOrder S; S.init(MT, 4096, F.G, F.bid);
          pg8::EpiRow<0> E{(bf16*)(F.ws + WS_KX), 4096, nullptr, nullptr, 1.f}; pg8::gemm_phase<pg8::EpiRow<0>, pg8::StaticOrder, true, true>(ring, g, S, E, F.tid); }
        { pg8::Gemm g{(const bf16*)(F.ws + WS_WV), (const bf16*)(F.ws + WS_MEMN), 4096, MT, D}; pg8::StaticOrder S; S.init(4096, MT, F.G, F.bid);
          pg8::EpiRow<0> E{(bf16*)(F.ws + WS_VTX), 4096, nullptr, nullptr, 1.f}; pg8::gemm_phase<pg8::EpiRow<0>, pg8::StaticOrder, true, true>(ring, g, S, E, F.tid); }
    }
    if constexpr (PH == PH_E1) { unsigned char* eb = F.ws + WS_EV + j * EV_STRIDE;
        { pg8::Gemm g{XB, (const bf16*)(eb + EV_INN), T, 3072, D}; pg8::StaticOrder S; S.init(T, 3072, F.G, F.bid);
          pg8::EpiRow<1> E{(bf16*)(ACT + A_PE), PEW, SSQ, A.pos, 1.f, A.ev_df + j * 8, A.ev_db + j * 8}; pg8::gemm_phase<pg8::EpiRow<1>, pg8::StaticOrder, true, true>(ring, g, S, E, F.tid); }
        { pg8::Gemm g{(const bf16*)(eb + EV_INS), XB, 512, T, D}; pg8::StaticOrder S; S.init(512, T, F.G, F.bid);
          pg8::EpiCol<0> E{(bf16*)(ACT + A_VTE), nullptr, nullptr, (size_t)T, SSQ, nullptr, nullptr, nullptr};
          pg8::gemm_phase<pg8::EpiCol<0>, pg8::StaticOrder, true, true>(ring, g, S, E, F.tid); }
    }
    if constexpr (PH == PH_RETKV) { Frame P = F; P.bid = vcu; fret_phase(P, A, j); }
    if constexpr (PH == PH_D1) { unsigned char* ob = F.ws + WS_OD + j * OD_STRIDE;
        { pg8::Gemm g{XB, (const bf16*)(ob + OD_INN), T, 2048, D}; pg8::StaticOrder S; S.init(T, 2048, F.G, F.bid);
          pg8::EpiRow<2> E{(bf16*)(ACT + A_QK), QKP, SSQ, A.pos, 1.f}; pg8::gemm_phase<pg8::EpiRow<2>, pg8::StaticOrder, true, true>(ring, g, S, E, F.tid); }
        { pg8::Gemm g{(const bf16*)(ob + OD_INS), XB, 1024, T, D}; pg8::StaticOrder S; S.init(1024, T, F.G, F.bid);
          pg8::EpiCol<0> E{(bf16*)(ACT + A_VTD), nullptr, nullptr, (size_t)VTP, SSQ, nullptr, nullptr, nullptr};
          pg8::gemm_phase<pg8::EpiCol<0>, pg8::StaticOrder, true, true>(ring, g, S, E, F.tid); }
    }
    if constexpr (PH == PH_DATTN) { Frame P = F; P.bid = vcu; dattn_phase(P, A, j, lambda_init_of(i)); }
    if constexpr (PH == PH_OUTRES) {
        const bf16* mixA = (i & 1) ? (const bf16*)(ACT + A_AO) : (const bf16*)(ACT + A_R);
        const bf16* mixB = (i & 1) ? (const bf16*)(F.ws + WS_OD + j * OD_STRIDE + OD_OUT) : (const bf16*)(F.ws + WS_EV + j * EV_STRIDE + EV_OUT);
        pg8::Gemm g{mixA, mixB, T, D, D}; pg8::StaticOrder S; S.init(T, D, F.G, F.bid);
        if (half) { pg8::EpiRes E{(bf16*)(ACT + 256 * MiB), (float*)(ACT + 320 * MiB), 1.f}; pg8::gemm_phase<pg8::EpiRes, pg8::StaticOrder, true, true>(ring, g, S, E, F.tid); }
        else { typedef pg8::EpiResT<(long long)(WS_ACT + A_XB8) - (long long)WS_XB> EpiRes8; EpiRes8 E{XB, SSQ, 1.f}; pg8::gemm_phase<EpiRes8, pg8::StaticOrder, true, true>(ring, g, S, E, F.tid); }
    }
    if constexpr (PH == PH_X1) { pg8::Gemm g{(const bf16*)(ACT + A_XB8), (const bf16*)(F.ws + WS_WQ + (size_t)i * D * D), T, D, D / 2}; pg8::StaticOrder S; S.init(T, D, F.G, F.bid);
        pg8::EpiRow<0> E{(bf16*)(ACT + A_QX), 1024, SSQ, nullptr, LOG2E / 16.f / MOE_WSCALE}; pg8::gemm_phase<pg8::EpiRow<0>, pg8::StaticOrder, true, true, true>(ring, g, S, E, F.tid); }
    if constexpr (PH == PH_XATTN) { Frame P = F; P.bid = vcu; xattn_phase(P, i); }
    if constexpr (PH == PH_X3) { pg8::Gemm g{(const bf16*)(ACT + A_OX), (const bf16*)(F.ws + WS_WO + (size_t)i * D * D), T, D, D / 2};
        pg8::StaticOrder S; S.init(T, D, F.G, F.bid); if (half) { pg8::EpiRes E{(bf16*)(ACT + 256 * MiB), (float*)(ACT + 320 * MiB), 1.f / (MOE_WSCALE * 4.f)}; pg8::gemm_phase<pg8::EpiRes, pg8::StaticOrder, true, true, true>(ring, g, S, E, F.tid); }
        else if (i & 1) { pg8::EpiRes E{XB, SSQ, 1.f / (MOE_WSCALE * 4.f)}; pg8::gemm_phase<pg8::EpiRes, pg8::StaticOrder, true, true, true>(ring, g, S, E, F.tid); }
        else { typedef pg8::EpiResT<(long long)(WS_ACT + A_XB8) - (long long)WS_XB> EpiRes8; EpiRes8 E{XB, SSQ, 1.f / (MOE_WSCALE * 4.f)}; pg8::gemm_phase<EpiRes8, pg8::StaticOrder, true, true, true>(ring, g, S, E, F.tid); } }
    if constexpr (PH == PH_F1) { pg8::Gemm g{(const bf16*)(ACT + A_XB8), (const bf16*)(F.ws + WS_EV + j * EV_STRIDE + EV_GU), T, 2 * FF, D / 2}; pg8::StaticOrder S; S.init(T, 2 * FF, F.G, F.bid);
        pg8::EpiSwiT<true> E{(void*)(ACT + A_H), FF, SSQ, 22, 1.f / MOE_WSCALE, MOE_HSCALE}; pg8::gemm_phase<pg8::EpiSwiT<true>, pg8::StaticOrder, true, true, true>(ring, g, S, E, F.tid); }
    if constexpr (PH == PH_F2) { pg8::Gemm g{(const bf16*)(ACT + A_H), (const bf16*)(F.ws + WS_EV + j * EV_STRIDE + EV_DN), T, D, FF / 2}; pg8::StaticOrder S; S.init(T, D, F.G, F.bid);
        pg8::EpiRes E{half ? (bf16*)(ACT + 304 * MiB) : XB, half ? (float*)(ACT + 368 * MiB) : SSQ, 1.f / (MOE_WSCALE * MOE_HSCALE)}; pg8::gemm_phase<pg8::EpiRes, pg8::StaticOrder, true, true, true>(ring, g, S, E, F.tid); }
    if constexpr (PH == PH_ROUTER) router_phase(F, A, i, j, j + 2 * half);
    if constexpr (PH == PH_GATHER) gather_phase(F, j);
    if constexpr (PH == PH_M1 || PH == PH_M2) {
        pg8::MoeOrder S; TileBase B; load_tilebase(F, j, B);
#pragma unroll
        for (int k = 0; k < 9; ++k) S.tb[k] = B.tb[k];
        S.nM = B.tb[8]; S.G = F.G; S.c = F.bid; S.lo = 0;
        if constexpr (PH == PH_M1) { S.nN = 28; S.nwg = S.nM * 28;
            pg8::Gemm g{(const bf16*)(ACT + A_XS), (const bf16*)(F.ws + WS_MOE + (size_t)j * MOE_STRIDE), 0, 0, D / 2};
            pg8::EpiSwiT<true> E{(void*)(ACT + A_HID), FE, nullptr, 28, 1.f / MOE_WSCALE, MOE_HSCALE};
            pg8::gemm_phase<pg8::EpiSwiT<true>, pg8::MoeOrder, true, true, true>(ring, g, S, E, F.tid); }
        else { S.nN = 4; S.nwg = S.nM * 4;
            pg8::Gemm g{(const bf16*)(ACT + A_HID), (const bf16*)(F.ws + WS_MOE + (size_t)j * MOE_STRIDE + MOE_DN), 0, 0, FE / 2};
            pg8::EpiY E{(bf16*)(ACT + A_Y), 1024, 4, 1.f / (MOE_WSCALE * MOE_HSCALE)};
            pg8::gemm_phase<pg8::EpiY, pg8::MoeOrder, true, true, true>(ring, g, S, E, F.tid); }
    }
    if constexpr (PH == PH_COMB) combine_phase(F, A, i == 3, half);
}
__device__ __forceinline__ void make_frame(Frame& F, const Args& A, unsigned char* lds_raw, int& vcu) {
    F.lds = (LAS unsigned char*)lds_raw; F.tid = threadIdx.x; F.lane = F.tid & 63; F.wave = __builtin_amdgcn_readfirstlane(F.tid >> 6);
    F.G = gridDim.x; F.bid = blockIdx.x; F.ws = A.ws; F.ctl = (gu32*)(A.ws + WS_CTL);
    vcu = (F.G % 8 == 0) ? (F.bid % 8) * (F.G / 8) + F.bid / 8 : F.bid;
}


constexpr int NPHASES = 48;
__global__ void __launch_bounds__(NTHR, 2) fwd(Args A_) {
#if defined(__HIP_DEVICE_COMPILE__)
    extern __shared__ __attribute__((aligned(16))) unsigned char lds_raw[];
    typedef const Args __attribute__((address_space(4))) * KArgsP;
    KArgsP ap = (KArgsP)__builtin_amdgcn_kernarg_segment_ptr();
    { LAS unsigned char* lds = (LAS unsigned char*)lds_raw;
      for (int u = threadIdx.x; u < (LDS_BYTES - LDSCTL_OFF) / 4; u += NTHR) ((LAS unsigned*)(lds + LDSCTL_OFF))[u] = 0u; }
    int wave_s = __builtin_amdgcn_readfirstlane((int)threadIdx.x >> 6); asm volatile("" : "+s"(wave_s));
    __syncthreads();
    (void)xcd_barrier_post((unsigned*)(A_.ws + WS_CTL) + CW_BAR, (volatile LAS unsigned*)((LAS unsigned char*)lds_raw + LDSCTL_OFF));
#define RUN(PH, i, half) do { { unsigned lo_ = (unsigned)(unsigned long long)ap, hi_ = (unsigned)((unsigned long long)ap >> 32); asm volatile("" : "+v"(lo_), "+v"(hi_)); \
          ap = (KArgsP)(((unsigned long long)(unsigned)__builtin_amdgcn_readfirstlane((int)hi_) << 32) | (unsigned long long)(unsigned)__builtin_amdgcn_readfirstlane((int)lo_)); } Frame P; int vcu_; const Args AL = *ap; \
        { P.lds = (LAS unsigned char*)lds_raw; unsigned z_ = 0u; asm volatile("" : "+v"(z_)); int t_ = wave_s * 64 + (int)__builtin_amdgcn_mbcnt_hi(~0u, __builtin_amdgcn_mbcnt_lo(~0u, z_)); P.tid = t_; P.lane = t_ & 63; P.wave = __builtin_amdgcn_readfirstlane(t_ >> 6); \
          P.G = gridDim.x; P.bid = blockIdx.x; P.ws = AL.ws; P.ctl = (gu32*)(P.ws + WS_CTL); vcu_ = (P.G % 8 == 0) ? (P.bid % 8) * (P.G / 8) + P.bid / 8 : P.bid; } \
        run_phase<PH>(P, AL, (i), (half), vcu_); } while (0)
#define SEAM() do { XcdBarrier b_; b_.bar = (unsigned*)(ap->ws + WS_CTL) + CW_BAR; b_.x = xb_xcc_id(); b_.st = (volatile LAS unsigned*)((LAS unsigned char*)lds_raw + LDSCTL_OFF); { unsigned zb_ = 0u; asm volatile("" : "+v"(zb_)); b_.t0 = (wave_s == 0) && (__builtin_amdgcn_mbcnt_hi(~0u, __builtin_amdgcn_mbcnt_lo(~0u, zb_)) == 0u); } xcd_barrier(b_); } while (0)
#ifndef DUPMASK
#define DUPMASK 0u
#endif
#define RUNS(PH, i, half) do { if ((DUPMASK >> PH) & 1u) { RUN(PH, i, 1); SEAM(); } RUN(PH, i, 0); SEAM(); } while (0)
    RUNS(PH_PRO, 0, 0); RUN(PH_MEMKV, 0, 0);
    for (int i = 0; i < 4; ++i) {
        if ((i & 1) == 0) { RUNS(PH_E1, i, 0); RUNS(PH_RETKV, i, 0); }
        else { RUNS(PH_D1, i, 0); RUNS(PH_DATTN, i, 0); }
        RUNS(PH_OUTRES, i, 0); RUNS(PH_X1, i, 0); RUNS(PH_XATTN, i, 0); RUNS(PH_X3, i, 0);
        if ((i & 1) == 0) { RUNS(PH_F1, i, 0); RUNS(PH_F2, i, 0); }
        else { RUNS(PH_ROUTER, i, 0); RUNS(PH_GATHER, i, 0);
            RUNS(PH_M1, i, 0); RUNS(PH_M2, i, 0);
            if ((DUPMASK >> PH_COMB) & 1u) { RUN(PH_COMB, i, 1); SEAM(); } RUN(PH_COMB, i, 0); if (i != 3) SEAM(); }
    }
#undef RUN
#undef SEAM
#endif
}
#undef XB
#undef SSQ
#undef ACT
extern "C" void kernel_launch(void* const* d_in, const int* in_sizes, int n_in, void* d_out, int out_size, void* d_ws, size_t ws_size, hipStream_t stream) {
    static int grid = 0;
    if (grid == 0) {
        if (n_in != 31 || out_size != T * D || ws_size < WS_END) { fprintf(stderr, "kernel_launch: unexpected shapes (n_in %d, out %d, ws %zu < %zu)\n", n_in, out_size, ws_size, (size_t)WS_END); grid = -1; return; }
        int dev = 0, cus = 0, per_cu = 0;
        if (hipGetDevice(&dev) != hipSuccess || hipDeviceGetAttribute(&cus, hipDeviceAttributeMultiprocessorCount, dev) != hipSuccess) { grid = -1; return; }
        if (hipFuncSetAttribute((const void*)fwd, hipFuncAttributeMaxDynamicSharedMemorySize, LDS_BYTES) != hipSuccess) { fprintf(stderr, "kernel_launch: hipFuncSetAttribute failed\n"); grid = -1; return; }
        if (hipOccupancyMaxActiveBlocksPerMultiprocessor(&per_cu, (const void*)fwd, NTHR, LDS_BYTES) != hipSuccess || per_cu < 1) fprintf(stderr, "kernel_launch: occupancy query reports %d\n", per_cu);
        (void)hipGetLastError();
        grid = cus;
    }
    if (grid < 0) return;
    if (hipMemsetAsync((char*)d_ws + WS_CTL, 0, CTL_BYTES, stream) != hipSuccess) return;
    Args a{};
    const float** fp = (const float**)&a;
    for (int k = 0; k < 31; ++k) fp[k] = (const float*)d_in[k];
    a.out = (float*)d_out; a.ws = (unsigned char*)d_ws; a.ph_lo = 0; a.ph_hi = NPHASES;
    hipLaunchKernelGGL(fwd, dim3(grid), dim3(NTHR), LDS_BYTES, stream, a);
}
```

```cpp
#include <hip/hip_runtime.h>
#include <cstdio>
#include <cstdint>
#define DBG 0
namespace pg8 {
#define PG8_LAS __attribute__((address_space(3)))
typedef unsigned short bf16_t;
typedef short bf16x8 __attribute__((ext_vector_type(8)));
typedef float f32x4 __attribute__((ext_vector_type(4)));
typedef unsigned u32x4 __attribute__((ext_vector_type(4)));
constexpr int BM = 256, BK = 64, HALF = 128, HTB = HALF * BK * 2  , STAGE_BYTES = 8 * HTB, NXCD = 8, WGM = 8;

__host__ __device__ __forceinline__ int lds_byte(int r, int c) { const int st = (r >> 4) * 2 + (c >> 5), rr = r & 15, cc = c & 31, ob = rr * 64 + cc * 2; return st * 1024 + (ob ^ (((ob >> 9) & 1) << 5)); }
__host__ __device__ __forceinline__ void stage_rc(int b, int& R, int& C) { const int st = b / 1024, sb = b % 1024, swz = sb ^ (((sb >> 9) & 1) << 5); R = (st >> 1) * 16 + swz / 64; C = (st & 1) * 32 + (swz % 64) / 2; }
__host__ __device__ __forceinline__ int perm32(int rho) { const int n = rho >> 4, i = rho & 15; return 8 * (i >> 2) + 4 * n + (i & 3); }

struct Unit { int pm, pn; };
#ifdef GPROBE_ID
__device__ unsigned gp_buf[4];
#endif
struct Gemm { const bf16_t* A; const bf16_t* Bt; int M, N, K; };

struct StaticOrder {
    int nM, nN, nwg, G, c;
    __host__ __device__ void init(int M, int N, int G_, int c_) { nM = M / BM; nN = N / BM; nwg = nM * nN; G = G_; c = c_; }
    __host__ __device__ bool next(int i, Unit& u) const {
        const long L = (long)i * G + c; if (L >= nwg) return false;
        int wgid = (int)L; { const int q = nwg / NXCD, r = nwg % NXCD, xcd = wgid % NXCD, off = wgid / NXCD; wgid = (xcd < r ? xcd * (q + 1) : r * (q + 1) + (xcd - r) * q) + off; }
        const int nig = WGM * nN, gid = wgid / nig, fm = gid * WGM, gsz = (nM - fm) < WGM ? (nM - fm) : WGM;
        u.pm = fm + ((wgid % nig) % gsz); u.pn = (wgid % nig) / gsz; return true;
    }
    __device__ __forceinline__ void a_ready(const Unit&) const {}
    __device__ __forceinline__ void done(const Unit&) const {}
};

typedef float f32x2 __attribute__((ext_vector_type(2)));
typedef int v4i_t __attribute__((ext_vector_type(4)));
typedef int v8i_t __attribute__((ext_vector_type(8)));
__device__ __forceinline__ v8i_t cat8(bf16x8 a, bf16x8 b) { const v4i_t x = __builtin_bit_cast(v4i_t, a), y = __builtin_bit_cast(v4i_t, b); return __builtin_shufflevector(x, y, 0, 1, 2, 3, 4, 5, 6, 7); }
__device__ __forceinline__ unsigned pack_fp8x4(float a, float b, float c, float d) {
    a = fminf(fmaxf(a, -440.f), 440.f); b = fminf(fmaxf(b, -440.f), 440.f); c = fminf(fmaxf(c, -440.f), 440.f); d = fminf(fmaxf(d, -440.f), 440.f);
    int w = 0; w = __builtin_amdgcn_cvt_pk_fp8_f32(a, b, w, false); w = __builtin_amdgcn_cvt_pk_fp8_f32(c, d, w, true); return (unsigned)w; }
__device__ __forceinline__ unsigned cvt_pk_bf16(float lo, float hi) { unsigned r; asm volatile("v_cvt_pk_bf16_f32 %0, %1, %2" : "=v"(r) : "v"(lo), "v"(hi)); return r; }
__device__ __forceinline__ u32x4 pack8(const f32x4 a, const f32x4 b) { u32x4 w; w.x = cvt_pk_bf16(a[0], a[1]); w.y = cvt_pk_bf16(a[2], a[3]); w.z = cvt_pk_bf16(b[0], b[1]); w.w = cvt_pk_bf16(b[2], b[3]); return w; }
constexpr float RMS_EPS = 1e-6f, INV_D = 1.f / 1024.f, INV_2PI = 0.15915494309189535f, LOG2E = 1.4426950408889634f;
constexpr float L2_RET_THETA_32 = 13.287712379549449f / 32.f;
constexpr float L2_ROPE_THETA_8 = 18.931568569324174f / 8.f;
__device__ __forceinline__ float rs_row4(const float* ssq, int row, int fq) {
    const f32x4 p = *(const f32x4*)(ssq + (size_t)row * 16 + 4 * fq);
    float s = (p[0] + p[1]) + (p[2] + p[3]);
    s += __shfl_xor(s, 16); s += __shfl_xor(s, 32);
    return rsqrtf(s * INV_D + RMS_EPS);
}
__device__ __forceinline__ void sincos_rev(float rev, float& sn, float& cs) { rev -= floorf(rev); sn = __builtin_amdgcn_sinf(rev); cs = __builtin_amdgcn_cosf(rev); }

template <int MODE> struct EpiRow {
    static constexpr bool PERM = true, AFTER_DRAIN = false;
    bf16_t* O; int ldc; const float* ssq; const int* pos; float sc; const float* decf; const float* decb;
    __device__ __forceinline__ void operator()(const f32x4 (&acc)[2][2][4][2], const Unit& u, int wr, int wc, int fr, int fq) const {
        const int row0 = u.pm * BM + wr * 64 + fr, col0 = u.pn * BM + wc * 32 + 8 * fq;
        bool rope = false; float cf[4] = {0.f, 0.f, 0.f, 0.f}; float csc = sc;
        float lgf[2] = {0.f, 0.f}, lgb[2] = {0.f, 0.f};
        if (MODE == 1) { rope = (u.pn >= 6 && u.pn < 10); csc = (u.pn == 8 || u.pn == 9) ? 0.125f : 1.f; const int g = (wc & 1) * 4 + fq;
#pragma unroll
            for (int j = 0; j < 4; ++j) cf[j] = __builtin_amdgcn_exp2f(-(float)(4 * g + j) * L2_RET_THETA_32) * INV_2PI;
            if (rope) {
#pragma unroll
                for (int bj = 0; bj < 2; ++bj) { const int head = 4 * (u.pn & 1) + 2 * bj + (wc >> 1); lgf[bj] = -__expf(decf[head]) * LOG2E; lgb[bj] = -__expf(decb[head]) * LOG2E; } } }
        if (MODE == 2) { rope = ((wc & 1) == 0) && (fq < 2); csc = (u.pn < 4) ? 0.125f * LOG2E : 1.f;
#pragma unroll
            for (int j = 0; j < 4; ++j) cf[j] = __builtin_amdgcn_exp2f(-(float)(4 * fq + j) * L2_ROPE_THETA_8) * INV_2PI; }
        float rsv[8], posv[8];
#pragma unroll
        for (int k = 0; k < 8; ++k) { const int row = row0 + (k >> 2) * HALF + (k & 3) * 16; rsv[k] = ssq ? rs_row4(ssq, row, fq) : 1.f; posv[k] = (MODE != 0) ? (float)pos[row] : 0.f; }
#pragma unroll
        for (int k = 0; k < 8; ++k) asm volatile("" : "+v"(rsv[k]), "+v"(posv[k]));
#pragma unroll
        for (int ai = 0; ai < 2; ++ai)
#pragma unroll
            for (int m = 0; m < 4; ++m) { const int row = row0 + ai * HALF + m * 16;
                const float s = rsv[ai * 4 + m] * csc;
                float sn[4], cs[4];
                if (MODE == 2 || (MODE == 1 && rope)) { const float posf = posv[ai * 4 + m];
#pragma unroll
                    for (int j = 0; j < 4; ++j) sincos_rev(posf * cf[j], sn[j], cs[j]); }
                else {
#pragma unroll
                    for (int j = 0; j < 4; ++j) { sn[j] = 0.f; cs[j] = 1.f; } }
#pragma unroll
                for (int bj = 0; bj < 2; ++bj) { f32x4 v0 = acc[ai][bj][m][0] * s, v1 = acc[ai][bj][m][1] * s;
                    if (MODE != 0) { if (rope) {
#pragma unroll
                        for (int j = 0; j < 4; ++j) { const float x1 = v0[j], x2 = v1[j]; v0[j] = x1 * cs[j] - x2 * sn[j]; v1[j] = x1 * sn[j] + x2 * cs[j]; } } }
                    if (MODE == 1 && rope) {
                        const bool isk = u.pn >= 8; const int lm = isk ? (row & 63) : (row & 31);
                        const float ff = __builtin_amdgcn_exp2f(lgf[bj] * (float)(isk ? -lm : lm)), fb = __builtin_amdgcn_exp2f(lgb[bj] * (float)(isk ? lm : -lm));
                        *(u32x4*)(O + (size_t)row * ldc + col0 + bj * HALF) = pack8(v0 * ff, v1 * ff);
                        *(u32x4*)(O + (size_t)row * ldc + col0 + bj * HALF + 1536) = pack8(v0 * fb, v1 * fb); }
                    else *(u32x4*)(O + (size_t)row * ldc + col0 + bj * HALF) = pack8(v0, v1); } }
    }
};

template <int MODE> struct EpiCol {
    static constexpr bool PERM = true, AFTER_DRAIN = false;
    bf16_t* O; bf16_t* KF; bf16_t* KB; size_t ldc; const float* ssq; const int* pos; const float* decf; const float* decb;
    __device__ __forceinline__ float rs_tok(int tok, int fr) const { float p = ssq[(size_t)tok * 16 + fr]; p += __shfl_xor(p, 1); p += __shfl_xor(p, 2); p += __shfl_xor(p, 4); p += __shfl_xor(p, 8); return rsqrtf(p * INV_D + RMS_EPS); }
    __device__ __forceinline__ void operator()(const f32x4 (&acc)[2][2][4][2], const Unit& u, int wr, int wc, int fr, int fq) const {
        const int R0 = u.pm * BM + wr * 64 + fr, tok0 = u.pn * BM + wc * 32 + 8 * fq;
        typedef unsigned u32x2v __attribute__((ext_vector_type(2)));
        float rs16[16];
        if (ssq) { const int tkm = tok0 + (fr >> 3) * HALF + (fr & 7); const f32x4* sp = (const f32x4*)(ssq + (size_t)tkm * 16); const f32x4 s0 = sp[0], s1 = sp[1], s2 = sp[2], s3 = sp[3];
            const float pp = ((s0[0] + s0[1]) + (s0[2] + s0[3])) + ((s1[0] + s1[1]) + (s1[2] + s1[3])) + ((s2[0] + s2[1]) + (s2[2] + s2[3])) + ((s3[0] + s3[1]) + (s3[2] + s3[3]));
            const float myrs = rsqrtf(pp * INV_D + RMS_EPS); const int lb = (fq << 4);
#pragma unroll
            for (int t = 0; t < 16; ++t) rs16[t] = __shfl(myrs, lb + t); }
        else {
#pragma unroll
            for (int t = 0; t < 16; ++t) rs16[t] = 1.f; }
#pragma unroll
        for (int bj = 0; bj < 2; ++bj)
#pragma unroll
            for (int n = 0; n < 2; ++n) { const int tk = tok0 + bj * HALF + 4 * n;
                f32x4 rs;
#pragma unroll
                for (int j = 0; j < 4; ++j) rs[j] = rs16[bj * 8 + n * 4 + j];
                if (MODE == 1 && u.pm < 2) {
                    f32x4 posf;
#pragma unroll
                    for (int j = 0; j < 4; ++j) posf[j] = (float)pos[tk + j];
#pragma unroll
                    for (int mm = 0; mm < 2; ++mm) { const float cfm = __builtin_amdgcn_exp2f(-(float)(16 * mm + fr) * L2_RET_THETA_32) * INV_2PI;
                        f32x4 sn, cs;
#pragma unroll
                        for (int j = 0; j < 4; ++j) { float a, b; sincos_rev(posf[j] * cfm, a, b); sn[j] = a; cs[j] = b; }
#pragma unroll
                        for (int ai = 0; ai < 2; ++ai) { const int head = u.pm * 4 + ai * 2 + wr;
                            const float lgf = -__expf(decf[head]) * LOG2E, lgb = -__expf(decb[head]) * LOG2E;
                            const f32x4 x1 = acc[ai][bj][mm][n] * (rs * 0.125f), x2 = acc[ai][bj][mm + 2][n] * (rs * 0.125f);
                            const f32x4 y1 = x1 * cs - x2 * sn, y2 = x1 * sn + x2 * cs;
                            f32x4 wf, wb;
#pragma unroll
                            for (int j = 0; j < 4; ++j) { const int ci = (tk + j) & 127; wf[j] = __builtin_amdgcn_exp2f(lgf * (float)(127 - ci)); wb[j] = __builtin_amdgcn_exp2f(lgb * (float)ci); }
                            const size_t o1 = (size_t)(R0 + ai * HALF + mm * 16) * ldc + tk, o2 = o1 + (size_t)32 * ldc;
                            f32x4 t; u32x2v w;
                            t = y1 * wf; w.x = cvt_pk_bf16(t[0], t[1]); w.y = cvt_pk_bf16(t[2], t[3]); *(u32x2v*)(KF + o1) = w;
                            t = y2 * wf; w.x = cvt_pk_bf16(t[0], t[1]); w.y = cvt_pk_bf16(t[2], t[3]); *(u32x2v*)(KF + o2) = w;
                            t = y1 * wb; w.x = cvt_pk_bf16(t[0], t[1]); w.y = cvt_pk_bf16(t[2], t[3]); *(u32x2v*)(KB + o1) = w;
                            t = y2 * wb; w.x = cvt_pk_bf16(t[0], t[1]); w.y = cvt_pk_bf16(t[2], t[3]); *(u32x2v*)(KB + o2) = w; } }
                } else {
                    const int Roff = (MODE == 1) ? -512 : 0;
#pragma unroll
                    for (int ai = 0; ai < 2; ++ai)
#pragma unroll
                        for (int m = 0; m < 4; ++m) { const f32x4 t = acc[ai][bj][m][n] * rs; u32x2v w; w.x = cvt_pk_bf16(t[0], t[1]); w.y = cvt_pk_bf16(t[2], t[3]);
                            *(u32x2v*)(O + (size_t)(R0 + Roff + ai * HALF + m * 16) * ldc + tk) = w; }
                } }
    }
};

template <long long X8OFF = 0> struct EpiResT {
    static constexpr bool PERM = true, AFTER_DRAIN = false;
    bf16_t* XB; float* ssq; float sc;
    __device__ __forceinline__ void operator()(const f32x4 (&acc)[2][2][4][2], const Unit& u, int wr, int wc, int fr, int fq) const {
        const int row0 = u.pm * BM + wr * 64 + fr, col0 = u.pn * BM + wc * 32 + 8 * fq;
        u32x4 xv[4][2];
#pragma unroll
        for (int m = 0; m < 4; ++m)
#pragma unroll
            for (int bj = 0; bj < 2; ++bj) xv[m][bj] = *(const u32x4*)(XB + (size_t)(row0 + m * 16) * 1024 + col0 + bj * HALF);
#pragma unroll
        for (int ai = 0; ai < 2; ++ai) {
            float ss[4];
#pragma unroll
            for (int m = 0; m < 4; ++m) { bf16_t* xr = XB + (size_t)(row0 + ai * HALF + m * 16) * 1024 + col0; ss[m] = 0.f;
#pragma unroll
                for (int bj = 0; bj < 2; ++bj) { const u32x4 x = xv[m][bj]; f32x4 a, b;
                    if (ai == 0) xv[m][bj] = *(const u32x4*)(XB + (size_t)(row0 + HALF + m * 16) * 1024 + col0 + bj * HALF);
                    a[0] = __builtin_bit_cast(float, x.x << 16); a[1] = __builtin_bit_cast(float, x.x & 0xffff0000u); a[2] = __builtin_bit_cast(float, x.y << 16); a[3] = __builtin_bit_cast(float, x.y & 0xffff0000u);
                    b[0] = __builtin_bit_cast(float, x.z << 16); b[1] = __builtin_bit_cast(float, x.z & 0xffff0000u); b[2] = __builtin_bit_cast(float, x.w << 16); b[3] = __builtin_bit_cast(float, x.w & 0xffff0000u);
                    a = a + acc[ai][bj][m][0] * sc; b = b + acc[ai][bj][m][1] * sc;
                    const u32x4 w = pack8(a, b); *(u32x4*)(xr + bj * HALF) = w;
                    a[0] = __builtin_bit_cast(float, w.x << 16); a[1] = __builtin_bit_cast(float, w.x & 0xffff0000u); a[2] = __builtin_bit_cast(float, w.y << 16); a[3] = __builtin_bit_cast(float, w.y & 0xffff0000u);
                    b[0] = __builtin_bit_cast(float, w.z << 16); b[1] = __builtin_bit_cast(float, w.z & 0xffff0000u); b[2] = __builtin_bit_cast(float, w.w << 16); b[3] = __builtin_bit_cast(float, w.w & 0xffff0000u);
                    if constexpr (X8OFF != 0) { typedef unsigned u32x2v __attribute__((ext_vector_type(2))); u32x2v o; o.x = pack_fp8x4(a[0], a[1], a[2], a[3]); o.y = pack_fp8x4(b[0], b[1], b[2], b[3]);
                        *(u32x2v*)((unsigned char*)XB + X8OFF + (size_t)(row0 + ai * HALF + m * 16) * 1024 + col0 + bj * HALF) = o; }
                    ss[m] += (a[0] * a[0] + a[1] * a[1]) + (a[2] * a[2] + a[3] * a[3]) + (b[0] * b[0] + b[1] * b[1]) + (b[2] * b[2] + b[3] * b[3]); } }
#pragma unroll
            for (int m = 0; m < 4; ++m) ss[m] += __shfl_xor(ss[m], 16);
#pragma unroll
            for (int m = 0; m < 4; ++m) ss[m] += __shfl_xor(ss[m], 32);
            if (fq == 0) {
#pragma unroll
                for (int m = 0; m < 4; ++m) ssq[(size_t)(row0 + ai * HALF + m * 16) * 16 + u.pn * 4 + wc] = ss[m]; }
        }
    }
};

typedef EpiResT<0> EpiRes;

template <bool F8OUT> struct EpiSwiT {
    static constexpr bool PERM = true, AFTER_DRAIN = false;
    void* O; int ldc; const float* ssq; int nN; float asc, osc;
    __device__ __forceinline__ void operator()(const f32x4 (&acc)[2][2][4][2], const Unit& u, int wr, int wc, int fr, int fq) const {
        const int row0 = u.pm * BM + wr * 64 + fr, col0 = (u.pn % nN) * HALF + wc * 32 + 8 * fq;
        float rsv[8];
#pragma unroll
        for (int k = 0; k < 8; ++k) { const int row = row0 + (k >> 2) * HALF + (k & 3) * 16; rsv[k] = F8OUT ? (ssq ? rs_row4(ssq, row, fq) * asc : asc) : rs_row4(ssq, row, fq); }
        if (ssq) {
#pragma unroll
            for (int k = 0; k < 8; ++k) asm volatile("" : "+v"(rsv[k])); }
#pragma unroll
        for (int ai = 0; ai < 2; ++ai)
#pragma unroll
            for (int m = 0; m < 4; ++m) { const int row = row0 + ai * HALF + m * 16;
                const float rs = rsv[ai * 4 + m], kneg = -rs * LOG2E, c2 = rs * rs * (F8OUT ? osc : 1.f);
                f32x4 h[2];
#pragma unroll
                for (int n = 0; n < 2; ++n) { const f32x4 a = acc[ai][0][m][n], b = acc[ai][1][m][n]; const f32x4 t = a * kneg; f32x4 d;
#pragma unroll
                    for (int j = 0; j < 4; ++j) d[j] = __builtin_amdgcn_exp2f(t[j]);
                    d = d + 1.f;
#pragma unroll
                    for (int j = 0; j < 4; ++j) d[j] = __builtin_amdgcn_rcpf(d[j]);
                    h[n] = ((a * b) * c2) * d; }
                if (F8OUT) { typedef unsigned u32x2v __attribute__((ext_vector_type(2))); u32x2v w; w.x = pack_fp8x4(h[0][0], h[0][1], h[0][2], h[0][3]); w.y = pack_fp8x4(h[1][0], h[1][1], h[1][2], h[1][3]);
                    *(u32x2v*)((unsigned char*)O + (size_t)row * ldc + col0) = w; }
                else *(u32x4*)((bf16_t*)O + (size_t)row * ldc + col0) = pack8(h[0], h[1]); }
    }
};
typedef EpiSwiT<false> EpiSwi;

struct EpiY {
    static constexpr bool PERM = true, AFTER_DRAIN = false;
    bf16_t* O; int ldc; int nN; float sc;
    __device__ __forceinline__ void operator()(const f32x4 (&acc)[2][2][4][2], const Unit& u, int wr, int wc, int fr, int fq) const {
        const int row0 = u.pm * BM + wr * 64 + fr, col0 = (u.pn % nN) * BM + wc * 32 + 8 * fq;
#pragma unroll
        for (int ai = 0; ai < 2; ++ai)
#pragma unroll
            for (int m = 0; m < 4; ++m)
#pragma unroll
                for (int bj = 0; bj < 2; ++bj)
                    *(u32x4*)(O + (size_t)(row0 + ai * HALF + m * 16) * ldc + col0 + bj * HALF) = pack8(acc[ai][bj][m][0] * sc, acc[ai][bj][m][1] * sc);
    }
};

struct MoeOrder {
    int nM, nN, nwg, G, c, lo; int tb[9];
    __device__ __forceinline__ bool next(int i, Unit& u) const {
        const long L = (long)i * G + c; if (L >= nwg) return false;
        int wgid = (int)L; { const int q = nwg / NXCD, r = nwg % NXCD, xcd = wgid % NXCD, off = wgid / NXCD; wgid = (xcd < r ? xcd * (q + 1) : r * (q + 1) + (xcd - r) * q) + off; }
        const int nig = WGM * nN, gid = wgid / nig, fm = gid * WGM, gsz = (nM - fm) < WGM ? (nM - fm) : WGM;
        u.pm = fm + ((wgid % nig) % gsz); const int pn = (wgid % nig) / gsz; const int gt = lo + u.pm; int e = 0;
#pragma unroll
        for (int k = 1; k < 8; ++k) e += (gt >= tb[k]) ? 1 : 0;
        u.pn = e * nN + pn; return true;
    }
    __device__ __forceinline__ void a_ready(const Unit&) const {}
    __device__ __forceinline__ void done(const Unit&) const {}
};
template <class Epi, class Sched, bool ALIGN_EPI = false, bool SP2 = false, bool F8 = false>
__device__ __forceinline__ void gemm_phase(PG8_LAS unsigned char* lds, const Gemm g, const Sched& S, const Epi& E, int tid_in) {
    int tid_ = tid_in; asm volatile("" : "+v"(tid_));
    const int tid = tid_, wid = __builtin_amdgcn_readfirstlane(tid >> 6), lane = tid & 63, wr = wid >> 2, wc = wid & 3, fr = lane & 15, fq = lane >> 4;
    int Kv_ = g.K; asm volatile("" : "+v"(Kv_)); const int K = __builtin_amdgcn_readfirstlane(Kv_), nt = K / BK;
    unsigned voffA[2], voffB[2];
#pragma unroll
    for (int i = 0; i < 2; ++i) { int R, C; stage_rc(tid * 16 + i * 8192, R, C); const int Rb = Epi::PERM ? ((R & ~31) + perm32(R & 31)) : R;
        voffA[i] = (unsigned)(R * K + C) * 2u; voffB[i] = (unsigned)(Rb * K + C) * 2u; }
    const size_t kstep = (size_t)(BK * 2);
    const size_t hstep = (size_t)HALF * K * 2;
    const size_t tstep = 2 * hstep;
    const unsigned ldsw = (unsigned)wid * 1024u;
    const int aoff = lds_byte(wr * 64 + fr, fq * 8), boff = lds_byte(wc * 32 + fr, fq * 8);
#define PG8_SA(b, h) (((b) * 2 + (h)) * HTB)
#define PG8_SB(b, h) ((4 + (b) * 2 + (h)) * HTB)
#define PG8_STAGE(bufoff, gbase, voff) do { _Pragma("unroll") for (int _i = 0; _i < 2; ++_i) \
        __builtin_amdgcn_global_load_lds((const unsigned*)((const char*)(gbase) + (voff)[_i]), (PG8_LAS unsigned*)(lds + (bufoff) + ldsw + _i * 8192), 16, 0, 0); } while (0)
#define PG8_LDA(dst, b, h) do { _Pragma("unroll") for (int m = 0; m < 4; ++m) _Pragma("unroll") for (int k = 0; k < 2; ++k) dst[m][k] = *(const PG8_LAS bf16x8*)(lds + PG8_SA(b, h) + aoff + m * 2048 + k * 1024); } while (0)
#define PG8_LDB(dst, b, h) do { _Pragma("unroll") for (int n = 0; n < 2; ++n) _Pragma("unroll") for (int k = 0; k < 2; ++k) dst[n][k] = *(const PG8_LAS bf16x8*)(lds + PG8_SB(b, h) + boff + n * 2048 + k * 1024); } while (0)
#define PG8_MMA(ai, bj, At, Bt) do { __builtin_amdgcn_s_setprio(1); if constexpr (F8) { _Pragma("unroll") for (int m = 0; m < 4; ++m) _Pragma("unroll") for (int n = 0; n < 2; ++n) \
        asm volatile("v_mfma_scale_f32_16x16x128_f8f6f4 %0, %1, %2, %0, %3, %3 op_sel_hi:[0,0,0]" : "+v"(acc[ai][bj][m][n]) : "v"(cat8(Bt[n][0], Bt[n][1])), "v"(cat8(At[m][0], At[m][1])), "v"(f8scale)); } \
        else { _Pragma("unroll") for (int m = 0; m < 4; ++m) _Pragma("unroll") for (int n = 0; n < 2; ++n) _Pragma("unroll") for (int k = 0; k < 2; ++k) \
        acc[ai][bj][m][n] = __builtin_amdgcn_mfma_f32_16x16x32_bf16(Bt[n][k], At[m][k], acc[ai][bj][m][n], 0, 0, 0); } __builtin_amdgcn_s_setprio(0); } while (0)
#define PG8_WAIT_V(n) asm volatile("s_waitcnt vmcnt(" #n ")" ::: "memory")
#define PG8_WAIT_L(n) asm volatile("s_waitcnt lgkmcnt(" #n ")" ::: "memory")
#define PG8_BAR __builtin_amdgcn_s_barrier()
#define PG8_SCHED __builtin_amdgcn_sched_barrier(0)
    const int f8scale = 0x7f7f7f7f;
    Unit cur, nxt; int ui = 0;
    if (!S.next(0, cur)) return;
    f32x4 acc[2][2][4][2];
#pragma unroll
    for (int a = 0; a < 2; ++a)
#pragma unroll
        for (int b = 0; b < 2; ++b)
#pragma unroll
            for (int m = 0; m < 4; ++m)
#pragma unroll
                for (int n = 0; n < 2; ++n) { acc[a][b][m][n] = (f32x4){0.f, 0.f, 0.f, 0.f}; if constexpr (F8) asm volatile("" : "+v"(acc[a][b][m][n])); }
    bf16x8 At[4][2], B0[2][2], B1[2][2];
    const char* cA = (const char*)g.A + (size_t)cur.pm * tstep; const char* cB = (const char*)g.Bt + (size_t)cur.pn * tstep;
    S.a_ready(cur);
    if constexpr (SP2) {
        PG8_STAGE(PG8_SB(0, 0), cB, voffB); PG8_STAGE(PG8_SB(0, 1), cB + hstep, voffB); PG8_STAGE(PG8_SA(0, 0), cA, voffA); PG8_STAGE(PG8_SA(0, 1), cA + hstep, voffA);
        if (wr == 1) PG8_BAR;
        PG8_WAIT_V(2); PG8_BAR;
        PG8_STAGE(PG8_SB(1, 0), cB + kstep, voffB); PG8_STAGE(PG8_SA(1, 0), cA + kstep, voffA); PG8_STAGE(PG8_SB(1, 1), cB + hstep + kstep, voffB);
        PG8_WAIT_V(6); PG8_BAR;
    } else {
        PG8_STAGE(PG8_SB(0, 0), cB, voffB); PG8_STAGE(PG8_SA(0, 0), cA, voffA); PG8_STAGE(PG8_SB(0, 1), cB + hstep, voffB); PG8_STAGE(PG8_SA(0, 1), cA + hstep, voffA);
        if (wr == 1) PG8_BAR;
        PG8_WAIT_V(4); PG8_BAR;
        PG8_STAGE(PG8_SB(1, 0), cB + kstep, voffB); PG8_STAGE(PG8_SA(1, 0), cA + kstep, voffA); PG8_STAGE(PG8_SB(1, 1), cB + hstep + kstep, voffB);
        PG8_WAIT_V(6); PG8_BAR;
    }
    for (;;) {
        const bool has_next = S.next(ui + 1, nxt);
        const char* nA = has_next ? (const char*)g.A + (size_t)nxt.pm * tstep : cA; const char* nB = has_next ? (const char*)g.Bt + (size_t)nxt.pn * tstep : cB;
        int t = 0;
#pragma unroll 1
        do {
            const bool last = (t == nt - 2);
            const char* a1 = cA + (size_t)(t + 1) * kstep;
            const char* a2 = last ? nA : cA + (size_t)(t + 2) * kstep; const char* b2 = last ? nB : cB + (size_t)(t + 2) * kstep;
            const char* a3 = a2 + kstep; const char* b3 = b2 + kstep;
            if (last && has_next) S.a_ready(nxt);
            if constexpr (SP2) {
            PG8_LDB(B0, 0, 0); PG8_LDB(B1, 0, 1); PG8_SCHED; PG8_LDA(At, 0, 0); PG8_STAGE(PG8_SA(1, 1), a1 + hstep, voffA);
            PG8_WAIT_V(8); PG8_WAIT_L(0); PG8_BAR; PG8_MMA(0, 0, At, B0); PG8_MMA(0, 1, At, B1); PG8_BAR; PG8_SCHED;
            PG8_LDA(At, 0, 1); PG8_STAGE(PG8_SB(0, 0), b2, voffB); PG8_STAGE(PG8_SB(0, 1), b2 + hstep, voffB); PG8_STAGE(PG8_SA(0, 0), a2, voffA);
            PG8_WAIT_V(8); PG8_WAIT_L(0); PG8_BAR; PG8_MMA(1, 0, At, B0); PG8_MMA(1, 1, At, B1); PG8_BAR; PG8_SCHED;
            PG8_LDB(B0, 1, 0); PG8_LDB(B1, 1, 1); PG8_SCHED; PG8_LDA(At, 1, 0); PG8_STAGE(PG8_SA(0, 1), a2 + hstep, voffA);
            PG8_WAIT_V(8); PG8_WAIT_L(0); PG8_BAR; PG8_MMA(0, 0, At, B0); PG8_MMA(0, 1, At, B1); PG8_BAR; PG8_SCHED;
            PG8_LDA(At, 1, 1); PG8_STAGE(PG8_SB(1, 0), b3, voffB); PG8_STAGE(PG8_SB(1, 1), b3 + hstep, voffB); PG8_STAGE(PG8_SA(1, 0), a3, voffA);
            PG8_WAIT_V(8); PG8_WAIT_L(0); PG8_BAR; PG8_MMA(1, 0, At, B0); PG8_MMA(1, 1, At, B1); PG8_BAR; PG8_SCHED;
            } else {
            PG8_LDB(B0, 0, 0); PG8_SCHED; PG8_LDA(At, 0, 0); PG8_STAGE(PG8_SA(1, 1), a1 + hstep, voffA);
            PG8_WAIT_L(8); PG8_BAR; PG8_WAIT_L(0); PG8_MMA(0, 0, At, B0); PG8_BAR; PG8_SCHED;
            PG8_LDB(B1, 0, 1); PG8_STAGE(PG8_SB(0, 0), b2, voffB);
            PG8_BAR; PG8_WAIT_L(0); PG8_MMA(0, 1, At, B1); PG8_BAR;
            PG8_LDA(At, 0, 1); PG8_STAGE(PG8_SA(0, 0), a2, voffA);
            PG8_BAR; PG8_WAIT_L(0); PG8_MMA(1, 0, At, B0); PG8_BAR; PG8_SCHED;
            PG8_STAGE(PG8_SB(0, 1), b2 + hstep, voffB);
            PG8_WAIT_V(6); PG8_BAR; PG8_MMA(1, 1, At, B1); PG8_BAR;
            PG8_LDB(B0, 1, 0); PG8_SCHED; PG8_LDA(At, 1, 0); PG8_STAGE(PG8_SA(0, 1), a2 + hstep, voffA);
            PG8_WAIT_L(8); PG8_BAR; PG8_WAIT_L(0); PG8_MMA(0, 0, At, B0); PG8_BAR; PG8_SCHED;
            PG8_LDB(B1, 1, 1); PG8_STAGE(PG8_SB(1, 0), b3, voffB);
            PG8_BAR; PG8_WAIT_L(0); PG8_MMA(0, 1, At, B1); PG8_BAR;
            PG8_LDA(At, 1, 1); PG8_STAGE(PG8_SA(1, 0), a3, voffA);
            PG8_BAR; PG8_WAIT_L(0); PG8_MMA(1, 0, At, B0); PG8_BAR; PG8_SCHED;
            PG8_STAGE(PG8_SB(1, 1), b3 + hstep, voffB);
            PG8_WAIT_V(6); PG8_BAR; PG8_MMA(1, 1, At, B1); PG8_BAR;
            }
            t += 2;
        } while (t < nt);
        if constexpr (ALIGN_EPI) { if (wr == 0) PG8_BAR; }
        if constexpr (F8) asm volatile("s_nop 15\n\ts_nop 15" ::: "memory");
        if constexpr (!Epi::AFTER_DRAIN) { E(acc, cur, wr, wc, fr, fq); S.done(cur); }
        if (!has_next) break;
#pragma unroll
        for (int a = 0; a < 2; ++a)
#pragma unroll
            for (int b = 0; b < 2; ++b)
#pragma unroll
                for (int m = 0; m < 4; ++m)
#pragma unroll
                    for (int n = 0; n < 2; ++n) { acc[a][b][m][n] = (f32x4){0.f, 0.f, 0.f, 0.f}; if constexpr (F8) asm volatile("" : "+v"(acc[a][b][m][n])); }
        cur = nxt; cA = nA; cB = nB; ++ui;
        if constexpr (ALIGN_EPI) { if (wr == 1) PG8_BAR; }
    }
    PG8_WAIT_V(0);
    if constexpr (!ALIGN_EPI) { if (wr == 0) PG8_BAR; }
    PG8_BAR;
    if constexpr (Epi::AFTER_DRAIN) { E.fused(acc, cur, wr, wc, fr, fq, lds, wid, lane); S.done(cur); }
#undef PG8_SA
#undef PG8_SB
#undef PG8_STAGE
#undef PG8_LDA
#undef PG8_LDB
#undef PG8_MMA
#undef PG8_WAIT_V
#undef PG8_WAIT_L
#undef PG8_BAR
#undef PG8_SCHED
}
}

#define GAS __attribute__((address_space(1)))
#define LAS __attribute__((address_space(3)))
typedef unsigned short bf16;
typedef unsigned u32x4 __attribute__((ext_vector_type(4)));
typedef unsigned u32x2 __attribute__((ext_vector_type(2)));
typedef float f32x4 __attribute__((ext_vector_type(4)));
typedef float f32x16 __attribute__((ext_vector_type(16)));
typedef short bf16x8 __attribute__((ext_vector_type(8)));
typedef GAS unsigned gu32;
#define RLX_AGENT __ATOMIC_RELAXED, __HIP_MEMORY_SCOPE_AGENT

#ifndef DBG
#define DBG 0
#endif
#ifndef N_LAUNCH_SPLIT
#define N_LAUNCH_SPLIT 0
#endif

constexpr int NB = 16, SL = 2048, T = NB * SL, D = 1024, ML = 256, MT = NB * ML;
constexpr int FF = 2816, FE = 3584, NE = 8, RMAXT = 264;
constexpr float EPS = 1e-6f, LOG2E = 1.4426950408889634f, INV_2PI = 0.15915494309189535f;
constexpr int NWAVES = 8, NTHR = 512;

constexpr size_t MiB = 1u << 20;
constexpr size_t WS_CTL = 0, CTL_BYTES = 1 * MiB;
constexpr size_t WS_WQ = 1 * MiB;
constexpr size_t WS_WO = WS_WQ + 8 * MiB;
constexpr size_t WS_WK = WS_WO + 8 * MiB;
constexpr size_t WS_WV = WS_WK + 8 * MiB;
constexpr size_t WS_EV = WS_WV + 8 * MiB;
constexpr size_t EV_STRIDE = 27 * MiB, EV_INN = 0, EV_INS = 6 * MiB, EV_OUT = 8 * MiB, EV_GU = 10 * MiB, EV_DN = 21 * MiB;
constexpr size_t WS_OD = WS_EV + 2 * EV_STRIDE;
constexpr size_t OD_STRIDE = 8 * MiB, OD_INN = 0, OD_INS = 4 * MiB, OD_OUT = 6 * MiB;
constexpr size_t WS_MOE = WS_OD + 2 * OD_STRIDE;
constexpr size_t MOE_STRIDE = 84 * MiB, MOE_DN = 56 * MiB;
constexpr float MOE_WSCALE = 64.f, MOE_HSCALE = 4.f;
constexpr size_t WS_XB = WS_MOE + 168 * MiB;
constexpr size_t WS_SSQ = WS_XB + 64 * MiB;
constexpr size_t WS_MEMN = WS_SSQ + 2 * MiB;
constexpr size_t WS_KX = WS_MEMN + 8 * MiB;
constexpr size_t WS_VTX = WS_KX + 32 * MiB;
constexpr size_t WS_MISC = WS_VTX + 32 * MiB;
constexpr size_t MISC_LIST = 0, MISC_YROW = 1 * MiB, MISC_GATE = MISC_YROW + 256 * 1024, MISC_EPOS = MISC_GATE + 256 * 1024, MISC_RSS = MISC_EPOS + 256 * 1024;
constexpr size_t WS_ACT = WS_MISC + 3 * MiB;
constexpr size_t A_PE = 0, A_VTE = 256 * MiB, A_R = 352 * MiB;
constexpr int PEW = 4096;
constexpr size_t A_QK = 0, A_VTD = 128 * MiB, A_AO = 192 * MiB;
constexpr int QKP = 2048, VTP = T;
constexpr size_t A_QX = 0, A_OX = 64 * MiB;
constexpr size_t A_H = 0, A_XB8 = 432 * MiB;
constexpr size_t A_XS = 0, A_HID = 66 * MiB, A_Y = 297 * MiB;
constexpr size_t ACT_BYTES = 495 * MiB, WS_END = WS_ACT + ACT_BYTES;
constexpr int CW_TMO = 0, CW_BAR = 4096, CW_CNT = 8192  , CW_CHK = 16384  , CHK_NSTAGE = 96;
constexpr int PH_BYTES = 135168, LDSCTL_OFF = PH_BYTES, LDS_BYTES = PH_BYTES + 1024;

__device__ __forceinline__ float bf2f(bf16 b) { return __builtin_bit_cast(float, (unsigned)b << 16); }
__device__ __forceinline__ unsigned f2bf(float f) { unsigned u = __builtin_bit_cast(unsigned, f); return (u + 0x7fffu + ((u >> 16) & 1u)) >> 16; }
__device__ __forceinline__ unsigned pk2(float lo, float hi) { return f2bf(lo) | (f2bf(hi) << 16); }
__device__ __forceinline__ int crow(int r, int hi) { return (r & 3) + 8 * (r >> 2) + 4 * hi; }
#define LDS_WAIT() asm volatile("s_waitcnt lgkmcnt(0)" ::: "memory")
#define VM_WAIT() asm volatile("s_waitcnt vmcnt(0)" ::: "memory")
__device__ __forceinline__ float wave_sum(float v) {
#pragma unroll
    for (int o = 1; o < 64; o <<= 1) v += __shfl_xor(v, o);
    return v;
}
__device__ __forceinline__ float wave_max(float v) {
#pragma unroll
    for (int o = 1; o < 64; o <<= 1) v = fmaxf(v, __shfl_xor(v, o));
    return v;
}
#define MFMA32(a, b, c) __builtin_amdgcn_mfma_f32_32x32x16_bf16((a), (b), (c), 0, 0, 0)
__device__ __forceinline__ bf16x8 pack_frag(float a0, float a1, float a2, float a3, float a4, float a5, float a6, float a7) {
    u32x4 w; w.x = pg8::cvt_pk_bf16(a0, a1); w.y = pg8::cvt_pk_bf16(a2, a3); w.z = pg8::cvt_pk_bf16(a4, a5); w.w = pg8::cvt_pk_bf16(a6, a7); return __builtin_bit_cast(bf16x8, w);
}
__device__ __forceinline__ bf16x8 join8(u32x2 lo, u32x2 hi) { u32x4 w; w.x = lo.x; w.y = lo.y; w.z = hi.x; w.w = hi.y; return __builtin_bit_cast(bf16x8, w); }

struct Args {
    const float* x; const float* mem; const int* pos; const float* mem_g; const float* fin_g; const float* mix_g; const float* xa_g; const float* ffn_g;
    const float* xa_wq; const float* xa_wkv; const float* xa_wo; const float* ev_w_in; const float* ev_conv; const float* ev_df; const float* ev_db; const float* ev_gn;
    const float* ev_w_out; const float* ffd_g; const float* ffd_u; const float* ffd_d; const float* od_w_in; const float* lq1; const float* lk1; const float* lq2; const float* lk2;
    const float* od_gn; const float* od_w_out; const float* router; const float* moe_g; const float* moe_u; const float* moe_d;
    float* out; unsigned char* ws; int ph_lo, ph_hi;
};
struct Frame {
    LAS unsigned char* lds; gu32* ctl; unsigned char* ws; int tid, lane, wave, G, bid;
};
#define XB_TMO      128
#define XB_XCNT(j)  (256  + 64 * (j))
#define XB_XSUB(j)  (1280 + 64 * (j))
#define XB_XGEN(j)  (2304 + 64 * (j))
#define XB_TOP      3328
#define XB_TOPGEN   3392
#define XCD_BAR_WORDS 3456
#define XB_SPIN_CAP (1u << 18)

__device__ __forceinline__ unsigned xb_ld(unsigned* p)              { return __hip_atomic_load(p, __ATOMIC_RELAXED, __HIP_MEMORY_SCOPE_AGENT); }
__device__ __forceinline__ unsigned xb_add(unsigned* p, unsigned v) { return __hip_atomic_fetch_add(p, v, __ATOMIC_RELAXED, __HIP_MEMORY_SCOPE_AGENT); }
__device__ __forceinline__ unsigned xb_xcc_id() { return (unsigned)__builtin_amdgcn_s_getreg((3 << 11) | 20) & 0xFu; }
#define XB_SPIN(cond, bar) do { unsigned _sp = 0; while (cond) { __builtin_amdgcn_s_sleep(1); \
    if ((++_sp & 255u) == 0u) { if (xb_ld(&(bar)[XB_TMO])) break; if (_sp > XB_SPIN_CAP) { atomicAdd(&(bar)[XB_TMO], 1u); break; } } } } while (0)

struct XcdBarrier {
    unsigned* bar; unsigned x;
    bool t0;
    volatile LAS unsigned* st;
};

__device__ __forceinline__ XcdBarrier xcd_barrier_post(unsigned* bar, volatile LAS unsigned* st) {
    XcdBarrier b; b.bar = bar; b.x = xb_xcc_id(); b.st = st; b.t0 = (threadIdx.x == 0);
    if (threadIdx.x == 0) (void)xb_add(&bar[XB_XCNT(b.x)], 1u);
    return b;
}
__device__ __forceinline__ void xcd_barrier_complete(unsigned* bar, unsigned x, unsigned& nloc, unsigned& nx) {
    const unsigned G = gridDim.x * gridDim.y * gridDim.z;
    unsigned sum, cnt, mine, sp = 0u;
    for (;;) {
        sum = 0u; cnt = 0u; mine = 0u;
#pragma unroll
        for (unsigned j = 0; j < 16; ++j) { const unsigned c = xb_ld(&bar[XB_XCNT(j)]); sum += c; cnt += (c > 0u) ? 1u : 0u; mine = (j == x) ? c : mine; }
        if (sum == G) break;
        __builtin_amdgcn_s_sleep(1);
        if ((++sp & 255u) == 0u) { if (xb_ld(&bar[XB_TMO])) break; if (sp > XB_SPIN_CAP) { atomicAdd(&bar[XB_TMO], 1u); break; } }
    }
    nloc = mine > 0u ? mine : 1u; nx = cnt > 0u ? cnt : 1u;
}

__device__ __forceinline__ void xcd_barrier(const XcdBarrier& b) {
    asm volatile("s_waitcnt vmcnt(0)" ::: "memory");
    __syncthreads();
    if (b.t0) {
        unsigned* bar = b.bar;
        __builtin_amdgcn_s_waitcnt(0);
        unsigned nloc = b.st[0], nx = b.st[1];
        if (nloc == 0u) { xcd_barrier_complete(bar, b.x, nloc, nx); b.st[0] = nloc; b.st[1] = nx; }
        const unsigned old = xb_add(&bar[XB_XSUB(b.x)], 1u);
        const unsigned gen = old / nloc;
        if (old + 1u == (gen + 1u) * nloc) {
            __builtin_amdgcn_fence(__ATOMIC_RELEASE, "agent");
            asm volatile("s_waitcnt vmcnt(0)" ::: "memory");
            const unsigned og = xb_add(&bar[XB_TOP], 1u);
            const unsigned tg = og / nx;
            if (og + 1u == (tg + 1u) * nx) xb_add(&bar[XB_TOPGEN], 1u);
            else XB_SPIN(xb_ld(&bar[XB_TOPGEN]) == tg, bar);
            __builtin_amdgcn_fence(__ATOMIC_ACQUIRE, "agent");
            xb_add(&bar[XB_XGEN(b.x)], 1u);
            asm volatile("s_waitcnt vmcnt(0)" ::: "memory");
        } else {
            XB_SPIN(xb_ld(&bar[XB_XGEN(b.x)]) == gen, bar);
            __builtin_amdgcn_fence(__ATOMIC_ACQUIRE, "agent");
            asm volatile("s_waitcnt vmcnt(0)" ::: "memory");
        }
    }
    __syncthreads();
}

template <bool F8W = false> __device__ __forceinline__ void tr_item(const float* W0, const float* W1, int ldw, int K, int cm, int coff, const float* gk, bf16* WT, int item, int nblk, LAS float* scr, int lane, float wsc = 1.f) {
    const int kb = item / nblk, nb = item % nblk, k0 = 64 * kb, n0 = 64 * nb;
    const int np = n0 + 4 * (lane & 15);
    const float* W = W0; int sc;
    if (cm == 0) sc = np + coff;
    else if (cm == 1) { if (np < 1536) sc = np; else if (np < 2560) { const int c = np & 63, g = c >> 3, s = c & 7; sc = (np & ~63) + ((s < 4) ? 4 * g + s : 32 + 4 * g + (s - 4)); } else sc = np + 512; }
    else if (cm == 2) { const int c = np & 63; if (c < 16) { const int g = c >> 3, s = c & 7; sc = (np & ~63) + ((s < 4) ? 4 * g + s : 8 + 4 * g + (s - 4)); } else sc = np; }
    else { const int t = np >> 8, r = np & 255; if (r < 128) sc = 128 * t + r; else { sc = 128 * t + r - 128; W = W1; } }
#pragma unroll 4
    for (int i = 0; i < 16; ++i) { const int kk = 4 * i + (lane >> 4); const f32x4 v = *(const f32x4*)(W + (size_t)(k0 + kk) * ldw + sc); const float g = (gk ? gk[k0 + kk] : 1.f) * wsc;
        LAS float* d = scr + kk * 65 + 4 * (lane & 15); d[0] = v[0] * g; d[1] = v[1] * g; d[2] = v[2] * g; d[3] = v[3] * g; }
    LDS_WAIT(); asm volatile("" ::: "memory");
    const int c = lane & 7;
#pragma unroll
    for (int j = 0; j < 8; ++j) { const int n = (lane >> 3) + 8 * j; const LAS float* s = scr + (8 * c) * 65 + n;
        if constexpr (F8W) { u32x2 o; o.x = pg8::pack_fp8x4(s[0 * 65], s[1 * 65], s[2 * 65], s[3 * 65]); o.y = pg8::pack_fp8x4(s[4 * 65], s[5 * 65], s[6 * 65], s[7 * 65]);
            *(u32x2*)((unsigned char*)WT + (size_t)(n0 + n) * K + k0 + 8 * c) = o; }
        else { u32x4 o; o.x = pk2(s[0 * 65], s[1 * 65]); o.y = pk2(s[2 * 65], s[3 * 65]); o.z = pk2(s[4 * 65], s[5 * 65]); o.w = pk2(s[6 * 65], s[7 * 65]);
            *(u32x4*)(WT + (size_t)(n0 + n) * K + k0 + 8 * c) = o; } }
    LDS_WAIT(); asm volatile("" ::: "memory");
}
#define TRMAT(W0_, W1_, ldw_, K_, N_, cm_, coff_, gk_, WT_) do { const int nblk_ = (N_) / 64, ni_ = ((K_) / 64) * nblk_; \
    for (int it_ = (int)(((long)gw - ib + (long)NGW * 1024) % NGW); it_ < ni_; it_ += NGW) tr_item((W0_), (W1_), (ldw_), (K_), (cm_), (coff_), (gk_), (WT_), it_, nblk_, scr, F.lane); \
    ib = (ib + ni_) % NGW; } while (0)
#define TRMAT8(W0_, W1_, ldw_, K_, N_, cm_, coff_, gk_, WT_) do { const int nblk_ = (N_) / 64, ni_ = ((K_) / 64) * nblk_; \
    for (int it_ = (int)(((long)gw - ib + (long)NGW * 1024) % NGW); it_ < ni_; it_ += NGW) tr_item<true>((W0_), (W1_), (ldw_), (K_), (cm_), (coff_), (gk_), (bf16*)(WT_), it_, nblk_, scr, F.lane, MOE_WSCALE); \
    ib = (ib + ni_) % NGW; } while (0)

__device__ __forceinline__ void moe_convert(Frame& F, const Args& A, int j) {
    LAS float* scr = (LAS float*)(F.lds) + F.wave * (64 * 65);
    const int gw = F.bid * NWAVES + F.wave, NGW = F.G * NWAVES; long ib = 0;
    unsigned char* gu = F.ws + WS_MOE + (size_t)j * MOE_STRIDE; unsigned char* dn = gu + MOE_DN;
    for (int e = 0; e < NE; ++e) {
        const size_t wo = ((size_t)j * NE + e) * (size_t)D * FE;
        TRMAT8(A.moe_g + wo, A.moe_u + wo, FE, D, 2 * FE, 3, 0, A.ffn_g + (2 * j + 1) * D, gu + (size_t)e * 2 * FE * D);
        TRMAT8(A.moe_d + wo, nullptr, D, FE, D, 0, 0, nullptr, dn + (size_t)e * D * FE);
    }
}

__device__ __forceinline__ void prologue_phase(Frame& F, const Args& A) {
    LAS float* scr = (LAS float*)(F.lds) + F.wave * (64 * 65);
    const int gw = F.bid * NWAVES + F.wave, NGW = F.G * NWAVES; long ib = 0;
    { const bool h5 = (F.lane & 32) != 0, h4 = (F.lane & 16) != 0;
      for (int m0 = 4 * gw; m0 < T; m0 += 4 * NGW) {
        f32x4 v[4][4]; float sq[4];
#pragma unroll
        for (int s = 0; s < 4; ++s) { const f32x4* xr = (const f32x4*)(A.x + (size_t)(m0 + s) * D) + F.lane;
#pragma unroll
            for (int q = 0; q < 4; ++q) v[s][q] = xr[64 * q]; }
#pragma unroll
        for (int s = 0; s < 4; ++s) { sq[s] = 0.f;
#pragma unroll
            for (int q = 0; q < 4; ++q) {
#pragma unroll
                for (int e = 0; e < 4; ++e) v[s][q][e] = bf2f((bf16)f2bf(v[s][q][e]));
                sq[s] += (v[s][q][0] * v[s][q][0] + v[s][q][1] * v[s][q][1]) + (v[s][q][2] * v[s][q][2] + v[s][q][3] * v[s][q][3]); } }
        const float t0 = (h5 ? sq[2] : sq[0]) + __shfl_xor(h5 ? sq[0] : sq[2], 32), t1 = (h5 ? sq[3] : sq[1]) + __shfl_xor(h5 ? sq[1] : sq[3], 32);
        float tt = (h4 ? t1 : t0) + __shfl_xor(h4 ? t0 : t1, 16);
        tt += __shfl_xor(tt, 8); tt += __shfl_xor(tt, 4); tt += __shfl_xor(tt, 2); tt += __shfl_xor(tt, 1);
#pragma unroll
        for (int s = 0; s < 4; ++s) { const int m = m0 + s; const float ssum = __builtin_bit_cast(float, __builtin_amdgcn_readlane(__builtin_bit_cast(int, tt), 16 * s));
            u32x2* brow = (u32x2*)((bf16*)(F.ws + WS_XB) + (size_t)m * D) + F.lane;
#pragma unroll
            for (int q = 0; q < 4; ++q) { u32x2 w; w.x = pk2(v[s][q][0], v[s][q][1]); w.y = pk2(v[s][q][2], v[s][q][3]); brow[64 * q] = w; }
            if (F.lane < 16) ((float*)(F.ws + WS_SSQ))[(size_t)m * 16 + F.lane] = (F.lane == 0) ? ssum : 0.f; }
      } }
    for (int m = gw; m < MT; m += NGW) {
        const f32x4* xr = (const f32x4*)(A.mem + (size_t)m * D) + F.lane; const f32x4* gr = (const f32x4*)A.mem_g + F.lane; f32x4 v[4]; float s = 0.f;
#pragma unroll
        for (int q = 0; q < 4; ++q) { v[q] = xr[64 * q]; s += (v[q][0] * v[q][0] + v[q][1] * v[q][1]) + (v[q][2] * v[q][2] + v[q][3] * v[q][3]); }
        const float rs = rsqrtf(wave_sum(s) * (1.f / D) + EPS);
        u32x2* brow = (u32x2*)((bf16*)(F.ws + WS_MEMN) + (size_t)m * D) + F.lane;
#pragma unroll
        for (int q = 0; q < 4; ++q) { const f32x4 g = gr[64 * q]; u32x2 w; w.x = pk2(v[q][0] * rs * g[0], v[q][1] * rs * g[1]); w.y = pk2(v[q][2] * rs * g[2], v[q][3] * rs * g[3]); brow[64 * q] = w; }
    }
    for (int l = 0; l < 4; ++l) {
        TRMAT8(A.xa_wq + (size_t)l * D * D, nullptr, D, D, D, 0, 0, A.xa_g + l * D, F.ws + WS_WQ + (size_t)l * D * D);
        TRMAT8(A.xa_wo + (size_t)l * D * D, nullptr, D, D, D, 0, 0, nullptr, F.ws + WS_WO + (size_t)l * D * D);
        TRMAT(A.xa_wkv + (size_t)l * D * 2 * D, nullptr, 2 * D, D, D, 0, 0, nullptr, (bf16*)(F.ws + WS_WK) + (size_t)l * D * D);
        TRMAT(A.xa_wkv + (size_t)l * D * 2 * D, nullptr, 2 * D, D, D, 0, D, nullptr, (bf16*)(F.ws + WS_WV) + (size_t)l * D * D);
    }
    for (int j = 0; j < 2; ++j) {
        unsigned char* eb = F.ws + WS_EV + j * EV_STRIDE; const float* win = A.ev_w_in + (size_t)j * D * 3584;
        TRMAT(win, nullptr, 3584, D, 3072, 1, 0, A.mix_g + (2 * j) * D, (bf16*)(eb + EV_INN));
        TRMAT(win, nullptr, 3584, D, 512, 0, 2560, A.mix_g + (2 * j) * D, (bf16*)(eb + EV_INS));
        TRMAT(A.ev_w_out + (size_t)j * D * D, nullptr, D, D, D, 0, 0, nullptr, (bf16*)(eb + EV_OUT));
        TRMAT8(A.ffd_g + (size_t)j * D * FF, A.ffd_u + (size_t)j * D * FF, FF, D, 2 * FF, 3, 0, A.ffn_g + (2 * j) * D, eb + EV_GU);
        TRMAT8(A.ffd_d + (size_t)j * FF * D, nullptr, D, FF, D, 0, 0, nullptr, eb + EV_DN);
        unsigned char* ob = F.ws + WS_OD + j * OD_STRIDE; const float* oin = A.od_w_in + (size_t)j * D * 3072;
        TRMAT(oin, nullptr, 3072, D, 2048, 2, 0, A.mix_g + (2 * j + 1) * D, (bf16*)(ob + OD_INN));
        TRMAT(oin, nullptr, 3072, D, 1024, 0, 2048, A.mix_g + (2 * j + 1) * D, (bf16*)(ob + OD_INS));
        TRMAT(A.od_w_out + (size_t)j * D * D, nullptr, D, D, D, 0, 0, nullptr, (bf16*)(ob + OD_OUT));
    }
}

__device__ __forceinline__ void fret_phase(Frame& F, const Args& A, int j) {
    const bf16* PE = (const bf16*)(F.ws + WS_ACT + A_PE); bf16* R = (bf16*)(F.ws + WS_ACT + A_R); const bf16* VT = (const bf16*)(F.ws + WS_ACT + A_VTE);
    { const float* cw = A.ev_conv + (size_t)j * 3 * 512;
      const int c0 = (F.tid & 63) * 8;
      float cwv[3][8];
#pragma unroll
      for (int d = 0; d < 3; ++d) { const f32x4 a = *(const f32x4*)(cw + d * 512 + c0), bq = *(const f32x4*)(cw + d * 512 + c0 + 4);
#pragma unroll
          for (int e = 0; e < 4; ++e) { cwv[d][e] = a[e]; cwv[d][4 + e] = bq[e]; } }
      const int tstr = (F.G * NTHR) >> 6;
      for (int t0 = (F.bid * NTHR + F.tid) >> 6; t0 < T; t0 += 4 * tstr) {
        bf16x8 gcv[4][3], hcv[4][3], gbv[4];
#pragma unroll
        for (int s = 0; s < 4; ++s) { const int t = t0 + s * tstr; const bool tv = t < T; const int l = t & (SL - 1); const bf16* row = PE + (size_t)(tv ? t : 0) * PEW;
#pragma unroll
            for (int d = 0; d < 3; ++d) { const bool ok = tv && ((d == 0) ? (l > 0) : (d == 2) ? (l < SL - 1) : true); const bf16* rr = row + (ok ? (d - 1) * PEW : 0);
                gcv[s][d] = *(const bf16x8*)(rr + 512 + c0); hcv[s][d] = *(const bf16x8*)(rr + 1024 + c0); }
            gbv[s] = *(const bf16x8*)(row + c0); }
#pragma unroll
        for (int s = 0; s < 4; ++s) { const int t = t0 + s * tstr; if (t < T) { const int l = t & (SL - 1); float o[8];
#pragma unroll
            for (int e = 0; e < 8; ++e) { float acc = cwv[1][e] * (bf2f((bf16)gcv[s][1][e]) * bf2f((bf16)hcv[s][1][e]));
                if (l > 0) acc += cwv[0][e] * (bf2f((bf16)gcv[s][0][e]) * bf2f((bf16)hcv[s][0][e]));
                if (l < SL - 1) acc += cwv[2][e] * (bf2f((bf16)gcv[s][2][e]) * bf2f((bf16)hcv[s][2][e]));
                o[e] = bf2f((bf16)gbv[s][e]) * acc; }
            u32x4 wq; wq.x = pk2(o[0], o[1]); wq.y = pk2(o[2], o[3]); wq.z = pk2(o[4], o[5]); wq.w = pk2(o[6], o[7]);
            *(u32x4*)(R + (size_t)t * 1024 + c0) = wq; } } } }
    const int w = F.wave, lane = F.lane, r = lane & 31, hh = lane >> 5, tid = F.tid;
    LAS unsigned char* lds = F.lds;
    const float* gng = A.ev_gn + j * 512;
    const int srow = tid >> 3, sch = tid & 7;
    const int kfo = r * 144 + 16 * hh;
    const int vfo = 36864 + r * 144 + 16 * hh;
    const int sto = srow * 144 + sch * 16;
    const int stv = 36864 + srow * 144 + (sch >> 1) * 32 + (sch & 1) * 8;
    LAS float* gnl = (LAS float*)(lds + 57344);
    if (tid < 128) *(LAS f32x4*)(gnl + 4 * tid) = *(const f32x4*)(gng + 4 * tid);
    const unsigned kof = (unsigned)(srow * PEW + sch * 8) * 2u, vof = (unsigned)(srow * T + sch * 8) * 2u;
    int u = F.bid; if (u >= 1024) { __syncthreads(); return; }
    int b = u >> 6, h = (u >> 3) & 7, qt = u & 7; size_t tok0 = (size_t)b * SL + 256 * qt, kb = (size_t)b * SL;
    bf16x8 qff[4], qfb[4]; u32x4 rk0, rk1, rv0, rk2, rk3, rv1;
    const char* kbase = (const char*)(PE + kb * PEW + 2048 + h * 64); const char* vbase = (const char*)(VT + (size_t)(h * 64) * T + kb);
    { const bf16* qp = PE + (tok0 + 32 * w + r) * PEW + h * 64 + 8 * hh;
#pragma unroll
      for (int s = 0; s < 4; ++s) { qff[s] = *(const bf16x8*)(qp + 1536 + 16 * s); qfb[s] = *(const bf16x8*)(qp + 3072 + 16 * s); }
      rk0 = *(const u32x4*)(kbase + kof); rk1 = *(const u32x4*)(kbase + kof + 3072); rv0 = *(const u32x4*)(vbase + vof);
      rk2 = *(const u32x4*)(kbase + (size_t)(64 * PEW * 2) + kof); rk3 = *(const u32x4*)(kbase + (size_t)(64 * PEW * 2) + kof + 3072); rv1 = *(const u32x4*)(vbase + 128 + vof); }
    for (;;) {
        const float lgf = __builtin_bit_cast(float, __builtin_amdgcn_readfirstlane(__builtin_bit_cast(int, -__expf(A.ev_df[j * 8 + h]) * LOG2E))), lgb = __builtin_bit_cast(float, __builtin_amdgcn_readfirstlane(__builtin_bit_cast(int, -__expf(A.ev_db[j * 8 + h]) * LOG2E)));
        const int nw0 = 256 * qt + 32 * w, tmix = nw0 >> 6;
#define FR_LDK(t) do { const char* kt_ = kbase + (size_t)(t) * (64 * PEW * 2); rk0 = *(const u32x4*)(kt_ + kof); rk1 = *(const u32x4*)(kt_ + kof + 3072); } while (0)
#define FR_LDV(t) do { rv0 = *(const u32x4*)(vbase + (size_t)(t) * 128 + vof); } while (0)
#define FR_STK(bf) do { *(LAS u32x4*)(lds + (bf) * 18432 + sto) = rk0; *(LAS u32x4*)(lds + (bf) * 18432 + 9216 + sto) = rk1; } while (0)
#define FR_STV(bf) do { LAS unsigned char* vd_ = lds + (bf) * 9216 + stv; *(LAS u32x2*)(vd_) = (u32x2){rv0.x, rv0.y}; *(LAS u32x2*)(vd_ + 16) = (u32x2){rv0.z, rv0.w}; } while (0)
#define FR_KF(kbn, cb, kt2, s) (*(const LAS bf16x8*)(lds + (kbn) * 18432 + (cb) * 9216 + kfo + (kt2) * 4608 + 32 * (s)))
#define FR_VF(vbc, dvt, k2, s2) (*(const LAS bf16x8*)(lds + (vbc) * 9216 + vfo + 4608 * (dvt) + 64 * (k2) + 32 * (s2)))
#define FR_QKH(N, NC, tt, kbn, kt2) do { const int m0_ = 64 * (tt); N = zero16; \
        if ((tt) < tmix) { _Pragma("unroll") for (int s = 0; s < 4; ++s) N = MFMA32(FR_KF(kbn, 0, kt2, s), qff[s], N); NC = __builtin_amdgcn_exp2f(lgf * (float)(nw0 - m0_)); } \
        else if ((tt) > tmix) { _Pragma("unroll") for (int s = 0; s < 4; ++s) N = MFMA32(FR_KF(kbn, 1, kt2, s), qfb[s], N); NC = __builtin_amdgcn_exp2f(lgb * (float)(m0_ - nw0)); } \
        else { f32x16 b_ = zero16; \
            _Pragma("unroll") for (int s = 0; s < 4; ++s) { N = MFMA32(FR_KF(kbn, 0, kt2, s), qff[s], N); b_ = MFMA32(FR_KF(kbn, 1, kt2, s), qfb[s], b_); } \
            const float cf_ = __builtin_amdgcn_exp2f(lgf * (float)(nw0 - m0_)), cb_ = __builtin_amdgcn_exp2f(lgb * (float)(m0_ - nw0)); const int n_ = nw0 + r; \
            _Pragma("unroll") for (int q = 0; q < 16; ++q) { const int m_ = m0_ + 32 * (kt2) + crow(q, hh); N[q] = (m_ <= n_) ? N[q] * cf_ : b_[q] * cb_; } \
            NC = 1.f; } } while (0)
#define FR_PACK(P, B, c) pack_frag(P[B] * (c), P[B + 1] * (c), P[B + 2] * (c), P[B + 3] * (c), P[B + 4] * (c), P[B + 5] * (c), P[B + 6] * (c), P[B + 7] * (c))
        FR_STK(0); FR_STV(0); rk0 = rk2; rk1 = rk3; rv0 = rv1;
        __syncthreads();
        const f32x16 zero16 = {};
        f32x16 o[2] = {{}, {}};
#pragma unroll 1
        for (int t = 0; t < 32; ++t) { const int bc = t & 1;
            if (t + 1 < 32) { FR_STK(bc ^ 1); FR_STV(bc ^ 1); }
            if (t + 2 < 32) { FR_LDK(t + 2); FR_LDV(t + 2); }
            f32x16 s0_, s1_; float c0_, c1_;
            if (__builtin_expect(t != tmix, 1)) { const bool below_ = t < tmix; const int cbo_ = below_ ? 0 : 9216; s0_ = zero16; s1_ = zero16;
#pragma unroll
                for (int s = 0; s < 4; ++s) { const bf16x8 qs_ = below_ ? qff[s] : qfb[s];
                    s0_ = MFMA32(*(const LAS bf16x8*)(lds + bc * 18432 + cbo_ + kfo + 32 * s), qs_, s0_); s1_ = MFMA32(*(const LAS bf16x8*)(lds + bc * 18432 + cbo_ + kfo + 4608 + 32 * s), qs_, s1_); }
                c0_ = below_ ? __builtin_amdgcn_exp2f(lgf * (float)(nw0 - 64 * t)) : __builtin_amdgcn_exp2f(lgb * (float)(64 * t - nw0)); c1_ = c0_; }
            else { FR_QKH(s0_, c0_, t, bc, 0); FR_QKH(s1_, c1_, t, bc, 1); }
            const bf16x8 p0l = FR_PACK(s0_, 0, c0_), p0h = FR_PACK(s0_, 8, c0_), p1l = FR_PACK(s1_, 0, c1_), p1h = FR_PACK(s1_, 8, c1_);
            o[0] = MFMA32(FR_VF(bc, 0, 0, 0), p0l, o[0]); o[1] = MFMA32(FR_VF(bc, 1, 0, 0), p0l, o[1]); o[0] = MFMA32(FR_VF(bc, 0, 0, 1), p0h, o[0]); o[1] = MFMA32(FR_VF(bc, 1, 0, 1), p0h, o[1]);
            o[0] = MFMA32(FR_VF(bc, 0, 1, 0), p1l, o[0]); o[1] = MFMA32(FR_VF(bc, 1, 1, 0), p1l, o[1]); o[0] = MFMA32(FR_VF(bc, 0, 1, 1), p1h, o[0]); o[1] = MFMA32(FR_VF(bc, 1, 1, 1), p1h, o[1]);
            __syncthreads(); }
#undef FR_QKH
#undef FR_PACK
#undef FR_VF
#undef FR_KF
#undef FR_STV
#undef FR_STK
#undef FR_LDV
#undef FR_LDK
        const size_t tok = tok0 + 32 * w + r;
        u32x2 gwl[2][4];
#pragma unroll
        for (int dvt = 0; dvt < 2; ++dvt)
#pragma unroll
            for (int q4 = 0; q4 < 4; ++q4) gwl[dvt][q4] = *(const u32x2*)(PE + tok * PEW + 2560 + h * 64 + 32 * dvt + 8 * q4 + 4 * hh);
        const int un = u + F.G; const bool has_next = un < 1024;
        const int nb = un >> 6, nh = (un >> 3) & 7, nqt = un & 7; const size_t ntok0 = (size_t)nb * SL + 256 * nqt, nkb = (size_t)nb * SL;
        const char* nkbase = (const char*)(PE + nkb * PEW + 2048 + nh * 64); const char* nvbase = (const char*)(VT + (size_t)(nh * 64) * T + nkb);
        if (has_next) { const bf16* qp = PE + (ntok0 + 32 * w + r) * PEW + nh * 64 + 8 * hh;
#pragma unroll
            for (int s = 0; s < 4; ++s) { qff[s] = *(const bf16x8*)(qp + 1536 + 16 * s); qfb[s] = *(const bf16x8*)(qp + 3072 + 16 * s); }
            rk0 = *(const u32x4*)(nkbase + kof); rk1 = *(const u32x4*)(nkbase + kof + 3072); rv0 = *(const u32x4*)(nvbase + vof);
            rk2 = *(const u32x4*)(nkbase + (size_t)(64 * PEW * 2) + kof); rk3 = *(const u32x4*)(nkbase + (size_t)(64 * PEW * 2) + kof + 3072); rv1 = *(const u32x4*)(nvbase + 128 + vof); }
        float ss = 0.f;
#pragma unroll
        for (int dvt = 0; dvt < 2; ++dvt)
#pragma unroll
            for (int q = 0; q < 16; ++q) ss += o[dvt][q] * o[dvt][q];
        ss += __shfl_xor(ss, 32); const float rms = rsqrtf(ss * (1.f / 64.f) + EPS);
#pragma unroll
        for (int dvt = 0; dvt < 2; ++dvt)
#pragma unroll
            for (int q4 = 0; q4 < 4; ++q4) { const int dv0 = 32 * dvt + 8 * q4 + 4 * hh;
                const u32x2 gwv = gwl[dvt][q4]; const f32x4 gn = *(const LAS f32x4*)(gnl + h * 64 + dv0);
                const float gg[4] = {__builtin_bit_cast(float, gwv.x << 16), __builtin_bit_cast(float, gwv.x & 0xffff0000u), __builtin_bit_cast(float, gwv.y << 16), __builtin_bit_cast(float, gwv.y & 0xffff0000u)}; float ov[4];
#pragma unroll
                for (int e = 0; e < 4; ++e) ov[e] = o[dvt][4 * q4 + e] * rms * gn[e] * gg[e] * __builtin_amdgcn_rcpf(1.f + __builtin_amdgcn_exp2f(-gg[e] * LOG2E));
                u32x2 wv; wv.x = pk2(ov[0], ov[1]); wv.y = pk2(ov[2], ov[3]); *(u32x2*)(R + tok * 1024 + 512 + h * 64 + dv0) = wv; }
        if (!has_next) break;
        u = un; b = nb; h = nh; qt = nqt; tok0 = ntok0; kb = nkb; kbase = nkbase; vbase = nvbase;
    }
}

__device__ __forceinline__ void xattn_phase(Frame& F, int l) {
    const bf16* Q = (const bf16*)(F.ws + WS_ACT + A_QX); bf16* OX = (bf16*)(F.ws + WS_ACT + A_OX);
    const bf16* KX = (const bf16*)(F.ws + WS_KX); const bf16* VTX = (const bf16*)(F.ws + WS_VTX);
    const int w = F.wave, lane = F.lane, r = lane & 31, hh = lane >> 5, tid = F.tid;
    LAS unsigned char* lds = F.lds;
    for (int u = F.bid; u < 512; u += F.G) { const int b = u >> 5, hd = (u >> 3) & 3, qt = u & 7; const size_t tok0 = (size_t)b * SL + 256 * qt;
        { const bf16* src = KX + (size_t)(b * 256) * 4096 + l * 1024 + hd * 256;
          u32x4 stg[16];
#pragma unroll
          for (int i = 0; i < 16; ++i) { const int idx = tid + 512 * i, m = idx >> 5, ch = idx & 31; stg[i] = *(const u32x4*)(src + (size_t)m * 4096 + ch * 8); }
#pragma unroll
          for (int i = 0; i < 16; ++i) { const int idx = tid + 512 * i, m = idx >> 5, ch = idx & 31; *(LAS u32x4*)(lds + m * 528 + ch * 16) = stg[i]; } }
        const bf16* qp = Q + (tok0 + 32 * w + r) * 1024 + hd * 256 + 8 * hh; bf16x8 qa[4], qb[4];
#pragma unroll
        for (int s = 0; s < 4; ++s) qa[s] = *(const bf16x8*)(qp + 16 * s);
        __syncthreads();
        f32x16 st[8];
#pragma unroll
        for (int mt = 0; mt < 8; ++mt) st[mt] = (f32x16){};
#pragma unroll
        for (int sg = 0; sg < 4; ++sg) {
            if (sg < 3) {
#pragma unroll
                for (int s = 0; s < 4; ++s) qb[s] = *(const bf16x8*)(qp + 16 * (4 * (sg + 1) + s)); }
#pragma unroll
            for (int s = 0; s < 4; ++s)
#pragma unroll
                for (int mt = 0; mt < 8; ++mt) st[mt] = MFMA32(*(const LAS bf16x8*)(lds + (32 * mt + r) * 528 + (16 * (4 * sg + s) + 8 * hh) * 2), qa[s], st[mt]);
#pragma unroll
            for (int s = 0; s < 4; ++s) qa[s] = qb[s];
        }
        float mx = -3.0e38f;
#pragma unroll
        for (int mt = 0; mt < 8; ++mt)
#pragma unroll
            for (int q = 0; q < 16; ++q) mx = fmaxf(mx, st[mt][q]);
        mx = fmaxf(mx, __shfl_xor(mx, 32)); float sum = 0.f;
#pragma unroll
        for (int mt = 0; mt < 8; ++mt)
#pragma unroll
            for (int q = 0; q < 16; ++q) { st[mt][q] = __builtin_amdgcn_exp2f(st[mt][q] - mx); sum += st[mt][q]; }
        sum += __shfl_xor(sum, 32); const float inv = __builtin_amdgcn_rcpf(sum);
        bf16x8 pf[8][2];
#pragma unroll
        for (int mt = 0; mt < 8; ++mt)
#pragma unroll
            for (int s2 = 0; s2 < 2; ++s2) pf[mt][s2] = pack_frag(st[mt][8 * s2 + 0], st[mt][8 * s2 + 1], st[mt][8 * s2 + 2], st[mt][8 * s2 + 3], st[mt][8 * s2 + 4], st[mt][8 * s2 + 5], st[mt][8 * s2 + 6], st[mt][8 * s2 + 7]);
        __syncthreads();
        { const bf16* src = VTX + (size_t)(l * 1024 + hd * 256) * 4096 + b * 256;
#pragma unroll 1
          for (int hb = 0; hb < 2; ++hb) { u32x4 stg[8];
#pragma unroll
            for (int i = 0; i < 8; ++i) { const int idx = tid + 512 * (8 * hb + i), d = idx >> 5, ch = idx & 31; stg[i] = *(const u32x4*)(src + (size_t)d * 4096 + ch * 8); }
#pragma unroll
            for (int i = 0; i < 8; ++i) { const int idx = tid + 512 * (8 * hb + i), d = idx >> 5, ch = idx & 31;
                LAS unsigned char* vd_ = lds + d * 528 + (ch >> 1) * 32 + (ch & 1) * 8; *(LAS u32x2*)(vd_) = (u32x2){stg[i].x, stg[i].y}; *(LAS u32x2*)(vd_ + 16) = (u32x2){stg[i].z, stg[i].w}; } } }
        __syncthreads();
        unsigned char* op = (unsigned char*)OX + (tok0 + 32 * w + r) * 1024 + hd * 256; const float inv4 = inv * 4.f;
#pragma unroll 1
        for (int dp = 0; dp < 4; ++dp) { f32x16 o0 = {}, o1 = {};
#pragma unroll
            for (int mt = 0; mt < 8; ++mt)
#pragma unroll
                for (int s2 = 0; s2 < 2; ++s2) { const int mo = (32 * mt + 16 * s2) * 2 + 16 * hh;
                    const LAS unsigned char* a0 = lds + (64 * dp + r) * 528 + mo; const LAS unsigned char* a1 = a0 + 32 * 528;
                    o0 = MFMA32(*(const LAS bf16x8*)a0, pf[mt][s2], o0);
                    o1 = MFMA32(*(const LAS bf16x8*)a1, pf[mt][s2], o1); }
#pragma unroll
            for (int qp = 0; qp < 2; ++qp) {
                const int qa = 2 * qp, qb = 2 * qp + 1;
                const unsigned a0 = pg8::pack_fp8x4(o0[4 * qa] * inv4, o0[4 * qa + 1] * inv4, o0[4 * qa + 2] * inv4, o0[4 * qa + 3] * inv4), b0 = pg8::pack_fp8x4(o0[4 * qb] * inv4, o0[4 * qb + 1] * inv4, o0[4 * qb + 2] * inv4, o0[4 * qb + 3] * inv4);
                const unsigned a1 = pg8::pack_fp8x4(o1[4 * qa] * inv4, o1[4 * qa + 1] * inv4, o1[4 * qa + 2] * inv4, o1[4 * qa + 3] * inv4), b1 = pg8::pack_fp8x4(o1[4 * qb] * inv4, o1[4 * qb + 1] * inv4, o1[4 * qb + 2] * inv4, o1[4 * qb + 3] * inv4);
                const auto r0 = __builtin_amdgcn_permlane32_swap(a0, b0, false, false); const auto r1 = __builtin_amdgcn_permlane32_swap(a1, b1, false, false);
                *(u32x2*)(op + 64 * dp + 8 * (qa + hh)) = (u32x2){r0[0], r0[1]}; *(u32x2*)(op + 64 * dp + 32 + 8 * (qa + hh)) = (u32x2){r1[0], r1[1]}; } }
        __syncthreads();
    }
}

#define DA_SB() __builtin_amdgcn_sched_barrier(0)
__device__ __forceinline__ float da_max3(float a, float b, float c) { return fmaxf(fmaxf(a, b), c); }
__device__ __forceinline__ void dattn_phase(Frame& F, const Args& A, int j, float lambda_init) {
    const bf16* QK = (const bf16*)(F.ws + WS_ACT + A_QK); const bf16* VT = (const bf16*)(F.ws + WS_ACT + A_VTD); bf16* AO = (bf16*)(F.ws + WS_ACT + A_AO);
    const int w = F.wave, lane = F.lane, r = lane & 31, hh = lane >> 5, tid = F.tid, mp = w & 1, ig = w >> 1;
    LAS unsigned char* lds = F.lds;
    LAS float* xb = (LAS float*)(lds) + ig * 4096;
    float lam; { float s1 = 0.f, s2 = 0.f; for (int e = 0; e < 64; ++e) { s1 += A.lq1[j * 64 + e] * A.lk1[j * 64 + e]; s2 += A.lq2[j * 64 + e] * A.lk2[j * 64 + e]; } lam = __expf(s1) - __expf(s2) + lambda_init; }
    lam = __builtin_bit_cast(float, __builtin_amdgcn_readfirstlane(__builtin_bit_cast(int, lam)));
    const int li_s = __builtin_amdgcn_readfirstlane(__builtin_bit_cast(int, lambda_init)); const float* gng = A.od_gn + j * 1024;
    const int srow = tid >> 3, sch = tid & 7;
    const int kfo = mp * 9216 + r * 144 + 16 * hh;
    const int vfo = 36864 + r * 144 + 16 * hh;
    const int stv = srow * 144 + (sch >> 1) * 32 + (sch & 1) * 8;
    const int sto = srow * 144 + sch * 16;
    LAS float* gnl = (LAS float*)(lds + 77824);
    if (tid < 256) *(LAS f32x4*)(gnl + 4 * tid) = *(const f32x4*)(gng + 4 * tid);
    int u = F.bid; if (u >= 2048) { __syncthreads(); return; }
    int b = u >> 7, h = (u >> 4) & 7, qt = u & 15; size_t tok0 = (size_t)b * SL + 128 * qt, kb = (size_t)b * SL;
    bf16x8 qf[4]; u32x4 rk0, rk1, rv0, rv1, rk2, rk3;
    const bf16* k0s = QK + (kb + srow) * 2048 + 1024 + (2 * h) * 64 + sch * 8; const bf16* k1s = k0s + 64;
    const bf16* v0s = VT + (size_t)(h * 128 + srow) * T + kb + sch * 8; const bf16* v1s = v0s + (size_t)64 * T;
    { const bf16* qp = QK + (tok0 + 32 * ig + r) * 2048 + (2 * h + mp) * 64 + 8 * hh;
#pragma unroll
      for (int s = 0; s < 4; ++s) qf[s] = *(const bf16x8*)(qp + 16 * s);
      rk0 = *(const u32x4*)(k0s); rk1 = *(const u32x4*)(k1s); rv0 = *(const u32x4*)(v0s); rv1 = *(const u32x4*)(v1s); rk2 = *(const u32x4*)(k0s + (size_t)64 * 2048); rk3 = *(const u32x4*)(k1s + (size_t)64 * 2048); }
    for (;;) {
#define DA_LDK(t) do { const size_t ko_ = (size_t)(t) * 64 * 2048; rk0 = *(const u32x4*)(k0s + ko_); rk1 = *(const u32x4*)(k1s + ko_); } while (0)
#define DA_LDV(t) do { const size_t vo_ = (size_t)(t) * 64; rv0 = *(const u32x4*)(v0s + vo_); rv1 = *(const u32x4*)(v1s + vo_); } while (0)
#define DA_STK(bf) do { *(LAS u32x4*)(lds + (bf) * 18432 + sto) = rk0; *(LAS u32x4*)(lds + (bf) * 18432 + 9216 + sto) = rk1; } while (0)
#define DA_STV(bf) do { LAS unsigned char* vd_ = lds + 36864 + (bf) * 18432 + stv; *(LAS u32x2*)(vd_) = (u32x2){rv0.x, rv0.y}; *(LAS u32x2*)(vd_ + 16) = (u32x2){rv0.z, rv0.w}; \
        *(LAS u32x2*)(vd_ + 9216) = (u32x2){rv1.x, rv1.y}; *(LAS u32x2*)(vd_ + 9216 + 16) = (u32x2){rv1.z, rv1.w}; } while (0)
        DA_STK(0); DA_STV(0); *(LAS u32x4*)(lds + 18432 + sto) = rk2; *(LAS u32x4*)(lds + 18432 + 9216 + sto) = rk3; DA_LDK(2); DA_LDV(1);
        __syncthreads();
        const f32x16 zero16 = {};
        f32x16 pA0, pA1, pB0, pB1; f32x16 o[4] = {{}, {}, {}, {}}; float m_ref = 0.f, l_run = 0.f;
        { pA0 = zero16; pA1 = zero16;
#pragma unroll
          for (int s = 0; s < 4; ++s) { pA0 = MFMA32(*(const LAS bf16x8*)(lds + kfo + 32 * s), qf[s], pA0); pA1 = MFMA32(*(const LAS bf16x8*)(lds + kfo + 4608 + 32 * s), qf[s], pA1); }
          float rm = -3.0e38f;
#pragma unroll
          for (int q = 0; q < 16; ++q) rm = da_max3(rm, pA0[q], pA1[q]);
          rm = fmaxf(rm, __shfl_xor(rm, 32)); m_ref = rm; }
        __syncthreads();
        bf16x8 pb0, pb1, pb2, pb3;
#define DA_EXP4(P, B) do { P[B] = __builtin_amdgcn_exp2f(P[B] - m_ref); P[B + 1] = __builtin_amdgcn_exp2f(P[B + 1] - m_ref); P[B + 2] = __builtin_amdgcn_exp2f(P[B + 2] - m_ref); P[B + 3] = __builtin_amdgcn_exp2f(P[B + 3] - m_ref); \
        sacc += (P[B] + P[B + 1]) + (P[B + 2] + P[B + 3]); } while (0)
#define DA_PACK(P, B) pack_frag(P[B], P[B + 1], P[B + 2], P[B + 3], P[B + 4], P[B + 5], P[B + 6], P[B + 7])
#define DA_KF(kbn, kt2, s) (*(const LAS bf16x8*)(lds + (kbn) * 18432 + kfo + (kt2) * 4608 + 32 * (s)))
#define DA_VF(vbc, dvt, k2, s2) (*(const LAS bf16x8*)(lds + (vbc) * 18432 + vfo + 4608 * (dvt) + 64 * (k2) + 32 * (s2)))
#define DA_EXP2(P, B) do { P[B] = __builtin_amdgcn_exp2f(P[B] - m_ref); P[B + 1] = __builtin_amdgcn_exp2f(P[B + 1] - m_ref); sacc += P[B] + P[B + 1]; } while (0)
#define DA_STEP(C0, C1, N0, N1, t, HASN) do { const int kbn_ = ((t) + 1) & 1, vbc_ = (t) & 1; float sacc = 0.f; bf16x8 fa_, fb_; \
        if (HASN) fa_ = DA_KF(kbn_, 0, 0); else fa_ = DA_VF(vbc_, 0, 0, 0); \
        DA_SB(); \
        if (HASN) { fb_ = DA_KF(kbn_, 1, 0); N0 = MFMA32(fa_, qf[0], zero16); } DA_EXP2(C0, 0);  DA_SB(); \
        if (HASN) { fa_ = DA_KF(kbn_, 0, 1); N1 = MFMA32(fb_, qf[0], zero16); } DA_EXP2(C0, 2);  DA_SB(); \
        if (HASN) { fb_ = DA_KF(kbn_, 1, 1); N0 = MFMA32(fa_, qf[1], N0); }   DA_EXP2(C0, 4);  DA_SB(); \
        if (HASN) { fa_ = DA_KF(kbn_, 0, 2); N1 = MFMA32(fb_, qf[1], N1); }   DA_EXP2(C0, 6);  pb0 = DA_PACK(C0, 0); DA_SB(); \
        if (HASN) { fb_ = DA_KF(kbn_, 1, 2); N0 = MFMA32(fa_, qf[2], N0); }   DA_EXP2(C0, 8);  DA_SB(); \
        if (HASN) { fa_ = DA_KF(kbn_, 0, 3); N1 = MFMA32(fb_, qf[2], N1); }   DA_EXP2(C0, 10); DA_SB(); \
        if (HASN) { fb_ = DA_KF(kbn_, 1, 3); N0 = MFMA32(fa_, qf[3], N0); }   DA_EXP2(C0, 12); DA_SB(); \
        if (HASN) { fa_ = DA_VF(vbc_, 0, 0, 0); N1 = MFMA32(fb_, qf[3], N1); } DA_EXP2(C0, 14); pb1 = DA_PACK(C0, 8); DA_SB(); \
        float rm0 = -3.0e38f, rm1 = -3.0e38f; \
        fb_ = DA_VF(vbc_, 1, 0, 0); o[0] = MFMA32(fa_, pb0, o[0]); DA_EXP2(C1, 0);  if ((t) + 2 < 32) { DA_STK((t) & 1); } DA_SB(); \
        fa_ = DA_VF(vbc_, 2, 0, 0); o[1] = MFMA32(fb_, pb0, o[1]); DA_EXP2(C1, 2);  if ((t) + 3 < 32) { DA_LDK((t) + 3); } DA_SB(); \
        fb_ = DA_VF(vbc_, 3, 0, 0); o[2] = MFMA32(fa_, pb0, o[2]); DA_EXP2(C1, 4);  DA_SB(); \
        fa_ = DA_VF(vbc_, 0, 0, 1); o[3] = MFMA32(fb_, pb0, o[3]); DA_EXP2(C1, 6);  pb2 = DA_PACK(C1, 0); DA_SB(); \
        fb_ = DA_VF(vbc_, 1, 0, 1); o[0] = MFMA32(fa_, pb1, o[0]); DA_EXP2(C1, 8);  DA_SB(); \
        fa_ = DA_VF(vbc_, 2, 0, 1); o[1] = MFMA32(fb_, pb1, o[1]); DA_EXP2(C1, 10); DA_SB(); \
        fb_ = DA_VF(vbc_, 3, 0, 1); o[2] = MFMA32(fa_, pb1, o[2]); DA_EXP2(C1, 12); DA_SB(); \
        fa_ = DA_VF(vbc_, 0, 1, 0); o[3] = MFMA32(fb_, pb1, o[3]); DA_EXP2(C1, 14); pb3 = DA_PACK(C1, 8); DA_SB(); \
        l_run += sacc; \
        fb_ = DA_VF(vbc_, 1, 1, 0); o[0] = MFMA32(fa_, pb2, o[0]); if (HASN) { rm0 = da_max3(rm0, N0[0], N0[1]); rm1 = da_max3(rm1, N0[2], N0[3]); }     if ((t) + 1 < 32) { DA_STV(((t) + 1) & 1); } DA_SB(); \
        fa_ = DA_VF(vbc_, 2, 1, 0); o[1] = MFMA32(fb_, pb2, o[1]); if (HASN) { rm0 = da_max3(rm0, N0[4], N0[5]); rm1 = da_max3(rm1, N0[6], N0[7]); }     if ((t) + 2 < 32) { DA_LDV((t) + 2); } DA_SB(); \
        fb_ = DA_VF(vbc_, 3, 1, 0); o[2] = MFMA32(fa_, pb2, o[2]); if (HASN) { rm0 = da_max3(rm0, N0[8], N0[9]); rm1 = da_max3(rm1, N0[10], N0[11]); }   DA_SB(); \
        fa_ = DA_VF(vbc_, 0, 1, 1); o[3] = MFMA32(fb_, pb2, o[3]); if (HASN) { rm0 = da_max3(rm0, N0[12], N0[13]); rm1 = da_max3(rm1, N0[14], N0[15]); } DA_SB(); \
        fb_ = DA_VF(vbc_, 1, 1, 1); o[0] = MFMA32(fa_, pb3, o[0]); if (HASN) { rm0 = da_max3(rm0, N1[0], N1[1]); rm1 = da_max3(rm1, N1[2], N1[3]); }     DA_SB(); \
        fa_ = DA_VF(vbc_, 2, 1, 1); o[1] = MFMA32(fb_, pb3, o[1]); if (HASN) { rm0 = da_max3(rm0, N1[4], N1[5]); rm1 = da_max3(rm1, N1[6], N1[7]); }     DA_SB(); \
        fb_ = DA_VF(vbc_, 3, 1, 1); o[2] = MFMA32(fa_, pb3, o[2]); if (HASN) { rm0 = da_max3(rm0, N1[8], N1[9]); rm1 = da_max3(rm1, N1[10], N1[11]); }   DA_SB(); \
        o[3] = MFMA32(fb_, pb3, o[3]); if (HASN) { rm0 = da_max3(rm0, N1[12], N1[13]); rm1 = da_max3(rm1, N1[14], N1[15]); } DA_SB(); \
        if (HASN) { float rm = fmaxf(rm0, rm1); rm = fmaxf(rm, __shfl_xor(rm, 32)) - m_ref; \
            if (__builtin_expect(__any(rm > 8.f), 0)) { const float dl = fmaxf(rm, 0.f), f = __builtin_amdgcn_exp2f(-dl); m_ref += dl; l_run *= f; \
                _Pragma("unroll") for (int d_ = 0; d_ < 4; ++d_) _Pragma("unroll") for (int q = 0; q < 16; ++q) o[d_][q] *= f; } } \
        __syncthreads(); } while (0)
#pragma unroll 1
        for (int t = 0; t < 30; t += 2) { DA_STEP(pA0, pA1, pB0, pB1, t, true); DA_STEP(pB0, pB1, pA0, pA1, t + 1, true); }
        DA_STEP(pA0, pA1, pB0, pB1, 30, true); DA_STEP(pB0, pB1, pA0, pA1, 31, false);
#undef DA_STEP
#undef DA_VF
#undef DA_KF
#undef DA_PACK
#undef DA_EXP4
#undef DA_EXP2
#undef DA_LDK
#undef DA_LDV
#undef DA_STK
#undef DA_STV
        asm volatile("" ::: "memory");
        const int un = u + F.G; const bool has_next = un < 2048;
        const int nb = un >> 7, nh = (un >> 4) & 7, nqt = un & 15; const size_t ntok0 = (size_t)nb * SL + 128 * nqt, nkb = (size_t)nb * SL;
        const bf16* nk0s = QK + (nkb + srow) * 2048 + 1024 + (2 * nh) * 64 + sch * 8; const bf16* nv0s = VT + (size_t)(nh * 128 + srow) * T + nkb + sch * 8;
        if (has_next) { const bf16* qp = QK + (ntok0 + 32 * ig + r) * 2048 + (2 * nh + mp) * 64 + 8 * hh;
#pragma unroll
            for (int s = 0; s < 4; ++s) qf[s] = *(const bf16x8*)(qp + 16 * s);
            rk0 = *(const u32x4*)(nk0s); rk1 = *(const u32x4*)(nk0s + 64); rv0 = *(const u32x4*)(nv0s); rv1 = *(const u32x4*)(nv0s + (size_t)64 * T);
            rk2 = *(const u32x4*)(nk0s + (size_t)64 * 2048); rk3 = *(const u32x4*)(nk0s + 64 + (size_t)64 * 2048); }
        l_run += __shfl_xor(l_run, 32); const float inv = __builtin_amdgcn_rcpf(l_run);
        if (mp == 1) {
#pragma unroll
            for (int dvt = 0; dvt < 4; ++dvt)
#pragma unroll
                for (int q = 0; q < 16; ++q) xb[(dvt * 16 + q) * 64 + lane] = o[dvt][q] * inv; }
        __syncthreads();
        if (mp == 0) { float ss = 0.f;
#pragma unroll
            for (int dvt = 0; dvt < 4; ++dvt)
#pragma unroll
                for (int q = 0; q < 16; ++q) { o[dvt][q] = o[dvt][q] * inv - lam * xb[(dvt * 16 + q) * 64 + lane]; ss += o[dvt][q] * o[dvt][q]; }
            int lt_ = li_s; asm volatile("" : "+s"(lt_)); const float li_ = __builtin_bit_cast(float, lt_);
            ss += __shfl_xor(ss, 32); const float rms = rsqrtf(ss * (1.f / 128.f) + EPS) * (1.f - li_);
            bf16* op = AO + (tok0 + 32 * ig + r) * 1024 + h * 128;
#pragma unroll
            for (int dvt = 0; dvt < 4; ++dvt)
#pragma unroll
                for (int q4 = 0; q4 < 4; ++q4) { const int dv0 = 32 * dvt + 8 * q4 + 4 * hh; const f32x4 gn = *(const LAS f32x4*)(gnl + h * 128 + dv0);
                    u32x2 wv; wv.x = pk2(o[dvt][4 * q4] * rms * gn[0], o[dvt][4 * q4 + 1] * rms * gn[1]); wv.y = pk2(o[dvt][4 * q4 + 2] * rms * gn[2], o[dvt][4 * q4 + 3] * rms * gn[3]);
                    *(u32x2*)(op + dv0) = wv; } }
        __syncthreads();
        if (!has_next) break;
        u = un; b = nb; h = nh; qt = nqt; tok0 = ntok0; kb = nkb; k0s = nk0s; k1s = nk0s + 64; v0s = nv0s; v1s = nv0s + (size_t)64 * T;
    }
}
#undef DA_SB

__device__ __forceinline__ void router_phase(Frame& F, const Args& A, int i  , int j, int jc) {
    LAS int* lcnt = (LAS int*)(F.lds); LAS int* lbase = lcnt + 8;
    LAS f32x4* wl = (LAS f32x4*)(F.lds + 1024);
    const bf16* X = (const bf16*)(F.ws + WS_XB); const float* ssq = (const float*)(F.ws + WS_SSQ); const float* Wr = A.router + (size_t)j * D * NE; const float* gf = A.ffn_g + i * D;
    int* list = (int*)(F.ws + WS_MISC + MISC_LIST); float* gate = (float*)(F.ws + WS_MISC + MISC_GATE); int* epos = (int*)(F.ws + WS_MISC + MISC_EPOS);
    for (int idx = F.tid; idx < 2048; idx += NTHR) { const int ln = idx & 63, kk2 = idx >> 6, k = 4 * ln + 256 * (kk2 >> 3) + ((kk2 >> 1) & 3);
        wl[idx] = *(const f32x4*)(Wr + (size_t)k * 8 + 4 * (kk2 & 1)) * gf[k]; }
    if (F.tid < 8) lcnt[F.tid] = 0;
    __syncthreads();
    const bool h5 = (F.lane & 32) != 0, h4 = (F.lane & 16) != 0, h3 = (F.lane & 8) != 0, h2 = (F.lane & 4) != 0, h1 = (F.lane & 2) != 0, h0 = (F.lane & 1) != 0;
    for (int grp = F.bid; grp < T / 128; grp += F.G) {
        int my_e0 = 0, my_e1 = 0; float my_g0 = 0.f, my_g1 = 0.f;
#pragma unroll 1
        for (int bt = 0; bt < 2; ++bt) {
            const int tok0 = grp * 128 + F.wave * 16 + bt * 8;
            asm volatile("" ::: "memory");
            u32x2 xw[8][4];
#pragma unroll
            for (int s = 0; s < 8; ++s)
#pragma unroll
                for (int q = 0; q < 4; ++q) xw[s][q] = *(const u32x2*)(X + (size_t)(tok0 + s) * D + 4 * F.lane + 256 * q);
            const u32x2 spw = *(const u32x2*)(ssq + (size_t)(tok0 + (F.lane >> 3)) * 16 + 2 * (F.lane & 7));
            f32x4 acc[8][2];
#pragma unroll
            for (int s = 0; s < 8; ++s) { acc[s][0] = f32x4{0.f, 0.f, 0.f, 0.f}; acc[s][1] = f32x4{0.f, 0.f, 0.f, 0.f}; }
#pragma unroll
            for (int q = 0; q < 4; ++q)
#pragma unroll
                for (int e4 = 0; e4 < 4; ++e4) { const f32x4 w0 = wl[((q * 4 + e4) * 2 + 0) * 64 + F.lane], w1 = wl[((q * 4 + e4) * 2 + 1) * 64 + F.lane];
#pragma unroll
                    for (int s = 0; s < 8; ++s) { const unsigned wd = (e4 < 2) ? xw[s][q].x : xw[s][q].y; const float xv = __builtin_bit_cast(float, (e4 & 1) ? (wd & 0xffff0000u) : (wd << 16));
                        acc[s][0] += w0 * xv; acc[s][1] += w1 * xv; } }
            float v32[32], v16[16], v8[8], v4[4], v2[2];
#pragma unroll
            for (int v = 0; v < 32; ++v) { const float lo = acc[v >> 3][(v >> 2) & 1][v & 3], hi = acc[(v >> 3) + 4][(v >> 2) & 1][v & 3]; v32[v] = (h5 ? hi : lo) + __shfl_xor(h5 ? lo : hi, 32); }
#pragma unroll
            for (int v = 0; v < 16; ++v) v16[v] = (h4 ? v32[v + 16] : v32[v]) + __shfl_xor(h4 ? v32[v] : v32[v + 16], 16);
#pragma unroll
            for (int v = 0; v < 8; ++v) v8[v] = (h3 ? v16[v + 8] : v16[v]) + __shfl_xor(h3 ? v16[v] : v16[v + 8], 8);
#pragma unroll
            for (int v = 0; v < 4; ++v) v4[v] = (h2 ? v8[v + 4] : v8[v]) + __shfl_xor(h2 ? v8[v] : v8[v + 4], 4);
#pragma unroll
            for (int v = 0; v < 2; ++v) v2[v] = (h1 ? v4[v + 2] : v4[v]) + __shfl_xor(h1 ? v4[v] : v4[v + 2], 2);
            const float tot = (h0 ? v2[1] : v2[0]) + __shfl_xor(h0 ? v2[0] : v2[1], 1);
            float p = __builtin_bit_cast(float, spw.x) + __builtin_bit_cast(float, spw.y); p += __shfl_xor(p, 1); p += __shfl_xor(p, 2); p += __shfl_xor(p, 4);
            float m1 = tot * rsqrtf(p * (1.f / D) + EPS), m2 = -3.0e38f; int i1 = F.lane & 7, i2 = -1;
#pragma unroll
            for (int M = 1; M < 8; M <<= 1) {
                const float pm1 = __shfl_xor(m1, M), pm2 = __shfl_xor(m2, M); const int pi1 = __shfl_xor(i1, M), pi2 = __shfl_xor(i2, M);
                const bool ab = (m1 > pm1) || (m1 == pm1 && i1 < pi1);
                const float wm = ab ? m1 : pm1, lm = ab ? pm1 : m1, sm = ab ? m2 : pm2; const int wi = ab ? i1 : pi1, li = ab ? pi1 : i1, si = ab ? i2 : pi2;
                const bool ls = (lm > sm) || (lm == sm && li < si);
                m1 = wm; i1 = wi; m2 = ls ? lm : sm; i2 = ls ? li : si; }
            const float w1 = 1.f / (1.f + __expf(m2 - m1));
            const int src = 8 * (F.lane & 7); const int ri1 = __shfl(i1, src), ri2 = __shfl(i2, src); const float rw = __shfl(w1, src);
            if ((F.lane >> 3) == bt) { my_e0 = ri1; my_e1 = ri2; my_g0 = rw; my_g1 = 1.f - rw; } }
        int p0 = 0, p1 = 0;
        if (F.lane < 16) { p0 = atomicAdd((int*)&lcnt[my_e0], 1); p1 = atomicAdd((int*)&lcnt[my_e1], 1); }
        __syncthreads();
        if (F.tid < 8) lbase[F.tid] = (int)__hip_atomic_fetch_add((unsigned*)(F.ctl + CW_CNT + jc * 1024 + 64 * F.tid), (unsigned)lcnt[F.tid], RLX_AGENT);
        __syncthreads();
        if (F.lane < 16) { const int tok = grp * 128 + F.wave * 16 + F.lane; const int q0 = lbase[my_e0] + p0, q1 = lbase[my_e1] + p1;
            list[(size_t)my_e0 * T + q0] = tok * 2; list[(size_t)my_e1 * T + q1] = tok * 2 + 1;
            epos[tok * 2] = (my_e0 << 20) | q0; epos[tok * 2 + 1] = (my_e1 << 20) | q1; gate[tok * 2] = my_g0; gate[tok * 2 + 1] = my_g1; }
        __syncthreads();
        if (F.tid < 8) lcnt[F.tid] = 0;
        __syncthreads();
    }
}
struct TileBase { int tb[9]; int cnt[8]; };
__device__ __forceinline__ void load_tilebase(Frame& F, int j, TileBase& B) {
    int run = 0;
#pragma unroll
    for (int e = 0; e < 8; ++e) { const int c = (int)__hip_atomic_load((unsigned*)(F.ctl + CW_CNT + j * 1024 + 64 * e), RLX_AGENT); B.cnt[e] = c; B.tb[e] = run; run += (c + 255) >> 8; }
    B.tb[8] = run;
}
__device__ __forceinline__ void gather_phase(Frame& F, int j) {
    TileBase B; load_tilebase(F, j, B);
    const bf16* XB = (const bf16*)(F.ws + WS_XB); unsigned char* XS = F.ws + WS_ACT + A_XS; const float* ssq = (const float*)(F.ws + WS_SSQ);
    const int* list = (const int*)(F.ws + WS_MISC + MISC_LIST); int* yrow = (int*)(F.ws + WS_MISC + MISC_YROW);
    const int gw = F.bid * NWAVES + F.wave, NGW = F.G * NWAVES, nrows = B.tb[8] * 256;
    const int my_rr = 2 * gw + 2 * NGW * (F.lane >> 1) + (F.lane & 1); int my_tk = -1; float my_rs = 0.f;
    if (my_rr < nrows) { const int gt = my_rr >> 8; int e = 0, tbe = 0, ce = B.cnt[0];
#pragma unroll
        for (int k = 1; k < 8; ++k) if (gt >= B.tb[k]) { e = k; tbe = B.tb[k]; ce = B.cnt[k]; }
        const int posr = my_rr - tbe * 256;
        if (posr < ce) { my_tk = list[(size_t)e * T + posr]; const f32x4* sp = (const f32x4*)(ssq + (size_t)(my_tk >> 1) * 16);
            const f32x4 s0 = sp[0], s1 = sp[1], s2 = sp[2], s3 = sp[3];
            const float pp = ((s0[0] + s0[1]) + (s0[2] + s0[3])) + ((s1[0] + s1[1]) + (s1[2] + s1[3])) + ((s2[0] + s2[1]) + (s2[2] + s2[3])) + ((s3[0] + s3[1]) + (s3[2] + s3[3]));
            my_rs = rsqrtf(pp * (1.f / D) + EPS); yrow[my_tk] = my_rr; } }
#define GA_LOAD(V0, V1, RS, k_) do { _Pragma("unroll") for (int s = 0; s < 4; ++s) { const int li = 2 * (k_) + s; const int tks = __builtin_amdgcn_readlane(my_tk, li & 63); \
            RS[s] = __builtin_bit_cast(float, __builtin_amdgcn_readlane(__builtin_bit_cast(int, my_rs), li & 63)); \
            const u32x4* src = (const u32x4*)(XB + (size_t)((tks < 0 ? 0 : tks) >> 1) * D) + F.lane; V0[s] = src[0]; V1[s] = src[64]; } } while (0)
#define BFLO(w) (__builtin_bit_cast(float, (w) << 16) * rsx)
#define BFHI(w) (__builtin_bit_cast(float, (w) & 0xffff0000u) * rsx)
#define GA_PROC(V0, V1, RS, k_) do { _Pragma("unroll") for (int s = 0; s < 4; ++s) { const int rr = 2 * gw + 2 * NGW * ((k_) + (s >> 1)) + (s & 1); if (rr < nrows) { const float rsx = RS[s]; u32x2 o0, o1; \
                o0.x = pg8::pack_fp8x4(BFLO(V0[s].x), BFHI(V0[s].x), BFLO(V0[s].y), BFHI(V0[s].y)); o0.y = pg8::pack_fp8x4(BFLO(V0[s].z), BFHI(V0[s].z), BFLO(V0[s].w), BFHI(V0[s].w)); \
                o1.x = pg8::pack_fp8x4(BFLO(V1[s].x), BFHI(V1[s].x), BFLO(V1[s].y), BFHI(V1[s].y)); o1.y = pg8::pack_fp8x4(BFLO(V1[s].z), BFHI(V1[s].z), BFLO(V1[s].w), BFHI(V1[s].w)); \
                u32x2* dst = (u32x2*)(XS + (size_t)rr * D) + F.lane; dst[0] = o0; dst[64] = o1; } } } while (0)
    { u32x4 a0[4], a1[4], b0[4], b1[4]; float ars[4], brs[4];
      GA_LOAD(a0, a1, ars, 0);
#pragma unroll 1
      for (int k = 0; 2 * gw + 2 * NGW * k < nrows; k += 4) {
        GA_LOAD(b0, b1, brs, k + 2);
        GA_PROC(a0, a1, ars, k);
        GA_LOAD(a0, a1, ars, k + 4);
        GA_PROC(b0, b1, brs, k + 2); } }
#undef GA_PROC
#undef GA_LOAD
#undef BFHI
#undef BFLO
}
__device__ __forceinline__ void combine_phase(Frame& F, const Args& A, bool last, int dry = 0) {
    const bf16* Y = (const bf16*)(F.ws + WS_ACT + A_Y); const int* yrow = (const int*)(F.ws + WS_MISC + MISC_YROW); const float* gate = (const float*)(F.ws + WS_MISC + MISC_GATE);
    const int gw = F.bid * NWAVES + F.wave, NGW = F.G * NWAVES;
    const bool h5 = (F.lane & 32) != 0, h4 = (F.lane & 16) != 0;
    for (int base = gw * 16; base < T; base += NGW * 16) {
        u32x2 yr = {0u, 0u}, gg = {0u, 0u};
        if (F.lane < 16) { yr = *(const u32x2*)(yrow + 2 * (base + F.lane)); gg = *(const u32x2*)(gate + 2 * (base + F.lane)); }
#pragma unroll 1
        for (int b4 = 0; b4 < 4; ++b4) { const int m0 = base + b4 * 4;
            u32x2 xw[4][4], ya[4][4], yb[4][4]; float g0[4], g1[4];
#pragma unroll
            for (int s = 0; s < 4; ++s) { const int tl = b4 * 4 + s; const int r0 = __builtin_amdgcn_readlane((int)yr.x, tl), r1 = __builtin_amdgcn_readlane((int)yr.y, tl);
                g0[s] = __builtin_bit_cast(float, __builtin_amdgcn_readlane((int)gg.x, tl)); g1[s] = __builtin_bit_cast(float, __builtin_amdgcn_readlane((int)gg.y, tl));
                const u32x2* xr = (const u32x2*)((const bf16*)(F.ws + WS_XB) + (size_t)(m0 + s) * D) + F.lane; const u32x2* y0 = (const u32x2*)(Y + (size_t)r0 * D) + F.lane; const u32x2* y1 = (const u32x2*)(Y + (size_t)r1 * D) + F.lane;
#pragma unroll
                for (int q = 0; q < 4; ++q) { xw[s][q] = xr[64 * q]; ya[s][q] = y0[64 * q]; yb[s][q] = y1[64 * q]; } }
            f32x4 v[4][4]; float sq[4];
#pragma unroll
            for (int s = 0; s < 4; ++s) { sq[s] = 0.f;
#pragma unroll
                for (int q = 0; q < 4; ++q) { const u32x2 x = xw[s][q], a = ya[s][q], b = yb[s][q];
                    v[s][q][0] = __builtin_bit_cast(float, x.x << 16) + g0[s] * __builtin_bit_cast(float, a.x << 16) + g1[s] * __builtin_bit_cast(float, b.x << 16);
                    v[s][q][1] = __builtin_bit_cast(float, x.x & 0xffff0000u) + g0[s] * __builtin_bit_cast(float, a.x & 0xffff0000u) + g1[s] * __builtin_bit_cast(float, b.x & 0xffff0000u);
                    v[s][q][2] = __builtin_bit_cast(float, x.y << 16) + g0[s] * __builtin_bit_cast(float, a.y << 16) + g1[s] * __builtin_bit_cast(float, b.y << 16);
                    v[s][q][3] = __builtin_bit_cast(float, x.y & 0xffff0000u) + g0[s] * __builtin_bit_cast(float, a.y & 0xffff0000u) + g1[s] * __builtin_bit_cast(float, b.y & 0xffff0000u);
                    if (!last) {
#pragma unroll
                        for (int e = 0; e < 4; ++e) v[s][q][e] = bf2f((bf16)f2bf(v[s][q][e])); }
                    sq[s] += (v[s][q][0] * v[s][q][0] + v[s][q][1] * v[s][q][1]) + (v[s][q][2] * v[s][q][2] + v[s][q][3] * v[s][q][3]); } }
            const float t0 = (h5 ? sq[2] : sq[0]) + __shfl_xor(h5 ? sq[0] : sq[2], 32), t1 = (h5 ? sq[3] : sq[1]) + __shfl_xor(h5 ? sq[1] : sq[3], 32);
            float tt = (h4 ? t1 : t0) + __shfl_xor(h4 ? t0 : t1, 16);
            tt += __shfl_xor(tt, 8); tt += __shfl_xor(tt, 4); tt += __shfl_xor(tt, 2); tt += __shfl_xor(tt, 1);
#pragma unroll
            for (int s = 0; s < 4; ++s) { const int m = m0 + s; const float ssum = __builtin_bit_cast(float, __builtin_amdgcn_readlane(__builtin_bit_cast(int, tt), 16 * s));
                if (last && !dry) { const float rs = rsqrtf(ssum * (1.f / D) + EPS); const f32x4* gr = (const f32x4*)A.fin_g + F.lane;
                    f32x4* orow = (f32x4*)(A.out + (size_t)m * D) + F.lane;
#pragma unroll
                    for (int q = 0; q < 4; ++q) { const f32x4 g = gr[64 * q]; f32x4 o; o[0] = v[s][q][0] * rs * g[0]; o[1] = v[s][q][1] * rs * g[1]; o[2] = v[s][q][2] * rs * g[2]; o[3] = v[s][q][3] * rs * g[3]; orow[64 * q] = o; } }
                else { u32x2* xo = dry ? (u32x2*)((bf16*)(F.ws + WS_ACT) + (size_t)m * D) + F.lane : (u32x2*)((bf16*)(F.ws + WS_XB) + (size_t)m * D) + F.lane; float* sw = dry ? (float*)(F.ws + WS_ACT + 64 * MiB) : (float*)(F.ws + WS_SSQ);
#pragma unroll
                    for (int q = 0; q < 4; ++q) { u32x2 wv; wv.x = pk2(v[s][q][0], v[s][q][1]); wv.y = pk2(v[s][q][2], v[s][q][3]); xo[64 * q] = wv; }
                    if (F.lane < 16) sw[(size_t)m * 16 + F.lane] = (F.lane == 0) ? ssum : 0.f; } }
        }
    }
}

#if DBG
struct Ck { float num, den; };
__device__ __forceinline__ float f8tof(unsigned char b) { const int s = b >> 7, e = (b >> 3) & 15, m = b & 7; float v = (e == 0) ? (float)m * 0.001953125f : (1.f + (float)m * 0.125f) * exp2f((float)(e - 7)); return s ? -v : v; }
__device__ __forceinline__ unsigned hsh(unsigned x) { x ^= x >> 16; x *= 0x7feb352dU; x ^= x >> 15; x *= 0x846ca68bU; x ^= x >> 16; return x; }
__device__ __forceinline__ void ck_acc(Ck& c, float got, float ref) { const float d = got - ref; c.num += (d == d && fabsf(d) < 1e18f) ? d * d : 1e30f; c.den += ref * ref; }
__device__ __forceinline__ void ck_flush(Frame& F, int stage, Ck c) { const float n = wave_sum(c.num), d = wave_sum(c.den);
    if (F.lane == 0) { atomicAdd((float*)(F.ctl + CW_CHK) + stage * 2, n); atomicAdd((float*)(F.ctl + CW_CHK) + stage * 2 + 1, d); } }
__device__ __forceinline__ float rs_naive(const bf16* X, int t) { float s = 0.f; for (int k = 0; k < D; ++k) { const float v = bf2f(X[(size_t)t * D + k]); s += v * v; } return rsqrtf(s * (1.f / D) + EPS); }
__device__ __forceinline__ float dotx(const bf16* X, int t, const float* gk, const float* W, int ldw, int wc) { float s = 0.f; for (int k = 0; k < D; ++k) s += bf2f(X[(size_t)t * D + k]) * gk[k] * W[(size_t)k * ldw + wc]; return s; }
__device__ __forceinline__ void sc_acc(int pos, float invf, float& sn, float& cs) { double rv = (double)pos * (double)invf * 0.15915494309189535; rv -= floor(rv); sn = __builtin_amdgcn_sinf((float)rv); cs = __builtin_amdgcn_cosf((float)rv); }
#define CK_LOOP(NS) for (unsigned s_ = (unsigned)(F.bid * NTHR + F.tid); s_ < (unsigned)(NS); s_ += (unsigned)(F.G * NTHR))

__device__ __forceinline__ void ck_proj(Frame& F, const Args& A, int stage, int mode, int i, int j) {
    Ck c = {0.f, 0.f}; const bf16* X = (const bf16*)(F.ws + WS_XB);
    CK_LOOP(4096) { const unsigned h1 = hsh(s_ * 2u + 1u + 977u * (unsigned)stage), h2 = hsh(h1 + 12345u); const int t = (int)(h1 % T); float got, ref;
        const float rs = rs_naive(X, t); const int pos = A.pos[t];
        if (mode == 1) { const int cn = (int)(h2 % 4096); const float* W = A.ev_w_in + (size_t)j * D * 3584; const float* g = A.mix_g + i * D; got = bf2f(((const bf16*)(F.ws + WS_ACT + A_PE))[(size_t)t * PEW + cn]);
            if (cn < 1536) ref = rs * dotx(X, t, g, W, 3584, cn);
            else if (cn >= 2560 && cn < 3072) ref = rs * dotx(X, t, g, W, 3584, cn + 512);
            else { const bool bcopy = cn >= 3072; const int cf_ = bcopy ? cn - 1536 : cn; const int base = cf_ & ~63, cp = cf_ & 63, gg = cp >> 3, s = cp & 7, jj = 4 * gg + (s & 3);
                const float x1 = rs * dotx(X, t, g, W, 3584, base + jj), x2 = rs * dotx(X, t, g, W, 3584, base + 32 + jj); float sn, cs; sc_acc(pos, exp2f(-(float)jj * (13.287712379549449f / 32.f)), sn, cs);
                const bool isk = cf_ >= 2048; const int head = (cf_ & 511) >> 6, l = t & (SL - 1), lm = isk ? (l & 63) : (l & 31);
                const float lgf = -__expf(A.ev_df[j * 8 + head]), lgb = -__expf(A.ev_db[j * 8 + head]);
                const float dec = bcopy ? __expf(lgb * (float)(isk ? lm : -lm)) : __expf(lgf * (float)(isk ? -lm : lm));
                ref = ((s < 4) ? x1 * cs - x2 * sn : x1 * sn + x2 * cs) * (isk ? 0.125f : 1.f) * dec; } }
        else if (mode == 2) { const int cn = (int)(h2 % 2048); const float* W = A.od_w_in + (size_t)j * D * 3072; const float* g = A.mix_g + i * D; got = bf2f(((const bf16*)(F.ws + WS_ACT + A_QK))[(size_t)t * QKP + cn]);
            const int base = cn & ~63, cp = cn & 63; const float sc = (cn < 1024) ? 0.125f * LOG2E : 1.f;
            if (cp < 16) { const int gg = cp >> 3, s = cp & 7, jj = 4 * gg + (s & 3);
                const float x1 = rs * dotx(X, t, g, W, 3072, base + jj), x2 = rs * dotx(X, t, g, W, 3072, base + 8 + jj); float sn, cs; sc_acc(pos, exp2f(-(float)jj * (18.931568569324174f / 8.f)), sn, cs);
                ref = ((s < 4) ? x1 * cs - x2 * sn : x1 * sn + x2 * cs) * sc; }
            else ref = rs * dotx(X, t, g, W, 3072, cn) * sc; }
        else if (mode == 3) { const int cn = (int)(h2 % 1024); got = bf2f(((const bf16*)(F.ws + WS_ACT + A_QX))[(size_t)t * 1024 + cn]);
            ref = rs * dotx(X, t, A.xa_g + i * D, A.xa_wq + (size_t)i * D * D, D, cn) * (LOG2E / 16.f); }
        else { const int cn = (int)(h2 % FF); got = f8tof((F.ws + WS_ACT + A_H)[(size_t)t * FF + cn]) * (1.f / MOE_HSCALE); const float* g = A.ffn_g + i * D;
            const float a = rs * dotx(X, t, g, A.ffd_g + (size_t)j * D * FF, FF, cn), b = rs * dotx(X, t, g, A.ffd_u + (size_t)j * D * FF, FF, cn); ref = a / (1.f + __expf(-a)) * b; }
        ck_acc(c, got, ref); }
    ck_flush(F, stage, c);
}
__device__ __forceinline__ void ck_swapped(Frame& F, const Args& A, int stage, int mode, int i, int j) {
    Ck c = {0.f, 0.f}; const bf16* X = (const bf16*)(F.ws + WS_XB);
    CK_LOOP(4096) { const unsigned h1 = hsh(s_ * 2u + 7u + 977u * (unsigned)stage), h2 = hsh(h1 + 999u); const int t = (int)(h1 % T), R = (int)(h2 % 1024);
        const float rs = rs_naive(X, t); const float* g = A.mix_g + i * D;
        if (mode == 0) { const float ref = rs * dotx(X, t, g, A.od_w_in + (size_t)j * D * 3072, 3072, 2048 + R); ck_acc(c, bf2f(((const bf16*)(F.ws + WS_ACT + A_VTD))[(size_t)R * VTP + t]), ref); }
        else { const float* W = A.ev_w_in + (size_t)j * D * 3584; const int Rv = R & 511;
            const float ref = rs * dotx(X, t, g, W, 3584, 2560 + Rv); ck_acc(c, bf2f(((const bf16*)(F.ws + WS_ACT + A_VTE))[(size_t)Rv * T + t]), ref); } }
    ck_flush(F, stage, c);
}
__device__ __forceinline__ void ck_res(Frame& F, const Args& A, int stage, const bf16* act, int K, const float* W, const bf16* xprev, bool f8act = false) {
    Ck c = {0.f, 0.f}, c2 = {0.f, 0.f};
    CK_LOOP(4096) { const unsigned h1 = hsh(s_ * 2u + 3u + 977u * (unsigned)stage), h2 = hsh(h1 + 4242u); const int t = (int)(h1 % T), cn = (int)(h2 % D);
        float s = 0.f; for (int k = 0; k < K; ++k) s += (f8act ? f8tof(((const unsigned char*)act)[(size_t)t * K + k]) * (1.f / MOE_HSCALE) : bf2f(act[(size_t)t * K + k])) * W[(size_t)k * D + cn];
        const float ref = bf2f(xprev[(size_t)t * D + cn]) + s, got = bf2f(((const bf16*)(F.ws + WS_XB))[(size_t)t * D + cn]); ck_acc(c, got, ref);
        float ss = 0.f; for (int k = 0; k < D; ++k) { const float v = bf2f(((const bf16*)(F.ws + WS_XB))[(size_t)t * D + k]); ss += v * v; }
        float sp = 0.f; for (int k = 0; k < 16; ++k) sp += ((const float*)(F.ws + WS_SSQ))[(size_t)t * 16 + k];
        ck_acc(c2, sp, ss); }
    ck_flush(F, stage, c); ck_flush(F, stage + 1, c2);
}
__device__ __forceinline__ void ck_memkv(Frame& F, const Args& A, int stage) {
    Ck c = {0.f, 0.f};
    CK_LOOP(4096) { const unsigned h1 = hsh(s_ * 2u + 5u), h2 = hsh(h1 + 77u); const int r = (int)(h1 % MT), cn = (int)(h2 % 4096), l = cn >> 10, n = cn & 1023; const int which = (int)((h2 >> 16) & 1);
        float ss = 0.f; for (int k = 0; k < D; ++k) { const float v = A.mem[(size_t)r * D + k]; ss += v * v; } const float rs = rsqrtf(ss * (1.f / D) + EPS);
        float s = 0.f; for (int k = 0; k < D; ++k) s += A.mem[(size_t)r * D + k] * rs * A.mem_g[k] * A.xa_wkv[((size_t)l * D + k) * 2 * D + which * D + n];
        const float got = which ? bf2f(((const bf16*)(F.ws + WS_VTX))[(size_t)cn * 4096 + r]) : bf2f(((const bf16*)(F.ws + WS_KX))[(size_t)r * 4096 + cn]);
        ck_acc(c, got, s); }
    ck_flush(F, stage, c);
}
__device__ __forceinline__ void ck_xattn(Frame& F, const Args& A, int stage, int l) {
    Ck c = {0.f, 0.f}; const bf16* Q = (const bf16*)(F.ws + WS_ACT + A_QX); const bf16* KX = (const bf16*)(F.ws + WS_KX); const bf16* VTX = (const bf16*)(F.ws + WS_VTX);
    CK_LOOP(2048) { const unsigned h1 = hsh(s_ * 2u + 9u + 977u * (unsigned)stage), h2 = hsh(h1 + 31u); const int t = (int)(h1 % T), cn = (int)(h2 % D), hd = cn >> 8, b = t >> 11;
        float m = -3e38f, lsum = 0.f, o = 0.f;
        for (int mm = 0; mm < 256; ++mm) { float s = 0.f; for (int d = 0; d < 256; ++d) s += bf2f(Q[(size_t)t * D + hd * 256 + d]) * bf2f(KX[(size_t)(b * 256 + mm) * 4096 + l * 1024 + hd * 256 + d]);
            const float mn = fmaxf(m, s), al = exp2f(m - mn), p = exp2f(s - mn); lsum = lsum * al + p; o = o * al + p * bf2f(VTX[(size_t)(l * 1024 + cn) * 4096 + b * 256 + mm]); m = mn; }
        ck_acc(c, bf2f(((const bf16*)(F.ws + WS_ACT + A_OX))[(size_t)t * D + cn]), o / lsum); }
    ck_flush(F, stage, c);
}
__device__ __forceinline__ void ck_dattn(Frame& F, const Args& A, int stage, int j, float lambda_init) {
    Ck c = {0.f, 0.f}; const bf16* QK = (const bf16*)(F.ws + WS_ACT + A_QK); const bf16* VT = (const bf16*)(F.ws + WS_ACT + A_VTD); const bf16* AO = (const bf16*)(F.ws + WS_ACT + A_AO);
    LAS float* sc = (LAS float*)(F.lds) + F.wave * 4096;
    float lam; { float s1 = 0.f, s2 = 0.f; for (int e = 0; e < 64; ++e) { s1 += A.lq1[j * 64 + e] * A.lk1[j * 64 + e]; s2 += A.lq2[j * 64 + e] * A.lk2[j * 64 + e]; } lam = __expf(s1) - __expf(s2) + lambda_init; }
    const int gw = F.bid * NWAVES + F.wave;
    for (int smp = gw; smp < 512; smp += F.G * NWAVES) { const unsigned h1 = hsh((unsigned)smp * 2u + 11u + 977u * (unsigned)stage); const int t = (int)(h1 % T), h = (int)((h1 >> 20) & 7), b = t >> 11; const size_t kb = (size_t)b * SL;
        float mx[2] = {-3e38f, -3e38f};
        for (int kk = 0; kk < 32; ++kk) { const int key = F.lane + 64 * kk;
#pragma unroll
            for (int mp = 0; mp < 2; ++mp) { float s = 0.f; for (int d = 0; d < 64; ++d) s += bf2f(QK[(size_t)t * QKP + (2 * h + mp) * 64 + d]) * bf2f(QK[(kb + key) * QKP + 1024 + (2 * h + mp) * 64 + d]);
                sc[mp * 2048 + key] = s; mx[mp] = fmaxf(mx[mp], s); } }
        LDS_WAIT(); const float m0 = wave_max(mx[0]), m1 = wave_max(mx[1]); float l0 = 0.f, l1 = 0.f;
        for (int kk = 0; kk < 32; ++kk) { const int key = F.lane + 64 * kk; const float p0 = exp2f(sc[key] - m0), p1 = exp2f(sc[2048 + key] - m1); sc[key] = p0; sc[2048 + key] = p1; l0 += p0; l1 += p1; }
        LDS_WAIT(); l0 = wave_sum(l0); l1 = wave_sum(l1);
        float v[2], ss = 0.f;
#pragma unroll
        for (int e = 0; e < 2; ++e) { const int dv = F.lane + 64 * e; float o0 = 0.f, o1 = 0.f;
            for (int key = 0; key < 2048; ++key) { const float vv = bf2f(VT[(size_t)(h * 128 + dv) * VTP + kb + key]); o0 += sc[key] * vv; o1 += sc[2048 + key] * vv; }
            v[e] = o0 / l0 - lam * o1 / l1; ss += v[e] * v[e]; }
        ss = wave_sum(ss); const float rms = rsqrtf(ss * (1.f / 128.f) + EPS) * (1.f - lambda_init);
#pragma unroll
        for (int e = 0; e < 2; ++e) { const int dv = F.lane + 64 * e; ck_acc(c, bf2f(AO[(size_t)t * D + h * 128 + dv]), v[e] * rms * A.od_gn[j * 1024 + h * 128 + dv]); }
        LDS_WAIT(); }
    ck_flush(F, stage, c);
}
__device__ __forceinline__ void ck_ret(Frame& F, const Args& A, int stage, int j) {
    Ck c = {0.f, 0.f}, c2 = {0.f, 0.f}; const bf16* PE = (const bf16*)(F.ws + WS_ACT + A_PE); const bf16* VT = (const bf16*)(F.ws + WS_ACT + A_VTE); const bf16* R = (const bf16*)(F.ws + WS_ACT + A_R);
    LAS float* sc = (LAS float*)(F.lds) + F.wave * 2048;
    const int gw = F.bid * NWAVES + F.wave;
    for (int smp = gw; smp < 1024; smp += F.G * NWAVES) { const unsigned h1 = hsh((unsigned)smp * 2u + 13u + 977u * (unsigned)stage); const int t = (int)(h1 % T), h = (int)((h1 >> 20) & 7), b = t >> 11, n = t & (SL - 1); const size_t kb = (size_t)b * SL;
        const float lgf = -__expf(A.ev_df[j * 8 + h]), lgb = -__expf(A.ev_db[j * 8 + h]);
        for (int kk = 0; kk < 32; ++kk) { const int m = F.lane + 64 * kk; float s = 0.f; for (int d = 0; d < 64; ++d) s += bf2f(PE[(size_t)t * PEW + 1536 + h * 64 + d]) * bf2f(PE[(kb + m) * PEW + 2048 + h * 64 + d]);
            s *= __expf(-lgf * (float)(n & 31)) * __expf(lgf * (float)(m & 63));
            sc[m] = s * ((m <= n) ? __expf(lgf * (float)(n - m)) : __expf(lgb * (float)(m - n))); }
        LDS_WAIT(); const int dv = F.lane; float o = 0.f; for (int m = 0; m < 2048; ++m) o += sc[m] * bf2f(VT[(size_t)(h * 64 + dv) * T + kb + m]);
        const float ss = wave_sum(o * o), rms = rsqrtf(ss * (1.f / 64.f) + EPS); const float g = bf2f(PE[(size_t)t * PEW + 2560 + h * 64 + dv]);
        ck_acc(c, bf2f(R[(size_t)t * D + 512 + h * 64 + dv]), o * rms * A.ev_gn[j * 512 + h * 64 + dv] * g / (1.f + __expf(-g)));
        LDS_WAIT(); }
    CK_LOOP(4096) { const unsigned h1 = hsh(s_ * 2u + 15u + 977u * (unsigned)stage), h2 = hsh(h1 + 5u); const int t = (int)(h1 % T), cc = (int)(h2 % 512), l = t & (SL - 1); const float* cw = A.ev_conv + (size_t)j * 1536;
        float acc = 0.f; for (int d = 0; d < 3; ++d) { const int tt = t + d - 1; const bool ok = (d == 0) ? (l > 0) : (d == 2) ? (l < SL - 1) : true;
            if (ok) acc += cw[d * 512 + cc] * bf2f(PE[(size_t)tt * PEW + 512 + cc]) * bf2f(PE[(size_t)tt * PEW + 1024 + cc]); }
        ck_acc(c2, bf2f(R[(size_t)t * D + cc]), acc * bf2f(PE[(size_t)t * PEW + cc])); }
    ck_flush(F, stage, c); ck_flush(F, stage + 1, c2);
}
__device__ __forceinline__ void ck_route(Frame& F, const Args& A, int stage, int i, int j) {
    Ck c = {0.f, 0.f}, c2 = {0.f, 0.f}; const bf16* X = (const bf16*)(F.ws + WS_XB); TileBase B; load_tilebase(F, j, B);
    const int* epos = (const int*)(F.ws + WS_MISC + MISC_EPOS); const float* gate = (const float*)(F.ws + WS_MISC + MISC_GATE); const int* yrow = (const int*)(F.ws + WS_MISC + MISC_YROW);
    CK_LOOP(2048) { const unsigned h1 = hsh(s_ * 2u + 17u + 977u * (unsigned)stage); const int t = (int)(h1 % T); const float rs = rs_naive(X, t);
        float lg[8];
#pragma unroll
        for (int e = 0; e < 8; ++e) lg[e] = rs * dotx(X, t, A.ffn_g + i * D, A.router + (size_t)j * D * NE, NE, e);
        int i1 = 0; float m1 = lg[0];
#pragma unroll
        for (int e = 1; e < 8; ++e) if (lg[e] > m1) { m1 = lg[e]; i1 = e; }
        int i2 = -1; float m2 = -3e38f;
#pragma unroll
        for (int e = 0; e < 8; ++e) if (e != i1 && lg[e] > m2) { m2 = lg[e]; i2 = e; }
        const float w1 = 1.f / (1.f + __expf(m2 - m1));
        const int e0 = epos[2 * t] >> 20, e1 = epos[2 * t + 1] >> 20;
        ck_acc(c, (e0 == i1 && e1 == i2) ? 1.f : 0.f, 1.f); ck_acc(c, gate[2 * t], w1); ck_acc(c, gate[2 * t + 1], 1.f - w1);
        const int r0 = yrow[2 * t]; int tbe = 0;
#pragma unroll
        for (int k = 0; k < 8; ++k) if (k == e0) tbe = B.tb[k];
        ck_acc(c2, (float)r0, (float)(tbe * 256 + (epos[2 * t] & 0xfffff)));
        const int cc = (int)(hsh(h1) % D); ck_acc(c2, f8tof((F.ws + WS_ACT + A_XS)[(size_t)r0 * D + cc]) + 8.f, bf2f(((const bf16*)(F.ws + WS_XB))[(size_t)t * D + cc]) * rs + 8.f); }
    ck_flush(F, stage, c); ck_flush(F, stage + 1, c2);
}
__device__ __forceinline__ void ck_moe(Frame& F, const Args& A, int stage, int which, int i, int j, int lo, int hi) {
    Ck c = {0.f, 0.f}; const bf16* X = (const bf16*)(F.ws + WS_XB); const int* epos = (const int*)(F.ws + WS_MISC + MISC_EPOS); const int* yrow = (const int*)(F.ws + WS_MISC + MISC_YROW);
    const unsigned char* HID = F.ws + WS_ACT + A_HID; const bf16* Y = (const bf16*)(F.ws + WS_ACT + A_Y);
    CK_LOOP(4096) { const unsigned h1 = hsh(s_ * 2u + 19u + 977u * (unsigned)stage), h2 = hsh(h1 + 3u); const int tk = (int)(h1 % (2 * T)), t = tk >> 1, e = epos[tk] >> 20, r = yrow[tk];
        if (r < lo * 256 || r >= hi * 256) continue;
        const size_t wo = ((size_t)j * NE + e) * (size_t)D * FE;
        if (which == 0) { const int cc = (int)(h2 % FE); const float rs = rs_naive(X, t); const float a = rs * dotx(X, t, A.ffn_g + i * D, A.moe_g + wo, FE, cc), b = rs * dotx(X, t, A.ffn_g + i * D, A.moe_u + wo, FE, cc);
            ck_acc(c, f8tof(HID[(size_t)(r - lo * 256) * FE + cc]) * (1.f / MOE_HSCALE), a / (1.f + __expf(-a)) * b); }
        else { const int cc = (int)(h2 % D); float s = 0.f; for (int k = 0; k < FE; ++k) s += f8tof(HID[(size_t)(r - lo * 256) * FE + k]) * (1.f / MOE_HSCALE) * A.moe_d[wo + (size_t)k * D + cc];
            ck_acc(c, bf2f(Y[(size_t)r * D + cc]), s); } }
    ck_flush(F, stage, c);
}
__device__ __forceinline__ void ck_comb(Frame& F, const Args& A, int stage, const bf16* xprev, bool last) {
    Ck c = {0.f, 0.f}; const bf16* Y = (const bf16*)(F.ws + WS_ACT + A_Y); const int* yrow = (const int*)(F.ws + WS_MISC + MISC_YROW); const float* gate = (const float*)(F.ws + WS_MISC + MISC_GATE);
    CK_LOOP(2048) { const unsigned h1 = hsh(s_ * 2u + 23u + 977u * (unsigned)stage), h2 = hsh(h1 + 1u); const int t = (int)(h1 % T), cc = (int)(h2 % D); const int r0 = yrow[2 * t], r1 = yrow[2 * t + 1]; const float g0 = gate[2 * t], g1 = gate[2 * t + 1];
        float ss = 0.f, vc = 0.f; for (int k = 0; k < D; ++k) { const float v = bf2f(xprev[(size_t)t * D + k]) + g0 * bf2f(Y[(size_t)r0 * D + k]) + g1 * bf2f(Y[(size_t)r1 * D + k]); ss += v * v; if (k == cc) vc = v; }
        const float ref = last ? vc * rsqrtf(ss * (1.f / D) + EPS) * A.fin_g[cc] : vc; ck_acc(c, last ? A.out[(size_t)t * D + cc] : bf2f(((const bf16*)(F.ws + WS_XB))[(size_t)t * D + cc]), ref); }
    ck_flush(F, stage, c);
}
__device__ __forceinline__ void copy_x(Frame& F, const Args& A, float* dst) {
    for (size_t it = (size_t)F.bid * NTHR + F.tid; it < (size_t)T * D / 4; it += (size_t)F.G * NTHR) ((f32x4*)dst)[it] = ((const f32x4*)A.out)[it];
}
#endif

enum { PH_PRO = 0, PH_MEMKV, PH_E1, PH_RETKV, PH_RETSCAN, PH_RETOUT, PH_D1, PH_DATTN, PH_OUTRES, PH_X1, PH_XATTN, PH_X3, PH_F1, PH_F2, PH_ROUTER, PH_GATHER, PH_M1, PH_M2, PH_COMB, PH_COUNT };
#define XB ((bf16*)(F.ws + WS_XB))
#define SSQ ((float*)(F.ws + WS_SSQ))
#define ACT (F.ws + WS_ACT)
__device__ __forceinline__ float lambda_init_of(int i) { return 0.8f - 0.6f * __expf(-0.3f * (float)i); }
template <int PH> __device__ __forceinline__ void run_phase(Frame& F, const Args& A, int i, int half, int vcu) {
    const int j = i >> 1; PG8_LAS unsigned char* const ring = (PG8_LAS unsigned char*)F.lds;
    if constexpr (PH == PH_PRO) { prologue_phase(F, A); moe_convert(F, A, 0); moe_convert(F, A, 1); }
    if constexpr (PH == PH_MEMKV) {
        { pg8::Gemm g{(const bf16*)(F.ws + WS_MEMN), (const bf16*)(F.ws + WS_WK), MT, 4096, D}; pg8::StaticOrder S; S.init(MT, 4096, F.G, F.bid);
          pg8::EpiRow<0> E{(bf16*)(F.ws + WS_KX), 4096, nullptr, nullptr, 1.f}; pg8::gemm_phase<pg8::EpiRow<0>, pg8::StaticOrder, true, true>(ring, g, S, E, F.tid); }
        { pg8::Gemm g{(const bf16*)(F.ws + WS_WV), (const bf16*)(F.ws + WS_MEMN), 4096, MT, D}; pg8::StaticOrder S; S.init(4096, MT, F.G, F.bid);
          pg8::EpiRow<0> E{(bf16*)(F.ws + WS_VTX), 4096, nullptr, nullptr, 1.f}; pg8::gemm_phase<pg8::EpiRow<0>, pg8::StaticOrder, true, true>(ring, g, S, E, F.tid); }
    }
    if constexpr (PH == PH_E1) { unsigned char* eb = F.ws + WS_EV + j * EV_STRIDE;
        { pg8::Gemm g{XB, (const bf16*)(eb + EV_INN), T, 3072, D}; pg8::StaticOrder S; S.init(T, 3072, F.G, F.bid);
          pg8::EpiRow<1> E{(bf16*)(ACT + A_PE), PEW, SSQ, A.pos, 1.f, A.ev_df + j * 8, A.ev_db + j * 8}; pg8::gemm_phase<pg8::EpiRow<1>, pg8::StaticOrder, true, true>(ring, g, S, E, F.tid); }
        { pg8::Gemm g{(const bf16*)(eb + EV_INS), XB, 512, T, D}; pg8::StaticOrder S; S.init(512, T, F.G, F.bid);
          pg8::EpiCol<0> E{(bf16*)(ACT + A_VTE), nullptr, nullptr, (size_t)T, SSQ, nullptr, nullptr, nullptr};
          pg8::gemm_phase<pg8::EpiCol<0>, pg8::StaticOrder, true, true>(ring, g, S, E, F.tid); }
    }
    if constexpr (PH == PH_RETKV) { Frame P = F; P.bid = vcu; fret_phase(P, A, j); }
    if constexpr (PH == PH_D1) { unsigned char* ob = F.ws + WS_OD + j * OD_STRIDE;
        { pg8::Gemm g{XB, (const bf16*)(ob + OD_INN), T, 2048, D}; pg8::StaticOrder S; S.init(T, 2048, F.G, F.bid);
          pg8::EpiRow<2> E{(bf16*)(ACT + A_QK), QKP, SSQ, A.pos, 1.f}; pg8::gemm_phase<pg8::EpiRow<2>, pg8::StaticOrder, true, true>(ring, g, S, E, F.tid); }
        { pg8::Gemm g{(const bf16*)(ob + OD_INS), XB, 1024, T, D}; pg8::StaticOrder S; S.init(1024, T, F.G, F.bid);
          pg8::EpiCol<0> E{(bf16*)(ACT + A_VTD), nullptr, nullptr, (size_t)VTP, SSQ, nullptr, nullptr, nullptr};
          pg8::gemm_phase<pg8::EpiCol<0>, pg8::StaticOrder, true, true>(ring, g, S, E, F.tid); }
    }
    if constexpr (PH == PH_DATTN) { Frame P = F; P.bid = vcu; dattn_phase(P, A, j, lambda_init_of(i)); }
    if constexpr (PH == PH_OUTRES) {
        const bf16* mixA = (i & 1) ? (const bf16*)(ACT + A_AO) : (const bf16*)(ACT + A_R);
        const bf16* mixB = (i & 1) ? (const bf16*)(F.ws + WS_OD + j * OD_STRIDE + OD_OUT) : (const bf16*)(F.ws + WS_EV + j * EV_STRIDE + EV_OUT);
        pg8::Gemm g{mixA, mixB, T, D, D}; pg8::StaticOrder S; S.init(T, D, F.G, F.bid);
        if (half) { pg8::EpiRes E{(bf16*)(ACT + 256 * MiB), (float*)(ACT + 320 * MiB), 1.f}; pg8::gemm_phase<pg8::EpiRes, pg8::StaticOrder, true, true>(ring, g, S, E, F.tid); }
        else { typedef pg8::EpiResT<(long long)(WS_ACT + A_XB8) - (long long)WS_XB> EpiRes8; EpiRes8 E{XB, SSQ, 1.f}; pg8::gemm_phase<EpiRes8, pg8::StaticOrder, true, true>(ring, g, S, E, F.tid); }
    }
    if constexpr (PH == PH_X1) { pg8::Gemm g{(const bf16*)(ACT + A_XB8), (const bf16*)(F.ws + WS_WQ + (size_t)i * D * D), T, D, D / 2}; pg8::StaticOrder S; S.init(T, D, F.G, F.bid);
        pg8::EpiRow<0> E{(bf16*)(ACT + A_QX), 1024, SSQ, nullptr, LOG2E / 16.f / MOE_WSCALE}; pg8::gemm_phase<pg8::EpiRow<0>, pg8::StaticOrder, true, true, true>(ring, g, S, E, F.tid); }
    if constexpr (PH == PH_XATTN) { Frame P = F; P.bid = vcu; xattn_phase(P, i); }
    if constexpr (PH == PH_X3) { pg8::Gemm g{(const bf16*)(ACT + A_OX), (const bf16*)(F.ws + WS_WO + (size_t)i * D * D), T, D, D / 2};
        pg8::StaticOrder S; S.init(T, D, F.G, F.bid); if (half) { pg8::EpiRes E{(bf16*)(ACT + 256 * MiB), (float*)(ACT + 320 * MiB), 1.f / (MOE_WSCALE * 4.f)}; pg8::gemm_phase<pg8::EpiRes, pg8::StaticOrder, true, true, true>(ring, g, S, E, F.tid); }
        else if (i & 1) { pg8::EpiRes E{XB, SSQ, 1.f / (MOE_WSCALE * 4.f)}; pg8::gemm_phase<pg8::EpiRes, pg8::StaticOrder, true, true, true>(ring, g, S, E, F.tid); }
        else { typedef pg8::EpiResT<(long long)(WS_ACT + A_XB8) - (long long)WS_XB> EpiRes8; EpiRes8 E{XB, SSQ, 1.f / (MOE_WSCALE * 4.f)}; pg8::gemm_phase<EpiRes8, pg8::StaticOrder, true, true, true>(ring, g, S, E, F.tid); } }
    if constexpr (PH == PH_F1) { pg8::Gemm g{(const bf16*)(ACT + A_XB8), (const bf16*)(F.ws + WS_EV + j * EV_STRIDE + EV_GU), T, 2 * FF, D / 2}; pg8::StaticOrder S; S.init(T, 2 * FF, F.G, F.bid);
        pg8::EpiSwiT<true> E{(void*)(ACT + A_H), FF, SSQ, 22, 1.f / MOE_WSCALE, MOE_HSCALE}; pg8::gemm_phase<pg8::EpiSwiT<true>, pg8::StaticOrder, true, true, true>(ring, g, S, E, F.tid); }
    if constexpr (PH == PH_F2) { pg8::Gemm g{(const bf16*)(ACT + A_H), (const bf16*)(F.ws + WS_EV + j * EV_STRIDE + EV_DN), T, D, FF / 2}; pg8::StaticOrder S; S.init(T, D, F.G, F.bid);
        pg8::EpiRes E{half ? (bf16*)(ACT + 304 * MiB) : XB, half ? (float*)(ACT + 368 * MiB) : SSQ, 1.f / (MOE_WSCALE * MOE_HSCALE)}; pg8::gemm_phase<pg8::EpiRes, pg8::StaticOrder, true, true, true>(ring, g, S, E, F.tid); }
    if constexpr (PH == PH_ROUTER) router_phase(F, A, i, j, j + 2 * half);
    if constexpr (PH == PH_GATHER) gather_phase(F, j);
    if constexpr (PH == PH_M1 || PH == PH_M2) {
        pg8::MoeOrder S; TileBase B; load_tilebase(F, j, B);
#pragma unroll
        for (int k = 0; k < 9; ++k) S.tb[k] = B.tb[k];
        S.nM = B.tb[8]; S.G = F.G; S.c = F.bid; S.lo = 0;
        if constexpr (PH == PH_M1) { S.nN = 28; S.nwg = S.nM * 28;
            pg8::Gemm g{(const bf16*)(ACT + A_XS), (const bf16*)(F.ws + WS_MOE + (size_t)j * MOE_STRIDE), 0, 0, D / 2};
            pg8::EpiSwiT<true> E{(void*)(ACT + A_HID), FE, nullptr, 28, 1.f / MOE_WSCALE, MOE_HSCALE};
            pg8::gemm_phase<pg8::EpiSwiT<true>, pg8::MoeOrder, true, true, true>(ring, g, S, E, F.tid); }
        else { S.nN = 4; S.nwg = S.nM * 4;
            pg8::Gemm g{(const bf16*)(ACT + A_HID), (const bf16*)(F.ws + WS_MOE + (size_t)j * MOE_STRIDE + MOE_DN), 0, 0, FE / 2};
            pg8::EpiY E{(bf16*)(ACT + A_Y), 1024, 4, 1.f / (MOE_WSCALE * MOE_HSCALE)};
            pg8::gemm_phase<pg8::EpiY, pg8::MoeOrder, true, true, true>(ring, g, S, E, F.tid); }
    }
    if constexpr (PH == PH_COMB) combine_phase(F, A, i == 3, half);
}
__device__ __forceinline__ void make_frame(Frame& F, const Args& A, unsigned char* lds_raw, int& vcu) {
    F.lds = (LAS unsigned char*)lds_raw; F.tid = threadIdx.x; F.lane = F.tid & 63; F.wave = __builtin_amdgcn_readfirstlane(F.tid >> 6);
    F.G = gridDim.x; F.bid = blockIdx.x; F.ws = A.ws; F.ctl = (gu32*)(A.ws + WS_CTL);
    vcu = (F.G % 8 == 0) ? (F.bid % 8) * (F.G / 8) + F.bid / 8 : F.bid;
}


constexpr int NPHASES = 48;
__global__ void __launch_bounds__(NTHR, 2) fwd(Args A_) {
#if defined(__HIP_DEVICE_COMPILE__)
    extern __shared__ __attribute__((aligned(16))) unsigned char lds_raw[];
    typedef const Args __attribute__((address_space(4))) * KArgsP;
    KArgsP ap = (KArgsP)__builtin_amdgcn_kernarg_segment_ptr();
    { LAS unsigned char* lds = (LAS unsigned char*)lds_raw;
      for (int u = threadIdx.x; u < (LDS_BYTES - LDSCTL_OFF) / 4; u += NTHR) ((LAS unsigned*)(lds + LDSCTL_OFF))[u] = 0u; }
    int wave_s = __builtin_amdgcn_readfirstlane((int)threadIdx.x >> 6); asm volatile("" : "+s"(wave_s));
    __syncthreads();
    (void)xcd_barrier_post((unsigned*)(A_.ws + WS_CTL) + CW_BAR, (volatile LAS unsigned*)((LAS unsigned char*)lds_raw + LDSCTL_OFF));
#define RUN(PH, i, half) do { { unsigned lo_ = (unsigned)(unsigned long long)ap, hi_ = (unsigned)((unsigned long long)ap >> 32); asm volatile("" : "+v"(lo_), "+v"(hi_)); \
          ap = (KArgsP)(((unsigned long long)(unsigned)__builtin_amdgcn_readfirstlane((int)hi_) << 32) | (unsigned long long)(unsigned)__builtin_amdgcn_readfirstlane((int)lo_)); } Frame P; int vcu_; const Args AL = *ap; \
        { P.lds = (LAS unsigned char*)lds_raw; unsigned z_ = 0u; asm volatile("" : "+v"(z_)); int t_ = wave_s * 64 + (int)__builtin_amdgcn_mbcnt_hi(~0u, __builtin_amdgcn_mbcnt_lo(~0u, z_)); P.tid = t_; P.lane = t_ & 63; P.wave = __builtin_amdgcn_readfirstlane(t_ >> 6); \
          P.G = gridDim.x; P.bid = blockIdx.x; P.ws = AL.ws; P.ctl = (gu32*)(P.ws + WS_CTL); vcu_ = (P.G % 8 == 0) ? (P.bid % 8) * (P.G / 8) + P.bid / 8 : P.bid; } \
        run_phase<PH>(P, AL, (i), (half), vcu_); } while (0)
#define SEAM() do { XcdBarrier b_; b_.bar = (unsigned*)(ap->ws + WS_CTL) + CW_BAR; b_.x = xb_xcc_id(); b_.st = (volatile LAS unsigned*)((LAS unsigned char*)lds_raw + LDSCTL_OFF); { unsigned zb_ = 0u; asm volatile("" : "+v"(zb_)); b_.t0 = (wave_s == 0) && (__builtin_amdgcn_mbcnt_hi(~0u, __builtin_amdgcn_mbcnt_lo(~0u, zb_)) == 0u); } xcd_barrier(b_); } while (0)
#ifndef DUPMASK
#define DUPMASK 0u
#endif
#define RUNS(PH, i, half) do { if ((DUPMASK >> PH) & 1u) { RUN(PH, i, 1); SEAM(); } RUN(PH, i, 0); SEAM(); } while (0)
    RUNS(PH_PRO, 0, 0); RUN(PH_MEMKV, 0, 0);
    for (int i = 0; i < 4; ++i) {
        if ((i & 1) == 0) { RUNS(PH_E1, i, 0); RUNS(PH_RETKV, i, 0); }
        else { RUNS(PH_D1, i, 0); RUNS(PH_DATTN, i, 0); }
        RUNS(PH_OUTRES, i, 0); RUNS(PH_X1, i, 0); RUNS(PH_XATTN, i, 0); RUNS(PH_X3, i, 0);
        if ((i & 1) == 0) { RUNS(PH_F1, i, 0); RUNS(PH_F2, i, 0); }
        else { RUNS(PH_ROUTER, i, 0); RUNS(PH_GATHER, i, 0);
            RUNS(PH_M1, i, 0); RUNS(PH_M2, i, 0);
            if ((DUPMASK >> PH_COMB) & 1u) { RUN(PH_COMB, i, 1); SEAM(); } RUN(PH_COMB, i, 0); if (i != 3) SEAM(); }
    }
#undef RUN
#undef SEAM
#endif
}
#undef XB
#undef SSQ
#undef ACT
extern "C" void kernel_launch(void* const* d_in, const int* in_sizes, int n_in, void* d_out, int out_size, void* d_ws, size_t ws_size, hipStream_t stream) {
    static int grid = 0;
    if (grid == 0) {
        if (n_in != 31 || out_size != T * D || ws_size < WS_END) { fprintf(stderr, "kernel_launch: unexpected shapes (n_in %d, out %d, ws %zu < %zu)\n", n_in, out_size, ws_size, (size_t)WS_END); grid = -1; return; }
        int dev = 0, cus = 0, per_cu = 0;
        if (hipGetDevice(&dev) != hipSuccess || hipDeviceGetAttribute(&cus, hipDeviceAttributeMultiprocessorCount, dev) != hipSuccess) { grid = -1; return; }
        if (hipFuncSetAttribute((const void*)fwd, hipFuncAttributeMaxDynamicSharedMemorySize, LDS_BYTES) != hipSuccess) { fprintf(stderr, "kernel_launch: hipFuncSetAttribute failed\n"); grid = -1; return; }
        if (hipOccupancyMaxActiveBlocksPerMultiprocessor(&per_cu, (const void*)fwd, NTHR, LDS_BYTES) != hipSuccess || per_cu < 1) fprintf(stderr, "kernel_launch: occupancy query reports %d\n", per_cu);
        (void)hipGetLastError();
        grid = cus;
    }
    if (grid < 0) return;
    if (hipMemsetAsync((char*)d_ws + WS_CTL, 0, CTL_BYTES, stream) != hipSuccess) return;
    Args a{};
    const float** fp = (const float**)&a;
    for (int k = 0; k < 31; ++k) fp[k] = (const float*)d_in[k];
    a.out = (float*)d_out; a.ws = (unsigned char*)d_ws; a.ph_lo = 0; a.ph_hi = NPHASES;
    hipLaunchKernelGGL(fwd, dim3(grid), dim3(NTHR), LDS_BYTES, stream, a);
}
```

```cpp
#include <hip/hip_runtime.h>
#include <cstdio>
#include <cstdint>
#define DBG 0
namespace pg8 {
#define PG8_LAS __attribute__((address_space(3)))
typedef unsigned short bf16_t;
typedef short bf16x8 __attribute__((ext_vector_type(8)));
typedef float f32x4 __attribute__((ext_vector_type(4)));
typedef unsigned u32x4 __attribute__((ext_vector_type(4)));
constexpr int BM = 256, BK = 64, HALF = 128, HTB = HALF * BK * 2  , STAGE_BYTES = 8 * HTB, NXCD = 8, WGM = 8;

__host__ __device__ __forceinline__ int lds_byte(int r, int c) { const int st = (r >> 4) * 2 + (c >> 5), rr = r & 15, cc = c & 31, ob = rr * 64 + cc * 2; return st * 1024 + (ob ^ (((ob >> 9) & 1) << 5)); }
__host__ __device__ __forceinline__ void stage_rc(int b, int& R, int& C) { const int st = b / 1024, sb = b % 1024, swz = sb ^ (((sb >> 9) & 1) << 5); R = (st >> 1) * 16 + swz / 64; C = (st & 1) * 32 + (swz % 64) / 2; }
__host__ __device__ __forceinline__ int perm32(int rho) { const int n = rho >> 4, i = rho & 15; return 8 * (i >> 2) + 4 * n + (i & 3); }

struct Unit { int pm, pn; };
#ifdef GPROBE_ID
__device__ unsigned gp_buf[4];
#endif
struct Gemm { const bf16_t* A; const bf16_t* Bt; int M, N, K; };

struct StaticOrder {
    int nM, nN, nwg, G, c;
    __host__ __device__ void init(int M, int N, int G_, int c_) { nM = M / BM; nN = N / BM; nwg = nM * nN; G = G_; c = c_; }
    __host__ __device__ bool next(int i, Unit& u) const {
        const long L = (long)i * G + c; if (L >= nwg) return false;
        int wgid = (int)L; { const int q = nwg / NXCD, r = nwg % NXCD, xcd = wgid % NXCD, off = wgid / NXCD; wgid = (xcd < r ? xcd * (q + 1) : r * (q + 1) + (xcd - r) * q) + off; }
        const int nig = WGM * nN, gid = wgid / nig, fm = gid * WGM, gsz = (nM - fm) < WGM ? (nM - fm) : WGM;
        u.pm = fm + ((wgid % nig) % gsz); u.pn = (wgid % nig) / gsz; return true;
    }
    __device__ __forceinline__ void a_ready(const Unit&) const {}
    __device__ __forceinline__ void done(const Unit&) const {}
};

typedef float f32x2 __attribute__((ext_vector_type(2)));
typedef int v4i_t __attribute__((ext_vector_type(4)));
typedef int v8i_t __attribute__((ext_vector_type(8)));
__device__ __forceinline__ v8i_t cat8(bf16x8 a, bf16x8 b) { const v4i_t x = __builtin_bit_cast(v4i_t, a), y = __builtin_bit_cast(v4i_t, b); return __builtin_shufflevector(x, y, 0, 1, 2, 3, 4, 5, 6, 7); }
__device__ __forceinline__ unsigned pack_fp8x4(float a, float b, float c, float d) {
    a = fminf(fmaxf(a, -440.f), 440.f); b = fminf(fmaxf(b, -440.f), 440.f); c = fminf(fmaxf(c, -440.f), 440.f); d = fminf(fmaxf(d, -440.f), 440.f);
    int w = 0; w = __builtin_amdgcn_cvt_pk_fp8_f32(a, b, w, false); w = __builtin_amdgcn_cvt_pk_fp8_f32(c, d, w, true); return (unsigned)w; }
__device__ __forceinline__ unsigned cvt_pk_bf16(float lo, float hi) { unsigned r; asm volatile("v_cvt_pk_bf16_f32 %0, %1, %2" : "=v"(r) : "v"(lo), "v"(hi)); return r; }
__device__ __forceinline__ u32x4 pack8(const f32x4 a, const f32x4 b) { u32x4 w; w.x = cvt_pk_bf16(a[0], a[1]); w.y = cvt_pk_bf16(a[2], a[3]); w.z = cvt_pk_bf16(b[0], b[1]); w.w = cvt_pk_bf16(b[2], b[3]); return w; }
constexpr float RMS_EPS = 1e-6f, INV_D = 1.f / 1024.f, INV_2PI = 0.15915494309189535f, LOG2E = 1.4426950408889634f;
constexpr float L2_RET_THETA_32 = 13.287712379549449f / 32.f;
constexpr float L2_ROPE_THETA_8 = 18.931568569324174f / 8.f;
__device__ __forceinline__ float rs_row4(const float* ssq, int row, int fq) {
    const f32x4 p = *(const f32x4*)(ssq + (size_t)row * 16 + 4 * fq);
    float s = (p[0] + p[1]) + (p[2] + p[3]);
    s += __shfl_xor(s, 16); s += __shfl_xor(s, 32);
    return rsqrtf(s * INV_D + RMS_EPS);
}
__device__ __forceinline__ void sincos_rev(float rev, float& sn, float& cs) { rev -= floorf(rev); sn = __builtin_amdgcn_sinf(rev); cs = __builtin_amdgcn_cosf(rev); }

template <int MODE> struct EpiRow {
    static constexpr bool PERM = true, AFTER_DRAIN = false;
    bf16_t* O; int ldc; const float* ssq; const int* pos; float sc; const float* decf; const float* decb;
    __device__ __forceinline__ void operator()(const f32x4 (&acc)[2][2][4][2], const Unit& u, int wr, int wc, int fr, int fq) const {
        const int row0 = u.pm * BM + wr * 64 + fr, col0 = u.pn * BM + wc * 32 + 8 * fq;
        bool rope = false; float cf[4] = {0.f, 0.f, 0.f, 0.f}; float csc = sc;
        float lgf[2] = {0.f, 0.f}, lgb[2] = {0.f, 0.f};
        if (MODE == 1) { rope = (u.pn >= 6 && u.pn < 10); csc = (u.pn == 8 || u.pn == 9) ? 0.125f : 1.f; const int g = (wc & 1) * 4 + fq;
#pragma unroll
            for (int j = 0; j < 4; ++j) cf[j] = __builtin_amdgcn_exp2f(-(float)(4 * g + j) * L2_RET_THETA_32) * INV_2PI;
            if (rope) {
#pragma unroll
                for (int bj = 0; bj < 2; ++bj) { const int head = 4 * (u.pn & 1) + 2 * bj + (wc >> 1); lgf[bj] = -__expf(decf[head]) * LOG2E; lgb[bj] = -__expf(decb[head]) * LOG2E; } } }
        if (MODE == 2) { rope = ((wc & 1) == 0) && (fq < 2); csc = (u.pn < 4) ? 0.125f * LOG2E : 1.f;
#pragma unroll
            for (int j = 0; j < 4; ++j) cf[j] = __builtin_amdgcn_exp2f(-(float)(4 * fq + j) * L2_ROPE_THETA_8) * INV_2PI; }
        float rsv[8], posv[8];
#pragma unroll
        for (int k = 0; k < 8; ++k) { const int row = row0 + (k >> 2) * HALF + (k & 3) * 16; rsv[k] = ssq ? rs_row4(ssq, row, fq) : 1.f; posv[k] = (MODE != 0) ? (float)pos[row] : 0.f; }
#pragma unroll
        for (int k = 0; k < 8; ++k) asm volatile("" : "+v"(rsv[k]), "+v"(posv[k]));
#pragma unroll
        for (int ai = 0; ai < 2; ++ai)
#pragma unroll
            for (int m = 0; m < 4; ++m) { const int row = row0 + ai * HALF + m * 16;
                const float s = rsv[ai * 4 + m] * csc;
                float sn[4], cs[4];
                if (MODE == 2 || (MODE == 1 && rope)) { const float posf = posv[ai * 4 + m];
#pragma unroll
                    for (int j = 0; j < 4; ++j) sincos_rev(posf * cf[j], sn[j], cs[j]); }
                else {
#pragma unroll
                    for (int j = 0; j < 4; ++j) { sn[j] = 0.f; cs[j] = 1.f; } }
#pragma unroll
                for (int bj = 0; bj < 2; ++bj) { f32x4 v0 = acc[ai][bj][m][0] * s, v1 = acc[ai][bj][m][1] * s;
                    if (MODE != 0) { if (rope) {
#pragma unroll
                        for (int j = 0; j < 4; ++j) { const float x1 = v0[j], x2 = v1[j]; v0[j] = x1 * cs[j] - x2 * sn[j]; v1[j] = x1 * sn[j] + x2 * cs[j]; } } }
                    if (MODE == 1 && rope) {
                        const bool isk = u.pn >= 8; const int lm = isk ? (row & 63) : (row & 31);
                        const float ff = __builtin_amdgcn_exp2f(lgf[bj] * (float)(isk ? -lm : lm)), fb = __builtin_amdgcn_exp2f(lgb[bj] * (float)(isk ? lm : -lm));
                        *(u32x4*)(O + (size_t)row * ldc + col0 + bj * HALF) = pack8(v0 * ff, v1 * ff);
                        *(u32x4*)(O + (size_t)row * ldc + col0 + bj * HALF + 1536) = pack8(v0 * fb, v1 * fb); }
                    else *(u32x4*)(O + (size_t)row * ldc + col0 + bj * HALF) = pack8(v0, v1); } }
    }
};

template <int MODE> struct EpiCol {
    static constexpr bool PERM = true, AFTER_DRAIN = false;
    bf16_t* O; bf16_t* KF; bf16_t* KB; size_t ldc; const float* ssq; const int* pos; const float* decf; const float* decb;
    __device__ __forceinline__ float rs_tok(int tok, int fr) const { float p = ssq[(size_t)tok * 16 + fr]; p += __shfl_xor(p, 1); p += __shfl_xor(p, 2); p += __shfl_xor(p, 4); p += __shfl_xor(p, 8); return rsqrtf(p * INV_D + RMS_EPS); }
    __device__ __forceinline__ void operator()(const f32x4 (&acc)[2][2][4][2], const Unit& u, int wr, int wc, int fr, int fq) const {
        const int R0 = u.pm * BM + wr * 64 + fr, tok0 = u.pn * BM + wc * 32 + 8 * fq;
        typedef unsigned u32x2v __attribute__((ext_vector_type(2)));
        float rs16[16];
        if (ssq) { const int tkm = tok0 + (fr >> 3) * HALF + (fr & 7); const f32x4* sp = (const f32x4*)(ssq + (size_t)tkm * 16); const f32x4 s0 = sp[0], s1 = sp[1], s2 = sp[2], s3 = sp[3];
            const float pp = ((s0[0] + s0[1]) + (s0[2] + s0[3])) + ((s1[0] + s1[1]) + (s1[2] + s1[3])) + ((s2[0] + s2[1]) + (s2[2] + s2[3])) + ((s3[0] + s3[1]) + (s3[2] + s3[3]));
            const float myrs = rsqrtf(pp * INV_D + RMS_EPS); const int lb = (fq << 4);
#pragma unroll
            for (int t = 0; t < 16; ++t) rs16[t] = __shfl(myrs, lb + t); }
        else {
#pragma unroll
            for (int t = 0; t < 16; ++t) rs16[t] = 1.f; }
#pragma unroll
        for (int bj = 0; bj < 2; ++bj)
#pragma unroll
            for (int n = 0; n < 2; ++n) { const int tk = tok0 + bj * HALF + 4 * n;
                f32x4 rs;
#pragma unroll
                for (int j = 0; j < 4; ++j) rs[j] = rs16[bj * 8 + n * 4 + j];
                if (MODE == 1 && u.pm < 2) {
                    f32x4 posf;
#pragma unroll
                    for (int j = 0; j < 4; ++j) posf[j] = (float)pos[tk + j];
#pragma unroll
                    for (int mm = 0; mm < 2; ++mm) { const float cfm = __builtin_amdgcn_exp2f(-(float)(16 * mm + fr) * L2_RET_THETA_32) * INV_2PI;
                        f32x4 sn, cs;
#pragma unroll
                        for (int j = 0; j < 4; ++j) { float a, b; sincos_rev(posf[j] * cfm, a, b); sn[j] = a; cs[j] = b; }
#pragma unroll
                        for (int ai = 0; ai < 2; ++ai) { const int head = u.pm * 4 + ai * 2 + wr;
                            const float lgf = -__expf(decf[head]) * LOG2E, lgb = -__expf(decb[head]) * LOG2E;
                            const f32x4 x1 = acc[ai][bj][mm][n] * (rs * 0.125f), x2 = acc[ai][bj][mm + 2][n] * (rs * 0.125f);
                            const f32x4 y1 = x1 * cs - x2 * sn, y2 = x1 * sn + x2 * cs;
                            f32x4 wf, wb;
#pragma unroll
                            for (int j = 0; j < 4; ++j) { const int ci = (tk + j) & 127; wf[j] = __builtin_amdgcn_exp2f(lgf * (float)(127 - ci)); wb[j] = __builtin_amdgcn_exp2f(lgb * (float)ci); }
                            const size_t o1 = (size_t)(R0 + ai * HALF + mm * 16) * ldc + tk, o2 = o1 + (size_t)32 * ldc;
                            f32x4 t; u32x2v w;
                            t = y1 * wf; w.x = cvt_pk_bf16(t[0], t[1]); w.y = cvt_pk_bf16(t[2], t[3]); *(u32x2v*)(KF + o1) = w;
                            t = y2 * wf; w.x = cvt_pk_bf16(t[0], t[1]); w.y = cvt_pk_bf16(t[2], t[3]); *(u32x2v*)(KF + o2) = w;
                            t = y1 * wb; w.x = cvt_pk_bf16(t[0], t[1]); w.y = cvt_pk_bf16(t[2], t[3]); *(u32x2v*)(KB + o1) = w;
                            t = y2 * wb; w.x = cvt_pk_bf16(t[0], t[1]); w.y = cvt_pk_bf16(t[2], t[3]); *(u32x2v*)(KB + o2) = w; } }
                } else {
                    const int Roff = (MODE == 1) ? -512 : 0;
#pragma unroll
                    for (int ai = 0; ai < 2; ++ai)
#pragma unroll
                        for (int m = 0; m < 4; ++m) { const f32x4 t = acc[ai][bj][m][n] * rs; u32x2v w; w.x = cvt_pk_bf16(t[0], t[1]); w.y = cvt_pk_bf16(t[2], t[3]);
                            *(u32x2v*)(O + (size_t)(R0 + Roff + ai * HALF + m * 16) * ldc + tk) = w; }
                } }
    }
};

template <long long X8OFF = 0> struct EpiResT {
    static constexpr bool PERM = true, AFTER_DRAIN = false;
    bf16_t* XB; float* ssq; float sc;
    __device__ __forceinline__ void operator()(const f32x4 (&acc)[2][2][4][2], const Unit& u, int wr, int wc, int fr, int fq) const {
        const int row0 = u.pm * BM + wr * 64 + fr, col0 = u.pn * BM + wc * 32 + 8 * fq;
        u32x4 xv[4][2];
#pragma unroll
        for (int m = 0; m < 4; ++m)
#pragma unroll
            for (int bj = 0; bj < 2; ++bj) xv[m][bj] = *(const u32x4*)(XB + (size_t)(row0 + m * 16) * 1024 + col0 + bj * HALF);
#pragma unroll
        for (int ai = 0; ai < 2; ++ai) {
            float ss[4];
#pragma unroll
            for (int m = 0; m < 4; ++m) { bf16_t* xr = XB + (size_t)(row0 + ai * HALF + m * 16) * 1024 + col0; ss[m] = 0.f;
#pragma unroll
                for (int bj = 0; bj < 2; ++bj) { const u32x4 x = xv[m][bj]; f32x4 a, b;
                    if (ai == 0) xv[m][bj] = *(const u32x4*)(XB + (size_t)(row0 + HALF + m * 16) * 1024 + col0 + bj * HALF);
                    a[0] = __builtin_bit_cast(float, x.x << 16); a[1] = __builtin_bit_cast(float, x.x & 0xffff0000u); a[2] = __builtin_bit_cast(float, x.y << 16); a[3] = __builtin_bit_cast(float, x.y & 0xffff0000u);
                    b[0] = __builtin_bit_cast(float, x.z << 16); b[1] = __builtin_bit_cast(float, x.z & 0xffff0000u); b[2] = __builtin_bit_cast(float, x.w << 16); b[3] = __builtin_bit_cast(float, x.w & 0xffff0000u);
                    a = a + acc[ai][bj][m][0] * sc; b = b + acc[ai][bj][m][1] * sc;
                    const u32x4 w = pack8(a, b); *(u32x4*)(xr + bj * HALF) = w;
                    a[0] = __builtin_bit_cast(float, w.x << 16); a[1] = __builtin_bit_cast(float, w.x & 0xffff0000u); a[2] = __builtin_bit_cast(float, w.y << 16); a[3] = __builtin_bit_cast(float, w.y & 0xffff0000u);
                    b[0] = __builtin_bit_cast(float, w.z << 16); b[1] = __builtin_bit_cast(float, w.z & 0xffff0000u); b[2] = __builtin_bit_cast(float, w.w << 16); b[3] = __builtin_bit_cast(float, w.w & 0xffff0000u);
                    if constexpr (X8OFF != 0) { typedef unsigned u32x2v __attribute__((ext_vector_type(2))); u32x2v o; o.x = pack_fp8x4(a[0], a[1], a[2], a[3]); o.y = pack_fp8x4(b[0], b[1], b[2], b[3]);
                        *(u32x2v*)((unsigned char*)XB + X8OFF + (size_t)(row0 + ai * HALF + m * 16) * 1024 + col0 + bj * HALF) = o; }
                    ss[m] += (a[0] * a[0] + a[1] * a[1]) + (a[2] * a[2] + a[3] * a[3]) + (b[0] * b[0] + b[1] * b[1]) + (b[2] * b[2] + b[3] * b[3]); } }
#pragma unroll
            for (int m = 0; m < 4; ++m) ss[m] += __shfl_xor(ss[m], 16);
#pragma unroll
            for (int m = 0; m < 4; ++m) ss[m] += __shfl_xor(ss[m], 32);
            if (fq == 0) {
#pragma unroll
                for (int m = 0; m < 4; ++m) ssq[(size_t)(row0 + ai * HALF + m * 16) * 16 + u.pn * 4 + wc] = ss[m]; }
        }
    }
};

typedef EpiResT<0> EpiRes;

template <bool F8OUT> struct EpiSwiT {
    static constexpr bool PERM = true, AFTER_DRAIN = false;
    void* O; int ldc; const float* ssq; int nN; float asc, osc;
    __device__ __forceinline__ void operator()(const f32x4 (&acc)[2][2][4][2], const Unit& u, int wr, int wc, int fr, int fq) const {
        const int row0 = u.pm * BM + wr * 64 + fr, col0 = (u.pn % nN) * HALF + wc * 32 + 8 * fq;
        float rsv[8];
#pragma unroll
        for (int k = 0; k < 8; ++k) { const int row = row0 + (k >> 2) * HALF + (k & 3) * 16; rsv[k] = F8OUT ? (ssq ? rs_row4(ssq, row, fq) * asc : asc) : rs_row4(ssq, row, fq); }
        if (ssq) {
#pragma unroll
            for (int k = 0; k < 8; ++k) asm volatile("" : "+v"(rsv[k])); }
#pragma unroll
        for (int ai = 0; ai < 2; ++ai)
#pragma unroll
            for (int m = 0; m < 4; ++m) { const int row = row0 + ai * HALF + m * 16;
                const float rs = rsv[ai * 4 + m], kneg = -rs * LOG2E, c2 = rs * rs * (F8OUT ? osc : 1.f);
                f32x4 h[2];
#pragma unroll
                for (int n = 0; n < 2; ++n) { const f32x4 a = acc[ai][0][m][n], b = acc[ai][1][m][n]; const f32x4 t = a * kneg; f32x4 d;
#pragma unroll
                    for (int j = 0; j < 4; ++j) d[j] = __builtin_amdgcn_exp2f(t[j]);
                    d = d + 1.f;
#pragma unroll
                    for (int j = 0; j < 4; ++j) d[j] = __builtin_amdgcn_rcpf(d[j]);
                    h[n] = ((a * b) * c2) * d; }
                if (F8OUT) { typedef unsigned u32x2v __attribute__((ext_vector_type(2))); u32x2v w; w.x = pack_fp8x4(h[0][0], h[0][1], h[0][2], h[0][3]); w.y = pack_fp8x4(h[1][0], h[1][1], h[1][2], h[1][3]);
                    *(u32x2v*)((unsigned char*)O + (size_t)row * ldc + col0) = w; }
                else *(u32x4*)((bf16_t*)O + (size_t)row * ldc + col0) = pack8(h[0], h[1]); }
    }
};
typedef EpiSwiT<false> EpiSwi;

struct EpiY {
    static constexpr bool PERM = true, AFTER_DRAIN = false;
    bf16_t* O; int ldc; int nN; float sc;
    __device__ __forceinline__ void operator()(const f32x4 (&acc)[2][2][4][2], const Unit& u, int wr, int wc, int fr, int fq) const {
        const int row0 = u.pm * BM + wr * 64 + fr, col0 = (u.pn % nN) * BM + wc * 32 + 8 * fq;
#pragma unroll
        for (int ai = 0; ai < 2; ++ai)
#pragma unroll
            for (int m = 0; m < 4; ++m)
#pragma unroll
                for (int bj = 0; bj < 2; ++bj)
                    *(u32x4*)(O + (size_t)(row0 + ai * HALF + m * 16) * ldc + col0 + bj * HALF) = pack8(acc[ai][bj][m][0] * sc, acc[ai][bj][m][1] * sc);
    }
};

struct MoeOrder {
    int nM, nN, nwg, G, c, lo; int tb[9];
    __device__ __forceinline__ bool next(int i, Unit& u) const {
        const long L = (long)i * G + c; if (L >= nwg) return false;
        int wgid = (int)L; { const int q = nwg / NXCD, r = nwg % NXCD, xcd = wgid % NXCD, off = wgid / NXCD; wgid = (xcd < r ? xcd * (q + 1) : r * (q + 1) + (xcd - r) * q) + off; }
        const int nig = WGM * nN, gid = wgid / nig, fm = gid * WGM, gsz = (nM - fm) < WGM ? (nM - fm) : WGM;
        u.pm = fm + ((wgid % nig) % gsz); const int pn = (wgid % nig) / gsz; const int gt = lo + u.pm; int e = 0;
#pragma unroll
        for (int k = 1; k < 8; ++k) e += (gt >= tb[k]) ? 1 : 0;
        u.pn = e * nN + pn; return true;
    }
    __device__ __forceinline__ void a_ready(const Unit&) const {}
    __device__ __forceinline__ void done(const Unit&) const {}
};
template <class Epi, class Sched, bool ALIGN_EPI = false, bool SP2 = false, bool F8 = false>
__device__ __forceinline__ void gemm_phase(PG8_LAS unsigned char* lds, const Gemm g, const Sched& S, const Epi& E, int tid_in) {
    int tid_ = tid_in; asm volatile("" : "+v"(tid_));
    const int tid = tid_, wid = __builtin_amdgcn_readfirstlane(tid >> 6), lane = tid & 63, wr = wid >> 2, wc = wid & 3, fr = lane & 15, fq = lane >> 4;
    int Kv_ = g.K; asm volatile("" : "+v"(Kv_)); const int K = __builtin_amdgcn_readfirstlane(Kv_), nt = K / BK;
    unsigned voffA[2], voffB[2];
#pragma unroll
    for (int i = 0; i < 2; ++i) { int R, C; stage_rc(tid * 16 + i * 8192, R, C); const int Rb = Epi::PERM ? ((R & ~31) + perm32(R & 31)) : R;
        voffA[i] = (unsigned)(R * K + C) * 2u; voffB[i] = (unsigned)(Rb * K + C) * 2u; }
    const size_t kstep = (size_t)(BK * 2);
    const size_t hstep = (size_t)HALF * K * 2;
    const size_t tstep = 2 * hstep;
    const unsigned ldsw = (unsigned)wid * 1024u;
    const int aoff = lds_byte(wr * 64 + fr, fq * 8), boff = lds_byte(wc * 32 + fr, fq * 8);
#define PG8_SA(b, h) (((b) * 2 + (h)) * HTB)
#define PG8_SB(b, h) ((4 + (b) * 2 + (h)) * HTB)
#define PG8_STAGE(bufoff, gbase, voff) do { _Pragma("unroll") for (int _i = 0; _i < 2; ++_i) \
        __builtin_amdgcn_global_load_lds((const unsigned*)((const char*)(gbase) + (voff)[_i]), (PG8_LAS unsigned*)(lds + (bufoff) + ldsw + _i * 8192), 16, 0, 0); } while (0)
#define PG8_LDA(dst, b, h) do { _Pragma("unroll") for (int m = 0; m < 4; ++m) _Pragma("unroll") for (int k = 0; k < 2; ++k) dst[m][k] = *(const PG8_LAS bf16x8*)(lds + PG8_SA(b, h) + aoff + m * 2048 + k * 1024); } while (0)
#define PG8_LDB(dst, b, h) do { _Pragma("unroll") for (int n = 0; n < 2; ++n) _Pragma("unroll") for (int k = 0; k < 2; ++k) dst[n][k] = *(const PG8_LAS bf16x8*)(lds + PG8_SB(b, h) + boff + n * 2048 + k * 1024); } while (0)
#define PG8_MMA(ai, bj, At, Bt) do { __builtin_amdgcn_s_setprio(1); if constexpr (F8) { _Pragma("unroll") for (int m = 0; m < 4; ++m) _Pragma("unroll") for (int n = 0; n < 2; ++n) \
        asm volatile("v_mfma_scale_f32_16x16x128_f8f6f4 %0, %1, %2, %0, %3, %3 op_sel_hi:[0,0,0]" : "+v"(acc[ai][bj][m][n]) : "v"(cat8(Bt[n][0], Bt[n][1])), "v"(cat8(At[m][0], At[m][1])), "v"(f8scale)); } \
        else { _Pragma("unroll") for (int m = 0; m < 4; ++m) _Pragma("unroll") for (int n = 0; n < 2; ++n) _Pragma("unroll") for (int k = 0; k < 2; ++k) \
        acc[ai][bj][m][n] = __builtin_amdgcn_mfma_f32_16x16x32_bf16(Bt[n][k], At[m][k], acc[ai][bj][m][n], 0, 0, 0); } __builtin_amdgcn_s_setprio(0); } while (0)
#define PG8_WAIT_V(n) asm volatile("s_waitcnt vmcnt(" #n ")" ::: "memory")
#define PG8_WAIT_L(n) asm volatile("s_waitcnt lgkmcnt(" #n ")" ::: "memory")
#define PG8_BAR __builtin_amdgcn_s_barrier()
#define PG8_SCHED __builtin_amdgcn_sched_barrier(0)
    const int f8scale = 0x7f7f7f7f;
    Unit cur, nxt; int ui = 0;
    if (!S.next(0, cur)) return;
    f32x4 acc[2][2][4][2];
#pragma unroll
    for (int a = 0; a < 2; ++a)
#pragma unroll
        for (int b = 0; b < 2; ++b)
#pragma unroll
            for (int m = 0; m < 4; ++m)
#pragma unroll
                for (int n = 0; n < 2; ++n) { acc[a][b][m][n] = (f32x4){0.f, 0.f, 0.f, 0.f}; if constexpr (F8) asm volatile("" : "+v"(acc[a][b][m][n])); }
    bf16x8 At[4][2], B0[2][2], B1[2][2];
    const char* cA = (const char*)g.A + (size_t)cur.pm * tstep; const char* cB = (const char*)g.Bt + (size_t)cur.pn * tstep;
    S.a_ready(cur);
    if constexpr (SP2) {
        PG8_STAGE(PG8_SB(0, 0), cB, voffB); PG8_STAGE(PG8_SB(0, 1), cB + hstep, voffB); PG8_STAGE(PG8_SA(0, 0), cA, voffA); PG8_STAGE(PG8_SA(0, 1), cA + hstep, voffA);
        if (wr == 1) PG8_BAR;
        PG8_WAIT_V(2); PG8_BAR;
        PG8_STAGE(PG8_SB(1, 0), cB + kstep, voffB); PG8_STAGE(PG8_SA(1, 0), cA + kstep, voffA); PG8_STAGE(PG8_SB(1, 1), cB + hstep + kstep, voffB);
        PG8_WAIT_V(6); PG8_BAR;
    } else {
        PG8_STAGE(PG8_SB(0, 0), cB, voffB); PG8_STAGE(PG8_SA(0, 0), cA, voffA); PG8_STAGE(PG8_SB(0, 1), cB + hstep, voffB); PG8_STAGE(PG8_SA(0, 1), cA + hstep, voffA);
        if (wr == 1) PG8_BAR;
        PG8_WAIT_V(4); PG8_BAR;
        PG8_STAGE(PG8_SB(1, 0), cB + kstep, voffB); PG8_STAGE(PG8_SA(1, 0), cA + kstep, voffA); PG8_STAGE(PG8_SB(1, 1), cB + hstep + kstep, voffB);
        PG8_WAIT_V(6); PG8_BAR;
    }
    for (;;) {
        const bool has_next = S.next(ui + 1, nxt);
        const char* nA = has_next ? (const char*)g.A + (size_t)nxt.pm * tstep : cA; const char* nB = has_next ? (const char*)g.Bt + (size_t)nxt.pn * tstep : cB;
        int t = 0;
#pragma unroll 1
        do {
            const bool last = (t == nt - 2);
            const char* a1 = cA + (size_t)(t + 1) * kstep;
            const char* a2 = last ? nA : cA + (size_t)(t + 2) * kstep; const char* b2 = last ? nB : cB + (size_t)(t + 2) * kstep;
            const char* a3 = a2 + kstep; const char* b3 = b2 + kstep;
            if (last && has_next) S.a_ready(nxt);
            if constexpr (SP2) {
            PG8_LDB(B0, 0, 0); PG8_LDB(B1, 0, 1); PG8_SCHED; PG8_LDA(At, 0, 0); PG8_STAGE(PG8_SA(1, 1), a1 + hstep, voffA);
            PG8_WAIT_V(8); PG8_WAIT_L(0); PG8_BAR; PG8_MMA(0, 0, At, B0); PG8_MMA(0, 1, At, B1); PG8_BAR; PG8_SCHED;
            PG8_LDA(At, 0, 1); PG8_STAGE(PG8_SB(0, 0), b2, voffB); PG8_STAGE(PG8_SB(0, 1), b2 + hstep, voffB); PG8_STAGE(PG8_SA(0, 0), a2, voffA);
            PG8_WAIT_V(8); PG8_WAIT_L(0); PG8_BAR; PG8_MMA(1, 0, At, B0); PG8_MMA(1, 1, At, B1); PG8_BAR; PG8_SCHED;
            PG8_LDB(B0, 1, 0); PG8_LDB(B1, 1, 1); PG8_SCHED; PG8_LDA(At, 1, 0); PG8_STAGE(PG8_SA(0, 1), a2 + hstep, voffA);
            PG8_WAIT_V(8); PG8_WAIT_L(0); PG8_BAR; PG8_MMA(0, 0, At, B0); PG8_MMA(0, 1, At, B1); PG8_BAR; PG8_SCHED;
            PG8_LDA(At, 1, 1); PG8_STAGE(PG8_SB(1, 0), b3, voffB); PG8_STAGE(PG8_SB(1, 1), b3 + hstep, voffB); PG8_STAGE(PG8_SA(1, 0), a3, voffA);
            PG8_WAIT_V(8); PG8_WAIT_L(0); PG8_BAR; PG8_MMA(1, 0, At, B0); PG8_MMA(1, 1, At, B1); PG8_BAR; PG8_SCHED;
            } else {
            PG8_LDB(B0, 0, 0); PG8_SCHED; PG8_LDA(At, 0, 0); PG8_STAGE(PG8_SA(1, 1), a1 + hstep, voffA);
            PG8_WAIT_L(8); PG8_BAR; PG8_WAIT_L(0); PG8_MMA(0, 0, At, B0); PG8_BAR; PG8_SCHED;
            PG8_LDB(B1, 0, 1); PG8_STAGE(PG8_SB(0, 0), b2, voffB);
            PG8_BAR; PG8_WAIT_L(0); PG8_MMA(0, 1, At, B1); PG8_BAR;
            PG8_LDA(At, 0, 1); PG8_STAGE(PG8_SA(0, 0), a2, voffA);
            PG8_BAR; PG8_WAIT_L(0); PG8_MMA(1, 0, At, B0); PG8_BAR; PG8_SCHED;
            PG8_STAGE(PG8_SB(0, 1), b2 + hstep, voffB);
            PG8_WAIT_V(6); PG8_BAR; PG8_MMA(1, 1, At, B1); PG8_BAR;
            PG8_LDB(B0, 1, 0); PG8_SCHED; PG8_LDA(At, 1, 0); PG8_STAGE(PG8_SA(0, 1), a2 + hstep, voffA);
            PG8_WAIT_L(8); PG8_BAR; PG8_WAIT_L(0); PG8_MMA(0, 0, At, B0); PG8_BAR; PG8_SCHED;
            PG8_LDB(B1, 1, 1); PG8_STAGE(PG8_SB(1, 0), b3, voffB);
            PG8_BAR; PG8_WAIT_L(0); PG8_MMA(0, 1, At, B1); PG8_BAR;
            PG8_LDA(At, 1, 1); PG8_STAGE(PG8_SA(1, 0), a3, voffA);
            PG8_BAR; PG8_WAIT_L(0); PG8_MMA(1, 0, At, B0); PG8_BAR; PG8_SCHED;
            PG8_STAGE(PG8_SB(1, 1), b3 + hstep, voffB);
            PG8_WAIT_V(6); PG8_BAR; PG8_MMA(1, 1, At, B1); PG8_BAR;
            }
            t += 2;
        } while (t < nt);
        if constexpr (ALIGN_EPI) { if (wr == 0) PG8_BAR; }
        if constexpr (F8) asm volatile("s_nop 15\n\ts_nop 15" ::: "memory");
        if constexpr (!Epi::AFTER_DRAIN) { E(acc, cur, wr, wc, fr, fq); S.done(cur); }
        if (!has_next) break;
#pragma unroll
        for (int a = 0; a < 2; ++a)
#pragma unroll
            for (int b = 0; b < 2; ++b)
#pragma unroll
                for (int m = 0; m < 4; ++m)
#pragma unroll
                    for (int n = 0; n < 2; ++n) { acc[a][b][m][n] = (f32x4){0.f, 0.f, 0.f, 0.f}; if constexpr (F8) asm volatile("" : "+v"(acc[a][b][m][n])); }
        cur = nxt; cA = nA; cB = nB; ++ui;
        if constexpr (ALIGN_EPI) { if (wr == 1) PG8_BAR; }
    }
    PG8_WAIT_V(0);
    if constexpr (!ALIGN_EPI) { if (wr == 0) PG8_BAR; }
    PG8_BAR;
    if constexpr (Epi::AFTER_DRAIN) { E.fused(acc, cur, wr, wc, fr, fq, lds, wid, lane); S.done(cur); }
#undef PG8_SA
#undef PG8_SB
#undef PG8_STAGE
#undef PG8_LDA
#undef PG8_LDB
#undef PG8_MMA
#undef PG8_WAIT_V
#undef PG8_WAIT_L
#undef PG8_BAR
#undef PG8_SCHED
}
}

#define GAS __attribute__((address_space(1)))
#define LAS __attribute__((address_space(3)))
typedef unsigned short bf16;
typedef unsigned u32x4 __attribute__((ext_vector_type(4)));
typedef unsigned u32x2 __attribute__((ext_vector_type(2)));
typedef float f32x4 __attribute__((ext_vector_type(4)));
typedef float f32x16 __attribute__((ext_vector_type(16)));
typedef short bf16x8 __attribute__((ext_vector_type(8)));
typedef GAS unsigned gu32;
#define RLX_AGENT __ATOMIC_RELAXED, __HIP_MEMORY_SCOPE_AGENT

#ifndef DBG
#define DBG 0
#endif
#ifndef N_LAUNCH_SPLIT
#define N_LAUNCH_SPLIT 0
#endif

constexpr int NB = 16, SL = 2048, T = NB * SL, D = 1024, ML = 256, MT = NB * ML;
constexpr int FF = 2816, FE = 3584, NE = 8, RMAXT = 264;
constexpr float EPS = 1e-6f, LOG2E = 1.4426950408889634f, INV_2PI = 0.15915494309189535f;
constexpr int NWAVES = 8, NTHR = 512;

constexpr size_t MiB = 1u << 20;
constexpr size_t WS_CTL = 0, CTL_BYTES = 1 * MiB;
constexpr size_t WS_WQ = 1 * MiB;
constexpr size_t WS_WO = WS_WQ + 8 * MiB;
constexpr size_t WS_WK = WS_WO + 8 * MiB;
constexpr size_t WS_WV = WS_WK + 8 * MiB;
constexpr size_t WS_EV = WS_WV + 8 * MiB;
constexpr size_t EV_STRIDE = 27 * MiB, EV_INN = 0, EV_INS = 6 * MiB, EV_OUT = 8 * MiB, EV_GU = 10 * MiB, EV_DN = 21 * MiB;
constexpr size_t WS_OD = WS_EV + 2 * EV_STRIDE;
constexpr size_t OD_STRIDE = 8 * MiB, OD_INN = 0, OD_INS = 4 * MiB, OD_OUT = 6 * MiB;
constexpr size_t WS_MOE = WS_OD + 2 * OD_STRIDE;
constexpr size_t MOE_STRIDE = 84 * MiB, MOE_DN = 56 * MiB;
constexpr float MOE_WSCALE = 64.f, MOE_HSCALE = 4.f;
constexpr size_t WS_XB = WS_MOE + 168 * MiB;
constexpr size_t WS_SSQ = WS_XB + 64 * MiB;
constexpr size_t WS_MEMN = WS_SSQ + 2 * MiB;
constexpr size_t WS_KX = WS_MEMN + 8 * MiB;
constexpr size_t WS_VTX = WS_KX + 32 * MiB;
constexpr size_t WS_MISC = WS_VTX + 32 * MiB;
constexpr size_t MISC_LIST = 0, MISC_YROW = 1 * MiB, MISC_GATE = MISC_YROW + 256 * 1024, MISC_EPOS = MISC_GATE + 256 * 1024, MISC_RSS = MISC_EPOS + 256 * 1024;
constexpr size_t WS_ACT = WS_MISC + 3 * MiB;
constexpr size_t A_PE = 0, A_VTE = 256 * MiB, A_R = 352 * MiB;
constexpr int PEW = 4096;
constexpr size_t A_QK = 0, A_VTD = 128 * MiB, A_AO = 192 * MiB;
constexpr int QKP = 2048, VTP = T;
constexpr size_t A_QX = 0, A_OX = 64 * MiB;
constexpr size_t A_H = 0, A_XB8 = 432 * MiB;
constexpr size_t A_XS = 0, A_HID = 66 * MiB, A_Y = 297 * MiB;
constexpr size_t ACT_BYTES = 495 * MiB, WS_END = WS_ACT + ACT_BYTES;
constexpr int CW_TMO = 0, CW_BAR = 4096, CW_CNT = 8192  , CW_CHK = 16384  , CHK_NSTAGE = 96;
constexpr int PH_BYTES = 135168, LDSCTL_OFF = PH_BYTES, LDS_BYTES = PH_BYTES + 1024;

__device__ __forceinline__ float bf2f(bf16 b) { return __builtin_bit_cast(float, (unsigned)b << 16); }
__device__ __forceinline__ unsigned f2bf(float f) { unsigned u = __builtin_bit_cast(unsigned, f); return (u + 0x7fffu + ((u >> 16) & 1u)) >> 16; }
__device__ __forceinline__ unsigned pk2(float lo, float hi) { return f2bf(lo) | (f2bf(hi) << 16); }
__device__ __forceinline__ int crow(int r, int hi) { return (r & 3) + 8 * (r >> 2) + 4 * hi; }
#define LDS_WAIT() asm volatile("s_waitcnt lgkmcnt(0)" ::: "memory")
#define VM_WAIT() asm volatile("s_waitcnt vmcnt(0)" ::: "memory")
__device__ __forceinline__ float wave_sum(float v) {
#pragma unroll
    for (int o = 1; o < 64; o <<= 1) v += __shfl_xor(v, o);
    return v;
}
__device__ __forceinline__ float wave_max(float v) {
#pragma unroll
    for (int o = 1; o < 64; o <<= 1) v = fmaxf(v, __shfl_xor(v, o));
    return v;
}
#define MFMA32(a, b, c) __builtin_amdgcn_mfma_f32_32x32x16_bf16((a), (b), (c), 0, 0, 0)
__device__ __forceinline__ bf16x8 pack_frag(float a0, float a1, float a2, float a3, float a4, float a5, float a6, float a7) {
    u32x4 w; w.x = pg8::cvt_pk_bf16(a0, a1); w.y = pg8::cvt_pk_bf16(a2, a3); w.z = pg8::cvt_pk_bf16(a4, a5); w.w = pg8::cvt_pk_bf16(a6, a7); return __builtin_bit_cast(bf16x8, w);
}
__device__ __forceinline__ bf16x8 join8(u32x2 lo, u32x2 hi) { u32x4 w; w.x = lo.x; w.y = lo.y; w.z = hi.x; w.w = hi.y; return __builtin_bit_cast(bf16x8, w); }

struct Args {
    const float* x; const float* mem; const int* pos; const float* mem_g; const float* fin_g; const float* mix_g; const float* xa_g; const float* ffn_g;
    const float* xa_wq; const float* xa_wkv; const float* xa_wo; const float* ev_w_in; const float* ev_conv; const float* ev_df; const float* ev_db; const float* ev_gn;
    const float* ev_w_out; const float* ffd_g; const float* ffd_u; const float* ffd_d; const float* od_w_in; const float* lq1; const float* lk1; const float* lq2; const float* lk2;
    const float* od_gn; const float* od_w_out; const float* router; const float* moe_g; const float* moe_u; const float* moe_d;
    float* out; unsigned char* ws; int ph_lo, ph_hi;
};
struct Frame {
    LAS unsigned char* lds; gu32* ctl; unsigned char* ws; int tid, lane, wave, G, bid;
};
#define XB_TMO      128
#define XB_XCNT(j)  (256  + 64 * (j))
#define XB_XSUB(j)  (1280 + 64 * (j))
#define XB_XGEN(j)  (2304 + 64 * (j))
#define XB_TOP      3328
#define XB_TOPGEN   3392
#define XCD_BAR_WORDS 3456
#define XB_SPIN_CAP (1u << 18)

__device__ __forceinline__ unsigned xb_ld(unsigned* p)              { return __hip_atomic_load(p, __ATOMIC_RELAXED, __HIP_MEMORY_SCOPE_AGENT); }
__device__ __forceinline__ unsigned xb_add(unsigned* p, unsigned v) { return __hip_atomic_fetch_add(p, v, __ATOMIC_RELAXED, __HIP_MEMORY_SCOPE_AGENT); }
__device__ __forceinline__ unsigned xb_xcc_id() { return (unsigned)__builtin_amdgcn_s_getreg((3 << 11) | 20) & 0xFu; }
#define XB_SPIN(cond, bar) do { unsigned _sp = 0; while (cond) { __builtin_amdgcn_s_sleep(1); \
    if ((++_sp & 255u) == 0u) { if (xb_ld(&(bar)[XB_TMO])) break; if (_sp > XB_SPIN_CAP) { atomicAdd(&(bar)[XB_TMO], 1u); break; } } } } while (0)

struct XcdBarrier {
    unsigned* bar; unsigned x;
    bool t0;
    volatile LAS unsigned* st;
};

__device__ __forceinline__ XcdBarrier xcd_barrier_post(unsigned* bar, volatile LAS unsigned* st) {
    XcdBarrier b; b.bar = bar; b.x = xb_xcc_id(); b.st = st; b.t0 = (threadIdx.x == 0);
    if (threadIdx.x == 0) (void)xb_add(&bar[XB_XCNT(b.x)], 1u);
    return b;
}
__device__ __forceinline__ void xcd_barrier_complete(unsigned* bar, unsigned x, unsigned& nloc, unsigned& nx) {
    const unsigned G = gridDim.x * gridDim.y * gridDim.z;
    unsigned sum, cnt, mine, sp = 0u;
    for (;;) {
        sum = 0u; cnt = 0u; mine = 0u;
#pragma unroll
        for (unsigned j = 0; j < 16; ++j) { const unsigned c = xb_ld(&bar[XB_XCNT(j)]); sum += c; cnt += (c > 0u) ? 1u : 0u; mine = (j == x) ? c : mine; }
        if (sum == G) break;
        __builtin_amdgcn_s_sleep(1);
        if ((++sp & 255u) == 0u) { if (xb_ld(&bar[XB_TMO])) break; if (sp > XB_SPIN_CAP) { atomicAdd(&bar[XB_TMO], 1u); break; } }
    }
    nloc = mine > 0u ? mine : 1u; nx = cnt > 0u ? cnt : 1u;
}

__device__ __forceinline__ void xcd_barrier(const XcdBarrier& b) {
    asm volatile("s_waitcnt vmcnt(0)" ::: "memory");
    __syncthreads();
    if (b.t0) {
        unsigned* bar = b.bar;
        __builtin_amdgcn_s_waitcnt(0);
        unsigned nloc = b.st[0], nx = b.st[1];
        if (nloc == 0u) { xcd_barrier_complete(bar, b.x, nloc, nx); b.st[0] = nloc; b.st[1] = nx; }
        const unsigned old = xb_add(&bar[XB_XSUB(b.x)], 1u);
        const unsigned gen = old / nloc;
        if (old + 1u == (gen + 1u) * nloc) {
            __builtin_amdgcn_fence(__ATOMIC_RELEASE, "agent");
            asm volatile("s_waitcnt vmcnt(0)" ::: "memory");
            const unsigned og = xb_add(&bar[XB_TOP], 1u);
            const unsigned tg = og / nx;
            if (og + 1u == (tg + 1u) * nx) xb_add(&bar[XB_TOPGEN], 1u);
            else XB_SPIN(xb_ld(&bar[XB_TOPGEN]) == tg, bar);
            __builtin_amdgcn_fence(__ATOMIC_ACQUIRE, "agent");
            xb_add(&bar[XB_XGEN(b.x)], 1u);
            asm volatile("s_waitcnt vmcnt(0)" ::: "memory");
        } else {
            XB_SPIN(xb_ld(&bar[XB_XGEN(b.x)]) == gen, bar);
            __builtin_amdgcn_fence(__ATOMIC_ACQUIRE, "agent");
            asm volatile("s_waitcnt vmcnt(0)" ::: "memory");
        }
    }
    __syncthreads();
}

template <bool F8W = false> __device__ __forceinline__ void tr_item(const float* W0, const float* W1, int ldw, int K, int cm, int coff, const float* gk, bf16* WT, int item, int nblk, LAS float* scr, int lane, float wsc = 1.f) {
    const int kb = item / nblk, nb = item % nblk, k0 = 64 * kb, n0 = 64 * nb;
    const int np = n0 + 4 * (lane & 15);
    const float* W = W0; int sc;
    if (cm == 0) sc = np + coff;
    else if (cm == 1) { if (np < 1536) sc = np; else if (np < 2560) { const int c = np & 63, g = c >> 3, s = c & 7; sc = (np & ~63) + ((s < 4) ? 4 * g + s : 32 + 4 * g + (s - 4)); } else sc = np + 512; }
    else if (cm == 2) { const int c = np & 63; if (c < 16) { const int g = c >> 3, s = c & 7; sc = (np & ~63) + ((s < 4) ? 4 * g + s : 8 + 4 * g + (s - 4)); } else sc = np; }
    else { const int t = np >> 8, r = np & 255; if (r < 128) sc = 128 * t + r; else { sc = 128 * t + r - 128; W = W1; } }
#pragma unroll 4
    for (int i = 0; i < 16; ++i) { const int kk = 4 * i + (lane >> 4); const f32x4 v = *(const f32x4*)(W + (size_t)(k0 + kk) * ldw + sc); const float g = (gk ? gk[k0 + kk] : 1.f) * wsc;
        LAS float* d = scr + kk * 65 + 4 * (lane & 15); d[0] = v[0] * g; d[1] = v[1] * g; d[2] = v[2] * g; d[3] = v[3] * g; }
    LDS_WAIT(); asm volatile("" ::: "memory");
    const int c = lane & 7;
#pragma unroll
    for (int j = 0; j < 8; ++j) { const int n = (lane >> 3) + 8 * j; const LAS float* s = scr + (8 * c) * 65 + n;
        if constexpr (F8W) { u32x2 o; o.x = pg8::pack_fp8x4(s[0 * 65], s[1 * 65], s[2 * 65], s[3 * 65]); o.y = pg8::pack_fp8x4(s[4 * 65], s[5 * 65], s[6 * 65], s[7 * 65]);
            *(u32x2*)((unsigned char*)WT + (size_t)(n0 + n) * K + k0 + 8 * c) = o; }
        else { u32x4 o; o.x = pk2(s[0 * 65], s[1 * 65]); o.y = pk2(s[2 * 65], s[3 * 65]); o.z = pk2(s[4 * 65], s[5 * 65]); o.w = pk2(s[6 * 65], s[7 * 65]);
            *(u32x4*)(WT + (size_t)(n0 + n) * K + k0 + 8 * c) = o; } }
    LDS_WAIT(); asm volatile("" ::: "memory");
}
#define TRMAT(W0_, W1_, ldw_, K_, N_, cm_, coff_, gk_, WT_) do { const int nblk_ = (N_) / 64, ni_ = ((K_) / 64) * nblk_; \
    for (int it_ = (int)(((long)gw - ib + (long)NGW * 1024) % NGW); it_ < ni_; it_ += NGW) tr_item((W0_), (W1_), (ldw_), (K_), (cm_), (coff_), (gk_), (WT_), it_, nblk_, scr, F.lane); \
    ib = (ib + ni_) % NGW; } while (0)
#define TRMAT8(W0_, W1_, ldw_, K_, N_, cm_, coff_, gk_, WT_) do { const int nblk_ = (N_) / 64, ni_ = ((K_) / 64) * nblk_; \
    for (int it_ = (int)(((long)gw - ib + (long)NGW * 1024) % NGW); it_ < ni_; it_ += NGW) tr_item<true>((W0_), (W1_), (ldw_), (K_), (cm_), (coff_), (gk_), (bf16*)(WT_), it_, nblk_, scr, F.lane, MOE_WSCALE); \
    ib = (ib + ni_) % NGW; } while (0)

__device__ __forceinline__ void moe_convert(Frame& F, const Args& A, int j) {
    LAS float* scr = (LAS float*)(F.lds) + F.wave * (64 * 65);
    const int gw = F.bid * NWAVES + F.wave, NGW = F.G * NWAVES; long ib = 0;
    unsigned char* gu = F.ws + WS_MOE + (size_t)j * MOE_STRIDE; unsigned char* dn = gu + MOE_DN;
    for (int e = 0; e < NE; ++e) {
        const size_t wo = ((size_t)j * NE + e) * (size_t)D * FE;
        TRMAT8(A.moe_g + wo, A.moe_u + wo, FE, D, 2 * FE, 3, 0, A.ffn_g + (2 * j + 1) * D, gu + (size_t)e * 2 * FE * D);
        TRMAT8(A.moe_d + wo, nullptr, D, FE, D, 0, 0, nullptr, dn + (size_t)e * D * FE);
    }
}

__device__ __forceinline__ void prologue_phase(Frame& F, const Args& A) {
    LAS float* scr = (LAS float*)(F.lds) + F.wave * (64 * 65);
    const int gw = F.bid * NWAVES + F.wave, NGW = F.G * NWAVES; long ib = 0;
    { const bool h5 = (F.lane & 32) != 0, h4 = (F.lane & 16) != 0;
      for (int m0 = 4 * gw; m0 < T; m0 += 4 * NGW) {
        f32x4 v[4][4]; float sq[4];
#pragma unroll
        for (int s = 0; s < 4; ++s) { const f32x4* xr = (const f32x4*)(A.x + (size_t)(m0 + s) * D) + F.lane;
#pragma unroll
            for (int q = 0; q < 4; ++q) v[s][q] = xr[64 * q]; }
#pragma unroll
        for (int s = 0; s < 4; ++s) { sq[s] = 0.f;
#pragma unroll
            for (int q = 0; q < 4; ++q) {
#pragma unroll
                for (int e = 0; e < 4; ++e) v[s][q][e] = bf2f((bf16)f2bf(v[s][q][e]));
                sq[s] += (v[s][q][0] * v[s][q][0] + v[s][q][1] * v[s][q][1]) + (v[s][q][2] * v[s][q][2] + v[s][q][3] * v[s][q][3]); } }
        const float t0 = (h5 ? sq[2] : sq[0]) + __shfl_xor(h5 ? sq[0] : sq[2], 32), t1 = (h5 ? sq[3] : sq[1]) + __shfl_xor(h5 ? sq[1] : sq[3], 32);
        float tt = (h4 ? t1 : t0) + __shfl_xor(h4 ? t0 : t1, 16);
        tt += __shfl_xor(tt, 8); tt += __shfl_xor(tt, 4); tt += __shfl_xor(tt, 2); tt += __shfl_xor(tt, 1);
#pragma unroll
        for (int s = 0; s < 4; ++s) { const int m = m0 + s; const float ssum = __builtin_bit_cast(float, __builtin_amdgcn_readlane(__builtin_bit_cast(int, tt), 16 * s));
            u32x2* brow = (u32x2*)((bf16*)(F.ws + WS_XB) + (size_t)m * D) + F.lane;
#pragma unroll
            for (int q = 0; q < 4; ++q) { u32x2 w; w.x = pk2(v[s][q][0], v[s][q][1]); w.y = pk2(v[s][q][2], v[s][q][3]); brow[64 * q] = w; }
            if (F.lane < 16) ((float*)(F.ws + WS_SSQ))[(size_t)m * 16 + F.lane] = (F.lane == 0) ? ssum : 0.f; }
      } }
    for (int m = gw; m < MT; m += NGW) {
        const f32x4* xr = (const f32x4*)(A.mem + (size_t)m * D) + F.lane; const f32x4* gr = (const f32x4*)A.mem_g + F.lane; f32x4 v[4]; float s = 0.f;
#pragma unroll
        for (int q = 0; q < 4; ++q) { v[q] = xr[64 * q]; s += (v[q][0] * v[q][0] + v[q][1] * v[q][1]) + (v[q][2] * v[q][2] + v[q][3] * v[q][3]); }
        const float rs = rsqrtf(wave_sum(s) * (1.f / D) + EPS);
        u32x2* brow = (u32x2*)((bf16*)(F.ws + WS_MEMN) + (size_t)m * D) + F.lane;
#pragma unroll
        for (int q = 0; q < 4; ++q) { const f32x4 g = gr[64 * q]; u32x2 w; w.x = pk2(v[q][0] * rs * g[0], v[q][1] * rs * g[1]); w.y = pk2(v[q][2] * rs * g[2], v[q][3] * rs * g[3]); brow[64 * q] = w; }
    }
    for (int l = 0; l < 4; ++l) {
        TRMAT8(A.xa_wq + (size_t)l * D * D, nullptr, D, D, D, 0, 0, A.xa_g + l * D, F.ws + WS_WQ + (size_t)l * D * D);
        TRMAT8(A.xa_wo + (size_t)l * D * D, nullptr, D, D, D, 0, 0, nullptr, F.ws + WS_WO + (size_t)l * D * D);
        TRMAT(A.xa_wkv + (size_t)l * D * 2 * D, nullptr, 2 * D, D, D, 0, 0, nullptr, (bf16*)(F.ws + WS_WK) + (size_t)l * D * D);
        TRMAT(A.xa_wkv + (size_t)l * D * 2 * D, nullptr, 2 * D, D, D, 0, D, nullptr, (bf16*)(F.ws + WS_WV) + (size_t)l * D * D);
    }
    for (int j = 0; j < 2; ++j) {
        unsigned char* eb = F.ws + WS_EV + j * EV_STRIDE; const float* win = A.ev_w_in + (size_t)j * D * 3584;
        TRMAT(win, nullptr, 3584, D, 3072, 1, 0, A.mix_g + (2 * j) * D, (bf16*)(eb + EV_INN));
        TRMAT(win, nullptr, 3584, D, 512, 0, 2560, A.mix_g + (2 * j) * D, (bf16*)(eb + EV_INS));
        TRMAT(A.ev_w_out + (size_t)j * D * D, nullptr, D, D, D, 0, 0, nullptr, (bf16*)(eb + EV_OUT));
        TRMAT8(A.ffd_g + (size_t)j * D * FF, A.ffd_u + (size_t)j * D * FF, FF, D, 2 * FF, 3, 0, A.ffn_g + (2 * j) * D, eb + EV_GU);
        TRMAT8(A.ffd_d + (size_t)j * FF * D, nullptr, D, FF, D, 0, 0, nullptr, eb + EV_DN);
        unsigned char* ob = F.ws + WS_OD + j * OD_STRIDE; const float* oin = A.od_w_in + (size_t)j * D * 3072;
        TRMAT(oin, nullptr, 3072, D, 2048, 2, 0, A.mix_g + (2 * j + 1) * D, (bf16*)(ob + OD_INN));
        TRMAT(oin, nullptr, 3072, D, 1024, 0, 2048, A.mix_g + (2 * j + 1) * D, (bf16*)(ob + OD_INS));
        TRMAT(A.od_w_out + (size_t)j * D * D, nullptr, D, D, D, 0, 0, nullptr, (bf16*)(ob + OD_OUT));
    }
}

__device__ __forceinline__ void fret_phase(Frame& F, const Args& A, int j) {
    const bf16* PE = (const bf16*)(F.ws + WS_ACT + A_PE); bf16* R = (bf16*)(F.ws + WS_ACT + A_R); const bf16* VT = (const bf16*)(F.ws + WS_ACT + A_VTE);
    { const float* cw = A.ev_conv + (size_t)j * 3 * 512;
      const int c0 = (F.tid & 63) * 8;
      float cwv[3][8];
#pragma unroll
      for (int d = 0; d < 3; ++d) { const f32x4 a = *(const f32x4*)(cw + d * 512 + c0), bq = *(const f32x4*)(cw + d * 512 + c0 + 4);
#pragma unroll
          for (int e = 0; e < 4; ++e) { cwv[d][e] = a[e]; cwv[d][4 + e] = bq[e]; } }
      const int tstr = (F.G * NTHR) >> 6;
      for (int t0 = (F.bid * NTHR + F.tid) >> 6; t0 < T; t0 += 4 * tstr) {
        bf16x8 gcv[4][3], hcv[4][3], gbv[4];
#pragma unroll
        for (int s = 0; s < 4; ++s) { const int t = t0 + s * tstr; const bool tv = t < T; const int l = t & (SL - 1); const bf16* row = PE + (size_t)(tv ? t : 0) * PEW;
#pragma unroll
            for (int d = 0; d < 3; ++d) { const bool ok = tv && ((d == 0) ? (l > 0) : (d == 2) ? (l < SL - 1) : true); const bf16* rr = row + (ok ? (d - 1) * PEW : 0);
                gcv[s][d] = *(const bf16x8*)(rr + 512 + c0); hcv[s][d] = *(const bf16x8*)(rr + 1024 + c0); }
            gbv[s] = *(const bf16x8*)(row + c0); }
#pragma unroll
        for (int s = 0; s < 4; ++s) { const int t = t0 + s * tstr; if (t < T) { const int l = t & (SL - 1); float o[8];
#pragma unroll
            for (int e = 0; e < 8; ++e) { float acc = cwv[1][e] * (bf2f((bf16)gcv[s][1][e]) * bf2f((bf16)hcv[s][1][e]));
                if (l > 0) acc += cwv[0][e] * (bf2f((bf16)gcv[s][0][e]) * bf2f((bf16)hcv[s][0][e]));
                if (l < SL - 1) acc += cwv[2][e] * (bf2f((bf16)gcv[s][2][e]) * bf2f((bf16)hcv[s][2][e]));
                o[e] = bf2f((bf16)gbv[s][e]) * acc; }
            u32x4 wq; wq.x = pk2(o[0], o[1]); wq.y = pk2(o[2], o[3]); wq.z = pk2(o[4], o[5]); wq.w = pk2(o[6], o[7]);
            *(u32x4*)(R + (size_t)t * 1024 + c0) = wq; } } } }
    const int w = F.wave, lane = F.lane, r = lane & 31, hh = lane >> 5, tid = F.tid;
    LAS unsigned char* lds = F.lds;
    const float* gng = A.ev_gn + j * 512;
    const int srow = tid >> 3, sch = tid & 7;
    const int kfo = r * 144 + 16 * hh;
    const int vfo = 36864 + r * 144 + 16 * hh;
    const int sto = srow * 144 + sch * 16;
    const int stv = 36864 + srow * 144 + (sch >> 1) * 32 + (sch & 1) * 8;
    LAS float* gnl = (LAS float*)(lds + 57344);
    if (tid < 128) *(LAS f32x4*)(gnl + 4 * tid) = *(const f32x4*)(gng + 4 * tid);
    const unsigned kof = (unsigned)(srow * PEW + sch * 8) * 2u, vof = (unsigned)(srow * T + sch * 8) * 2u;
    int u = F.bid; if (u >= 1024) { __syncthreads(); return; }
    int b = u >> 6, h = (u >> 3) & 7, qt = u & 7; size_t tok0 = (size_t)b * SL + 256 * qt, kb = (size_t)b * SL;
    bf16x8 qff[4], qfb[4]; u32x4 rk0, rk1, rv0, rk2, rk3, rv1;
    const char* kbase = (const char*)(PE + kb * PEW + 2048 + h * 64); const char* vbase = (const char*)(VT + (size_t)(h * 64) * T + kb);
    { const bf16* qp = PE + (tok0 + 32 * w + r) * PEW + h * 64 + 8 * hh;
#pragma unroll
      for (int s = 0; s < 4; ++s) { qff[s] = *(const bf16x8*)(qp + 1536 + 16 * s); qfb[s] = *(const bf16x8*)(qp + 3072 + 16 * s); }
      rk0 = *(const u32x4*)(kbase + kof); rk1 = *(const u32x4*)(kbase + kof + 3072); rv0 = *(const u32x4*)(vbase + vof);
      rk2 = *(const u32x4*)(kbase + (size_t)(64 * PEW * 2) + kof); rk3 = *(const u32x4*)(kbase + (size_t)(64 * PEW * 2) + kof + 3072); rv1 = *(const u32x4*)(vbase + 128 + vof); }
    for (;;) {
        const float lgf = __builtin_bit_cast(float, __builtin_amdgcn_readfirstlane(__builtin_bit_cast(int, -__expf(A.ev_df[j * 8 + h]) * LOG2E))), lgb = __builtin_bit_cast(float, __builtin_amdgcn_readfirstlane(__builtin_bit_cast(int, -__expf(A.ev_db[j * 8 + h]) * LOG2E)));
        const int nw0 = 256 * qt + 32 * w, tmix = nw0 >> 6;
#define FR_LDK(t) do { const char* kt_ = kbase + (size_t)(t) * (64 * PEW * 2); rk0 = *(const u32x4*)(kt_ + kof); rk1 = *(const u32x4*)(kt_ + kof + 3072); } while (0)
#define FR_LDV(t) do { rv0 = *(const u32x4*)(vbase + (size_t)(t) * 128 + vof); } while (0)
#define FR_STK(bf) do { *(LAS u32x4*)(lds + (bf) * 18432 + sto) = rk0; *(LAS u32x4*)(lds + (bf) * 18432 + 9216 + sto) = rk1; } while (0)
#define FR_STV(bf) do { LAS unsigned char* vd_ = lds + (bf) * 9216 + stv; *(LAS u32x2*)(vd_) = (u32x2){rv0.x, rv0.y}; *(LAS u32x2*)(vd_ + 16) = (u32x2){rv0.z, rv0.w}; } while (0)
#define FR_KF(kbn, cb, kt2, s) (*(const LAS bf16x8*)(lds + (kbn) * 18432 + (cb) * 9216 + kfo + (kt2) * 4608 + 32 * (s)))
#define FR_VF(vbc, dvt, k2, s2) (*(const LAS bf16x8*)(lds + (vbc) * 9216 + vfo + 4608 * (dvt) + 64 * (k2) + 32 * (s2)))
#define FR_QKH(N, NC, tt, kbn, kt2) do { const int m0_ = 64 * (tt); N = zero16; \
        if ((tt) < tmix) { _Pragma("unroll") for (int s = 0; s < 4; ++s) N = MFMA32(FR_KF(kbn, 0, kt2, s), qff[s], N); NC = __builtin_amdgcn_exp2f(lgf * (float)(nw0 - m0_)); } \
        else if ((tt) > tmix) { _Pragma("unroll") for (int s = 0; s < 4; ++s) N = MFMA32(FR_KF(kbn, 1, kt2, s), qfb[s], N); NC = __builtin_amdgcn_exp2f(lgb * (float)(m0_ - nw0)); } \
        else { f32x16 b_ = zero16; \
            _Pragma("unroll") for (int s = 0; s < 4; ++s) { N = MFMA32(FR_KF(kbn, 0, kt2, s), qff[s], N); b_ = MFMA32(FR_KF(kbn, 1, kt2, s), qfb[s], b_); } \
            const float cf_ = __builtin_amdgcn_exp2f(lgf * (float)(nw0 - m0_)), cb_ = __builtin_amdgcn_exp2f(lgb * (float)(m0_ - nw0)); const int n_ = nw0 + r; \
            _Pragma("unroll") for (int q = 0; q < 16; ++q) { const int m_ = m0_ + 32 * (kt2) + crow(q, hh); N[q] = (m_ <= n_) ? N[q] * cf_ : b_[q] * cb_; } \
            NC = 1.f; } } while (0)
#define FR_PACK(P, B, c) pack_frag(P[B] * (c), P[B + 1] * (c), P[B + 2] * (c), P[B + 3] * (c), P[B + 4] * (c), P[B + 5] * (c), P[B + 6] * (c), P[B + 7] * (c))
        FR_STK(0); FR_STV(0); rk0 = rk2; rk1 = rk3; rv0 = rv1;
        __syncthreads();
        const f32x16 zero16 = {};
        f32x16 o[2] = {{}, {}};
#pragma unroll 1
        for (int t = 0; t < 32; ++t) { const int bc = t & 1;
            if (t + 1 < 32) { FR_STK(bc ^ 1); FR_STV(bc ^ 1); }
            if (t + 2 < 32) { FR_LDK(t + 2); FR_LDV(t + 2); }
            f32x16 s0_, s1_; float c0_, c1_;
            if (__builtin_expect(t != tmix, 1)) { const bool below_ = t < tmix; const int cbo_ = below_ ? 0 : 9216; s0_ = zero16; s1_ = zero16;
#pragma unroll
                for (int s = 0; s < 4; ++s) { const bf16x8 qs_ = below_ ? qff[s] : qfb[s];
                    s0_ = MFMA32(*(const LAS bf16x8*)(lds + bc * 18432 + cbo_ + kfo + 32 * s), qs_, s0_); s1_ = MFMA32(*(const LAS bf16x8*)(lds + bc * 18432 + cbo_ + kfo + 4608 + 32 * s), qs_, s1_); }
                c0_ = below_ ? __builtin_amdgcn_exp2f(lgf * (float)(nw0 - 64 * t)) : __builtin_amdgcn_exp2f(lgb * (float)(64 * t - nw0)); c1_ = c0_; }
            else { FR_QKH(s0_, c0_, t, bc, 0); FR_QKH(s1_, c1_, t, bc, 1); }
            const bf16x8 p0l = FR_PACK(s0_, 0, c0_), p0h = FR_PACK(s0_, 8, c0_), p1l = FR_PACK(s1_, 0, c1_), p1h = FR_PACK(s1_, 8, c1_);
            o[0] = MFMA32(FR_VF(bc, 0, 0, 0), p0l, o[0]); o[1] = MFMA32(FR_VF(bc, 1, 0, 0), p0l, o[1]); o[0] = MFMA32(FR_VF(bc, 0, 0, 1), p0h, o[0]); o[1] = MFMA32(FR_VF(bc, 1, 0, 1), p0h, o[1]);
            o[0] = MFMA32(FR_VF(bc, 0, 1, 0), p1l, o[0]); o[1] = MFMA32(FR_VF(bc, 1, 1, 0), p1l, o[1]); o[0] = MFMA32(FR_VF(bc, 0, 1, 1), p1h, o[0]); o[1] = MFMA32(FR_VF(bc, 1, 1, 1), p1h, o[1]);
            __syncthreads(); }
#undef FR_QKH
#undef FR_PACK
#undef FR_VF
#undef FR_KF
#undef FR_STV
#undef FR_STK
#undef FR_LDV
#undef FR_LDK
        const size_t tok = tok0 + 32 * w + r;
        u32x2 gwl[2][4];
#pragma unroll
        for (int dvt = 0; dvt < 2; ++dvt)
#pragma unroll
            for (int q4 = 0; q4 < 4; ++q4) gwl[dvt][q4] = *(const u32x2*)(PE + tok * PEW + 2560 + h * 64 + 32 * dvt + 8 * q4 + 4 * hh);
        const int un = u + F.G; const bool has_next = un < 1024;
        const int nb = un >> 6, nh = (un >> 3) & 7, nqt = un & 7; const size_t ntok0 = (size_t)nb * SL + 256 * nqt, nkb = (size_t)nb * SL;
        const char* nkbase = (const char*)(PE + nkb * PEW + 2048 + nh * 64); const char* nvbase = (const char*)(VT + (size_t)(nh * 64) * T + nkb);
        if (has_next) { const bf16* qp = PE + (ntok0 + 32 * w + r) * PEW + nh * 64 + 8 * hh;
#pragma unroll
            for (int s = 0; s < 4; ++s) { qff[s] = *(const bf16x8*)(qp + 1536 + 16 * s); qfb[s] = *(const bf16x8*)(qp + 3072 + 16 * s); }
            rk0 = *(const u32x4*)(nkbase + kof); rk1 = *(const u32x4*)(nkbase + kof + 3072); rv0 = *(const u32x4*)(nvbase + vof);
            rk2 = *(const u32x4*)(nkbase + (size_t)(64 * PEW * 2) + kof); rk3 = *(const u32x4*)(nkbase + (size_t)(64 * PEW * 2) + kof + 3072); rv1 = *(const u32x4*)(nvbase + 128 + vof); }
        float ss = 0.f;
#pragma unroll
        for (int dvt = 0; dvt < 2; ++dvt)
#pragma unroll
            for (int q = 0; q < 16; ++q) ss += o[dvt][q] * o[dvt][q];
        ss += __shfl_xor(ss, 32); const float rms = rsqrtf(ss * (1.f / 64.f) + EPS);
#pragma unroll
        for (int dvt = 0; dvt < 2; ++dvt) { u32x2 wq[4];
#pragma unroll
            for (int q4 = 0; q4 < 4; ++q4) { const int dv0 = 32 * dvt + 8 * q4 + 4 * hh;
                const u32x2 gwv = gwl[dvt][q4]; const f32x4 gn = *(const LAS f32x4*)(gnl + h * 64 + dv0);
                const float gg[4] = {__builtin_bit_cast(float, gwv.x << 16), __builtin_bit_cast(float, gwv.x & 0xffff0000u), __builtin_bit_cast(float, gwv.y << 16), __builtin_bit_cast(float, gwv.y & 0xffff0000u)}; float ov[4];
#pragma unroll
                for (int e = 0; e < 4; ++e) ov[e] = o[dvt][4 * q4 + e] * rms * gn[e] * gg[e] * __builtin_amdgcn_rcpf(1.f + __builtin_amdgcn_exp2f(-gg[e] * LOG2E));
                wq[q4].x = pk2(ov[0], ov[1]); wq[q4].y = pk2(ov[2], ov[3]); }
#pragma unroll
            for (int qp = 0; qp < 2; ++qp) {
                const auto rx = __builtin_amdgcn_permlane32_swap(wq[2 * qp].x, wq[2 * qp + 1].x, false, false); const auto ry = __builtin_amdgcn_permlane32_swap(wq[2 * qp].y, wq[2 * qp + 1].y, false, false);
                *(u32x4*)(R + tok * 1024 + 512 + h * 64 + 32 * dvt + 8 * (2 * qp + hh)) = (u32x4){rx[0], ry[0], rx[1], ry[1]}; } }
        if (!has_next) break;
        u = un; b = nb; h = nh; qt = nqt; tok0 = ntok0; kb = nkb; kbase = nkbase; vbase = nvbase;
    }
}

__device__ __forceinline__ void xattn_phase(Frame& F, int l) {
    const bf16* Q = (const bf16*)(F.ws + WS_ACT + A_QX); bf16* OX = (bf16*)(F.ws + WS_ACT + A_OX);
    const bf16* KX = (const bf16*)(F.ws + WS_KX); const bf16* VTX = (const bf16*)(F.ws + WS_VTX);
    const int w = F.wave, lane = F.lane, r = lane & 31, hh = lane >> 5, tid = F.tid;
    LAS unsigned char* lds = F.lds;
    for (int u = F.bid; u < 512; u += F.G) { const int b = u >> 5, hd = (u >> 3) & 3, qt = u & 7; const size_t tok0 = (size_t)b * SL + 256 * qt;
        { const bf16* src = KX + (size_t)(b * 256) * 4096 + l * 1024 + hd * 256;
          u32x4 stg[16];
#pragma unroll
          for (int i = 0; i < 16; ++i) { const int idx = tid + 512 * i, m = idx >> 5, ch = idx & 31; stg[i] = *(const u32x4*)(src + (size_t)m * 4096 + ch * 8); }
#pragma unroll
          for (int i = 0; i < 16; ++i) { const int idx = tid + 512 * i, m = idx >> 5, ch = idx & 31; *(LAS u32x4*)(lds + m * 528 + ch * 16) = stg[i]; } }
        const bf16* qp = Q + (tok0 + 32 * w + r) * 1024 + hd * 256 + 8 * hh; bf16x8 qa[4], qb[4];
#pragma unroll
        for (int s = 0; s < 4; ++s) qa[s] = *(const bf16x8*)(qp + 16 * s);
        __syncthreads();
        f32x16 st[8];
#pragma unroll
        for (int mt = 0; mt < 8; ++mt) st[mt] = (f32x16){};
#pragma unroll
        for (int sg = 0; sg < 4; ++sg) {
            if (sg < 3) {
#pragma unroll
                for (int s = 0; s < 4; ++s) qb[s] = *(const bf16x8*)(qp + 16 * (4 * (sg + 1) + s)); }
#pragma unroll
            for (int s = 0; s < 4; ++s)
#pragma unroll
                for (int mt = 0; mt < 8; ++mt) st[mt] = MFMA32(*(const LAS bf16x8*)(lds + (32 * mt + r) * 528 + (16 * (4 * sg + s) + 8 * hh) * 2), qa[s], st[mt]);
#pragma unroll
            for (int s = 0; s < 4; ++s) qa[s] = qb[s];
        }
        float mx = -3.0e38f;
#pragma unroll
        for (int mt = 0; mt < 8; ++mt)
#pragma unroll
            for (int q = 0; q < 16; ++q) mx = fmaxf(mx, st[mt][q]);
        mx = fmaxf(mx, __shfl_xor(mx, 32)); float sum = 0.f;
#pragma unroll
        for (int mt = 0; mt < 8; ++mt)
#pragma unroll
            for (int q = 0; q < 16; ++q) { st[mt][q] = __builtin_amdgcn_exp2f(st[mt][q] - mx); sum += st[mt][q]; }
        sum += __shfl_xor(sum, 32); const float inv = __builtin_amdgcn_rcpf(sum);
        bf16x8 pf[8][2];
#pragma unroll
        for (int mt = 0; mt < 8; ++mt)
#pragma unroll
            for (int s2 = 0; s2 < 2; ++s2) pf[mt][s2] = pack_frag(st[mt][8 * s2 + 0], st[mt][8 * s2 + 1], st[mt][8 * s2 + 2], st[mt][8 * s2 + 3], st[mt][8 * s2 + 4], st[mt][8 * s2 + 5], st[mt][8 * s2 + 6], st[mt][8 * s2 + 7]);
        __syncthreads();
        { const bf16* src = VTX + (size_t)(l * 1024 + hd * 256) * 4096 + b * 256;
#pragma unroll 1
          for (int hb = 0; hb < 2; ++hb) { u32x4 stg[8];
#pragma unroll
            for (int i = 0; i < 8; ++i) { const int idx = tid + 512 * (8 * hb + i), d = idx >> 5, ch = idx & 31; stg[i] = *(const u32x4*)(src + (size_t)d * 4096 + ch * 8); }
#pragma unroll
            for (int i = 0; i < 8; ++i) { const int idx = tid + 512 * (8 * hb + i), d = idx >> 5, ch = idx & 31;
                LAS unsigned char* vd_ = lds + d * 528 + (ch >> 1) * 32 + (ch & 1) * 8; *(LAS u32x2*)(vd_) = (u32x2){stg[i].x, stg[i].y}; *(LAS u32x2*)(vd_ + 16) = (u32x2){stg[i].z, stg[i].w}; } } }
        __syncthreads();
        unsigned char* op = (unsigned char*)OX + (tok0 + 32 * w + r) * 1024 + hd * 256; const float inv4 = inv * 4.f;
#pragma unroll 1
        for (int dp = 0; dp < 4; ++dp) { f32x16 o0 = {}, o1 = {};
#pragma unroll
            for (int mt = 0; mt < 8; ++mt)
#pragma unroll
                for (int s2 = 0; s2 < 2; ++s2) { const int mo = (32 * mt + 16 * s2) * 2 + 16 * hh;
                    const LAS unsigned char* a0 = lds + (64 * dp + r) * 528 + mo; const LAS unsigned char* a1 = a0 + 32 * 528;
                    o0 = MFMA32(*(const LAS bf16x8*)a0, pf[mt][s2], o0);
                    o1 = MFMA32(*(const LAS bf16x8*)a1, pf[mt][s2], o1); }
#pragma unroll
            for (int qp = 0; qp < 2; ++qp) {
                const int qa = 2 * qp, qb = 2 * qp + 1;
                const unsigned a0 = pg8::pack_fp8x4(o0[4 * qa] * inv4, o0[4 * qa + 1] * inv4, o0[4 * qa + 2] * inv4, o0[4 * qa + 3] * inv4), b0 = pg8::pack_fp8x4(o0[4 * qb] * inv4, o0[4 * qb + 1] * inv4, o0[4 * qb + 2] * inv4, o0[4 * qb + 3] * inv4);
                const unsigned a1 = pg8::pack_fp8x4(o1[4 * qa] * inv4, o1[4 * qa + 1] * inv4, o1[4 * qa + 2] * inv4, o1[4 * qa + 3] * inv4), b1 = pg8::pack_fp8x4(o1[4 * qb] * inv4, o1[4 * qb + 1] * inv4, o1[4 * qb + 2] * inv4, o1[4 * qb + 3] * inv4);
                const auto r0 = __builtin_amdgcn_permlane32_swap(a0, b0, false, false); const auto r1 = __builtin_amdgcn_permlane32_swap(a1, b1, false, false);
                *(u32x2*)(op + 64 * dp + 8 * (qa + hh)) = (u32x2){r0[0], r0[1]}; *(u32x2*)(op + 64 * dp + 32 + 8 * (qa + hh)) = (u32x2){r1[0], r1[1]}; } }
        __syncthreads();
    }
}

#define DA_SB() __builtin_amdgcn_sched_barrier(0)
__device__ __forceinline__ float da_max3(float a, float b, float c) { return fmaxf(fmaxf(a, b), c); }
__device__ __forceinline__ void dattn_phase(Frame& F, const Args& A, int j, float lambda_init) {
    const bf16* QK = (const bf16*)(F.ws + WS_ACT + A_QK); const bf16* VT = (const bf16*)(F.ws + WS_ACT + A_VTD); bf16* AO = (bf16*)(F.ws + WS_ACT + A_AO);
    const int w = F.wave, lane = F.lane, r = lane & 31, hh = lane >> 5, tid = F.tid, mp = w & 1, ig = w >> 1;
    LAS unsigned char* lds = F.lds;
    LAS float* xb = (LAS float*)(lds) + ig * 4096;
    float lam; { float s1 = 0.f, s2 = 0.f; for (int e = 0; e < 64; ++e) { s1 += A.lq1[j * 64 + e] * A.lk1[j * 64 + e]; s2 += A.lq2[j * 64 + e] * A.lk2[j * 64 + e]; } lam = __expf(s1) - __expf(s2) + lambda_init; }
    lam = __builtin_bit_cast(float, __builtin_amdgcn_readfirstlane(__builtin_bit_cast(int, lam)));
    const int li_s = __builtin_amdgcn_readfirstlane(__builtin_bit_cast(int, lambda_init)); const float* gng = A.od_gn + j * 1024;
    const int srow = tid >> 3, sch = tid & 7;
    const int kfo = mp * 9216 + r * 144 + 16 * hh;
    const int vfo = 36864 + r * 144 + 16 * hh;
    const int stv = srow * 144 + (sch >> 1) * 32 + (sch & 1) * 8;
    const int sto = srow * 144 + sch * 16;
    LAS float* gnl = (LAS float*)(lds + 77824);
    if (tid < 256) *(LAS f32x4*)(gnl + 4 * tid) = *(const f32x4*)(gng + 4 * tid);
    int u = F.bid; if (u >= 2048) { __syncthreads(); return; }
    int b = u >> 7, h = (u >> 4) & 7, qt = u & 15; size_t tok0 = (size_t)b * SL + 128 * qt, kb = (size_t)b * SL;
    bf16x8 qf[4]; u32x4 rk0, rk1, rv0, rv1, rk2, rk3;
    const bf16* k0s = QK + (kb + srow) * 2048 + 1024 + (2 * h) * 64 + sch * 8; const bf16* k1s = k0s + 64;
    const bf16* v0s = VT + (size_t)(h * 128 + srow) * T + kb + sch * 8; const bf16* v1s = v0s + (size_t)64 * T;
    { const bf16* qp = QK + (tok0 + 32 * ig + r) * 2048 + (2 * h + mp) * 64 + 8 * hh;
#pragma unroll
      for (int s = 0; s < 4; ++s) qf[s] = *(const bf16x8*)(qp + 16 * s);
      rk0 = *(const u32x4*)(k0s); rk1 = *(const u32x4*)(k1s); rv0 = *(const u32x4*)(v0s); rv1 = *(const u32x4*)(v1s); rk2 = *(const u32x4*)(k0s + (size_t)64 * 2048); rk3 = *(const u32x4*)(k1s + (size_t)64 * 2048); }
    for (;;) {
#define DA_LDK(t) do { const size_t ko_ = (size_t)(t) * 64 * 2048; rk0 = *(const u32x4*)(k0s + ko_); rk1 = *(const u32x4*)(k1s + ko_); } while (0)
#define DA_LDV(t) do { const size_t vo_ = (size_t)(t) * 64; rv0 = *(const u32x4*)(v0s + vo_); rv1 = *(const u32x4*)(v1s + vo_); } while (0)
#define DA_STK(bf) do { *(LAS u32x4*)(lds + (bf) * 18432 + sto) = rk0; *(LAS u32x4*)(lds + (bf) * 18432 + 9216 + sto) = rk1; } while (0)
#define DA_STV(bf) do { LAS unsigned char* vd_ = lds + 36864 + (bf) * 18432 + stv; *(LAS u32x2*)(vd_) = (u32x2){rv0.x, rv0.y}; *(LAS u32x2*)(vd_ + 16) = (u32x2){rv0.z, rv0.w}; \
        *(LAS u32x2*)(vd_ + 9216) = (u32x2){rv1.x, rv1.y}; *(LAS u32x2*)(vd_ + 9216 + 16) = (u32x2){rv1.z, rv1.w}; } while (0)
        DA_STK(0); DA_STV(0); *(LAS u32x4*)(lds + 18432 + sto) = rk2; *(LAS u32x4*)(lds + 18432 + 9216 + sto) = rk3; DA_LDK(2); DA_LDV(1);
        __syncthreads();
        const f32x16 zero16 = {};
        f32x16 pA0, pA1, pB0, pB1; f32x16 o[4] = {{}, {}, {}, {}}; float m_ref = 0.f, l_run = 0.f;
        { pA0 = zero16; pA1 = zero16;
#pragma unroll
          for (int s = 0; s < 4; ++s) { pA0 = MFMA32(*(const LAS bf16x8*)(lds + kfo + 32 * s), qf[s], pA0); pA1 = MFMA32(*(const LAS bf16x8*)(lds + kfo + 4608 + 32 * s), qf[s], pA1); }
          float rm = -3.0e38f;
#pragma unroll
          for (int q = 0; q < 16; ++q) rm = da_max3(rm, pA0[q], pA1[q]);
          rm = fmaxf(rm, __shfl_xor(rm, 32)); m_ref = rm; }
        __syncthreads();
        bf16x8 pb0, pb1, pb2, pb3;
#define DA_EXP4(P, B) do { P[B] = __builtin_amdgcn_exp2f(P[B] - m_ref); P[B + 1] = __builtin_amdgcn_exp2f(P[B + 1] - m_ref); P[B + 2] = __builtin_amdgcn_exp2f(P[B + 2] - m_ref); P[B + 3] = __builtin_amdgcn_exp2f(P[B + 3] - m_ref); \
        sacc += (P[B] + P[B + 1]) + (P[B + 2] + P[B + 3]); } while (0)
#define DA_PACK(P, B) pack_frag(P[B], P[B + 1], P[B + 2], P[B + 3], P[B + 4], P[B + 5], P[B + 6], P[B + 7])
#define DA_KF(kbn, kt2, s) (*(const LAS bf16x8*)(lds + (kbn) * 18432 + kfo + (kt2) * 4608 + 32 * (s)))
#define DA_VF(vbc, dvt, k2, s2) (*(const LAS bf16x8*)(lds + (vbc) * 18432 + vfo + 4608 * (dvt) + 64 * (k2) + 32 * (s2)))
#define DA_EXP2(P, B) do { P[B] = __builtin_amdgcn_exp2f(P[B] - m_ref); P[B + 1] = __builtin_amdgcn_exp2f(P[B + 1] - m_ref); sacc += P[B] + P[B + 1]; } while (0)
#define DA_STEP(C0, C1, N0, N1, t, HASN) do { const int kbn_ = ((t) + 1) & 1, vbc_ = (t) & 1; float sacc = 0.f; bf16x8 fa_, fb_; \
        if (HASN) fa_ = DA_KF(kbn_, 0, 0); else fa_ = DA_VF(vbc_, 0, 0, 0); \
        DA_SB(); \
        if (HASN) { fb_ = DA_KF(kbn_, 1, 0); N0 = MFMA32(fa_, qf[0], zero16); } DA_EXP2(C0, 0);  DA_SB(); \
        if (HASN) { fa_ = DA_KF(kbn_, 0, 1); N1 = MFMA32(fb_, qf[0], zero16); } DA_EXP2(C0, 2);  DA_SB(); \
        if (HASN) { fb_ = DA_KF(kbn_, 1, 1); N0 = MFMA32(fa_, qf[1], N0); }   DA_EXP2(C0, 4);  DA_SB(); \
        if (HASN) { fa_ = DA_KF(kbn_, 0, 2); N1 = MFMA32(fb_, qf[1], N1); }   DA_EXP2(C0, 6);  pb0 = DA_PACK(C0, 0); DA_SB(); \
        if (HASN) { fb_ = DA_KF(kbn_, 1, 2); N0 = MFMA32(fa_, qf[2], N0); }   DA_EXP2(C0, 8);  DA_SB(); \
        if (HASN) { fa_ = DA_KF(kbn_, 0, 3); N1 = MFMA32(fb_, qf[2], N1); }   DA_EXP2(C0, 10); DA_SB(); \
        if (HASN) { fb_ = DA_KF(kbn_, 1, 3); N0 = MFMA32(fa_, qf[3], N0); }   DA_EXP2(C0, 12); DA_SB(); \
        if (HASN) { fa_ = DA_VF(vbc_, 0, 0, 0); N1 = MFMA32(fb_, qf[3], N1); } DA_EXP2(C0, 14); pb1 = DA_PACK(C0, 8); DA_SB(); \
        float rm0 = -3.0e38f, rm1 = -3.0e38f; \
        fb_ = DA_VF(vbc_, 1, 0, 0); o[0] = MFMA32(fa_, pb0, o[0]); DA_EXP2(C1, 0);  if ((t) + 2 < 32) { DA_STK((t) & 1); } DA_SB(); \
        fa_ = DA_VF(vbc_, 2, 0, 0); o[1] = MFMA32(fb_, pb0, o[1]); DA_EXP2(C1, 2);  if ((t) + 3 < 32) { DA_LDK((t) + 3); } DA_SB(); \
        fb_ = DA_VF(vbc_, 3, 0, 0); o[2] = MFMA32(fa_, pb0, o[2]); DA_EXP2(C1, 4);  DA_SB(); \
        fa_ = DA_VF(vbc_, 0, 0, 1); o[3] = MFMA32(fb_, pb0, o[3]); DA_EXP2(C1, 6);  pb2 = DA_PACK(C1, 0); DA_SB(); \
        fb_ = DA_VF(vbc_, 1, 0, 1); o[0] = MFMA32(fa_, pb1, o[0]); DA_EXP2(C1, 8);  DA_SB(); \
        fa_ = DA_VF(vbc_, 2, 0, 1); o[1] = MFMA32(fb_, pb1, o[1]); DA_EXP2(C1, 10); DA_SB(); \
        fb_ = DA_VF(vbc_, 3, 0, 1); o[2] = MFMA32(fa_, pb1, o[2]); DA_EXP2(C1, 12); DA_SB(); \
        fa_ = DA_VF(vbc_, 0, 1, 0); o[3] = MFMA32(fb_, pb1, o[3]); DA_EXP2(C1, 14); pb3 = DA_PACK(C1, 8); DA_SB(); \
        l_run += sacc; \
        fb_ = DA_VF(vbc_, 1, 1, 0); o[0] = MFMA32(fa_, pb2, o[0]); if (HASN) { rm0 = da_max3(rm0, N0[0], N0[1]); rm1 = da_max3(rm1, N0[2], N0[3]); }     if ((t) + 1 < 32) { DA_STV(((t) + 1) & 1); } DA_SB(); \
        fa_ = DA_VF(vbc_, 2, 1, 0); o[1] = MFMA32(fb_, pb2, o[1]); if (HASN) { rm0 = da_max3(rm0, N0[4], N0[5]); rm1 = da_max3(rm1, N0[6], N0[7]); }     if ((t) + 2 < 32) { DA_LDV((t) + 2); } DA_SB(); \
        fb_ = DA_VF(vbc_, 3, 1, 0); o[2] = MFMA32(fa_, pb2, o[2]); if (HASN) { rm0 = da_max3(rm0, N0[8], N0[9]); rm1 = da_max3(rm1, N0[10], N0[11]); }   DA_SB(); \
        fa_ = DA_VF(vbc_, 0, 1, 1); o[3] = MFMA32(fb_, pb2, o[3]); if (HASN) { rm0 = da_max3(rm0, N0[12], N0[13]); rm1 = da_max3(rm1, N0[14], N0[15]); } DA_SB(); \
        fb_ = DA_VF(vbc_, 1, 1, 1); o[0] = MFMA32(fa_, pb3, o[0]); if (HASN) { rm0 = da_max3(rm0, N1[0], N1[1]); rm1 = da_max3(rm1, N1[2], N1[3]); }     DA_SB(); \
        fa_ = DA_VF(vbc_, 2, 1, 1); o[1] = MFMA32(fb_, pb3, o[1]); if (HASN) { rm0 = da_max3(rm0, N1[4], N1[5]); rm1 = da_max3(rm1, N1[6], N1[7]); }     DA_SB(); \
        fb_ = DA_VF(vbc_, 3, 1, 1); o[2] = MFMA32(fa_, pb3, o[2]); if (HASN) { rm0 = da_max3(rm0, N1[8], N1[9]); rm1 = da_max3(rm1, N1[10], N1[11]); }   DA_SB(); \
        o[3] = MFMA32(fb_, pb3, o[3]); if (HASN) { rm0 = da_max3(rm0, N1[12], N1[13]); rm1 = da_max3(rm1, N1[14], N1[15]); } DA_SB(); \
        if (HASN) { float rm = fmaxf(rm0, rm1); rm = fmaxf(rm, __shfl_xor(rm, 32)) - m_ref; \
            if (__builtin_expect(__any(rm > 8.f), 0)) { const float dl = fmaxf(rm, 0.f), f = __builtin_amdgcn_exp2f(-dl); m_ref += dl; l_run *= f; \
                _Pragma("unroll") for (int d_ = 0; d_ < 4; ++d_) _Pragma("unroll") for (int q = 0; q < 16; ++q) o[d_][q] *= f; } } \
        __syncthreads(); } while (0)
#pragma unroll 1
        for (int t = 0; t < 30; t += 2) { DA_STEP(pA0, pA1, pB0, pB1, t, true); DA_STEP(pB0, pB1, pA0, pA1, t + 1, true); }
        DA_STEP(pA0, pA1, pB0, pB1, 30, true); DA_STEP(pB0, pB1, pA0, pA1, 31, false);
#undef DA_STEP
#undef DA_VF
#undef DA_KF
#undef DA_PACK
#undef DA_EXP4
#undef DA_EXP2
#undef DA_LDK
#undef DA_LDV
#undef DA_STK
#undef DA_STV
        asm volatile("" ::: "memory");
        const int un = u + F.G; const bool has_next = un < 2048;
        const int nb = un >> 7, nh = (un >> 4) & 7, nqt = un & 15; const size_t ntok0 = (size_t)nb * SL + 128 * nqt, nkb = (size_t)nb * SL;
        const bf16* nk0s = QK + (nkb + srow) * 2048 + 1024 + (2 * nh) * 64 + sch * 8; const bf16* nv0s = VT + (size_t)(nh * 128 + srow) * T + nkb + sch * 8;
        if (has_next) { const bf16* qp = QK + (ntok0 + 32 * ig + r) * 2048 + (2 * nh + mp) * 64 + 8 * hh;
#pragma unroll
            for (int s = 0; s < 4; ++s) qf[s] = *(const bf16x8*)(qp + 16 * s);
            rk0 = *(const u32x4*)(nk0s); rk1 = *(const u32x4*)(nk0s + 64); rv0 = *(const u32x4*)(nv0s); rv1 = *(const u32x4*)(nv0s + (size_t)64 * T);
            rk2 = *(const u32x4*)(nk0s + (size_t)64 * 2048); rk3 = *(const u32x4*)(nk0s + 64 + (size_t)64 * 2048); }
        l_run += __shfl_xor(l_run, 32); const float inv = __builtin_amdgcn_rcpf(l_run);
        if (mp == 1) {
#pragma unroll
            for (int dvt = 0; dvt < 4; ++dvt)
#pragma unroll
                for (int q = 0; q < 16; ++q) xb[(dvt * 16 + q) * 64 + lane] = o[dvt][q] * inv; }
        __syncthreads();
        if (mp == 0) { float ss = 0.f;
#pragma unroll
            for (int dvt = 0; dvt < 4; ++dvt)
#pragma unroll
                for (int q = 0; q < 16; ++q) { o[dvt][q] = o[dvt][q] * inv - lam * xb[(dvt * 16 + q) * 64 + lane]; ss += o[dvt][q] * o[dvt][q]; }
            int lt_ = li_s; asm volatile("" : "+s"(lt_)); const float li_ = __builtin_bit_cast(float, lt_);
            ss += __shfl_xor(ss, 32); const float rms = rsqrtf(ss * (1.f / 128.f) + EPS) * (1.f - li_);
            bf16* op = AO + (tok0 + 32 * ig + r) * 1024 + h * 128;
#pragma unroll
            for (int dvt = 0; dvt < 4; ++dvt) { u32x2 wq[4];
#pragma unroll
                for (int q4 = 0; q4 < 4; ++q4) { const int dv0 = 32 * dvt + 8 * q4 + 4 * hh; const f32x4 gn = *(const LAS f32x4*)(gnl + h * 128 + dv0);
                    wq[q4].x = pk2(o[dvt][4 * q4] * rms * gn[0], o[dvt][4 * q4 + 1] * rms * gn[1]); wq[q4].y = pk2(o[dvt][4 * q4 + 2] * rms * gn[2], o[dvt][4 * q4 + 3] * rms * gn[3]); }
#pragma unroll
                for (int qp = 0; qp < 2; ++qp) {
                    const auto rx = __builtin_amdgcn_permlane32_swap(wq[2 * qp].x, wq[2 * qp + 1].x, false, false); const auto ry = __builtin_amdgcn_permlane32_swap(wq[2 * qp].y, wq[2 * qp + 1].y, false, false);
                    *(u32x4*)(op + 32 * dvt + 8 * (2 * qp + hh)) = (u32x4){rx[0], ry[0], rx[1], ry[1]}; } } }
        __syncthreads();
        if (!has_next) break;
        u = un; b = nb; h = nh; qt = nqt; tok0 = ntok0; kb = nkb; k0s = nk0s; k1s = nk0s + 64; v0s = nv0s; v1s = nv0s + (size_t)64 * T;
    }
}
#undef DA_SB

__device__ __forceinline__ void router_phase(Frame& F, const Args& A, int i  , int j, int jc) {
    LAS int* lcnt = (LAS int*)(F.lds); LAS int* lbase = lcnt + 8;
    LAS f32x4* wl = (LAS f32x4*)(F.lds + 1024);
    const bf16* X = (const bf16*)(F.ws + WS_XB); const float* ssq = (const float*)(F.ws + WS_SSQ); const float* Wr = A.router + (size_t)j * D * NE; const float* gf = A.ffn_g + i * D;
    int* list = (int*)(F.ws + WS_MISC + MISC_LIST); float* gate = (float*)(F.ws + WS_MISC + MISC_GATE); int* epos = (int*)(F.ws + WS_MISC + MISC_EPOS);
    for (int idx = F.tid; idx < 2048; idx += NTHR) { const int ln = idx & 63, kk2 = idx >> 6, k = 4 * ln + 256 * (kk2 >> 3) + ((kk2 >> 1) & 3);
        wl[idx] = *(const f32x4*)(Wr + (size_t)k * 8 + 4 * (kk2 & 1)) * gf[k]; }
    if (F.tid < 8) lcnt[F.tid] = 0;
    __syncthreads();
    const bool h5 = (F.lane & 32) != 0, h4 = (F.lane & 16) != 0, h3 = (F.lane & 8) != 0, h2 = (F.lane & 4) != 0, h1 = (F.lane & 2) != 0, h0 = (F.lane & 1) != 0;
    for (int grp = F.bid; grp < T / 128; grp += F.G) {
        int my_e0 = 0, my_e1 = 0; float my_g0 = 0.f, my_g1 = 0.f;
#pragma unroll 1
        for (int bt = 0; bt < 2; ++bt) {
            const int tok0 = grp * 128 + F.wave * 16 + bt * 8;
            asm volatile("" ::: "memory");
            u32x2 xw[8][4];
#pragma unroll
            for (int s = 0; s < 8; ++s)
#pragma unroll
                for (int q = 0; q < 4; ++q) xw[s][q] = *(const u32x2*)(X + (size_t)(tok0 + s) * D + 4 * F.lane + 256 * q);
            const u32x2 spw = *(const u32x2*)(ssq + (size_t)(tok0 + (F.lane >> 3)) * 16 + 2 * (F.lane & 7));
            f32x4 acc[8][2];
#pragma unroll
            for (int s = 0; s < 8; ++s) { acc[s][0] = f32x4{0.f, 0.f, 0.f, 0.f}; acc[s][1] = f32x4{0.f, 0.f, 0.f, 0.f}; }
#pragma unroll
            for (int q = 0; q < 4; ++q)
#pragma unroll
                for (int e4 = 0; e4 < 4; ++e4) { const f32x4 w0 = wl[((q * 4 + e4) * 2 + 0) * 64 + F.lane], w1 = wl[((q * 4 + e4) * 2 + 1) * 64 + F.lane];
#pragma unroll
                    for (int s = 0; s < 8; ++s) { const unsigned wd = (e4 < 2) ? xw[s][q].x : xw[s][q].y; const float xv = __builtin_bit_cast(float, (e4 & 1) ? (wd & 0xffff0000u) : (wd << 16));
                        acc[s][0] += w0 * xv; acc[s][1] += w1 * xv; } }
            float v32[32], v16[16], v8[8], v4[4], v2[2];
#pragma unroll
            for (int v = 0; v < 32; ++v) { const float lo = acc[v >> 3][(v >> 2) & 1][v & 3], hi = acc[(v >> 3) + 4][(v >> 2) & 1][v & 3]; v32[v] = (h5 ? hi : lo) + __shfl_xor(h5 ? lo : hi, 32); }
#pragma unroll
            for (int v = 0; v < 16; ++v) v16[v] = (h4 ? v32[v + 16] : v32[v]) + __shfl_xor(h4 ? v32[v] : v32[v + 16], 16);
#pragma unroll
            for (int v = 0; v < 8; ++v) v8[v] = (h3 ? v16[v + 8] : v16[v]) + __shfl_xor(h3 ? v16[v] : v16[v + 8], 8);
#pragma unroll
            for (int v = 0; v < 4; ++v) v4[v] = (h2 ? v8[v + 4] : v8[v]) + __shfl_xor(h2 ? v8[v] : v8[v + 4], 4);
#pragma unroll
            for (int v = 0; v < 2; ++v) v2[v] = (h1 ? v4[v + 2] : v4[v]) + __shfl_xor(h1 ? v4[v] : v4[v + 2], 2);
            const float tot = (h0 ? v2[1] : v2[0]) + __shfl_xor(h0 ? v2[0] : v2[1], 1);
            float p = __builtin_bit_cast(float, spw.x) + __builtin_bit_cast(float, spw.y); p += __shfl_xor(p, 1); p += __shfl_xor(p, 2); p += __shfl_xor(p, 4);
            float m1 = tot * rsqrtf(p * (1.f / D) + EPS), m2 = -3.0e38f; int i1 = F.lane & 7, i2 = -1;
#pragma unroll
            for (int M = 1; M < 8; M <<= 1) {
                const float pm1 = __shfl_xor(m1, M), pm2 = __shfl_xor(m2, M); const int pi1 = __shfl_xor(i1, M), pi2 = __shfl_xor(i2, M);
                const bool ab = (m1 > pm1) || (m1 == pm1 && i1 < pi1);
                const float wm = ab ? m1 : pm1, lm = ab ? pm1 : m1, sm = ab ? m2 : pm2; const int wi = ab ? i1 : pi1, li = ab ? pi1 : i1, si = ab ? i2 : pi2;
                const bool ls = (lm > sm) || (lm == sm && li < si);
                m1 = wm; i1 = wi; m2 = ls ? lm : sm; i2 = ls ? li : si; }
            const float w1 = 1.f / (1.f + __expf(m2 - m1));
            const int src = 8 * (F.lane & 7); const int ri1 = __shfl(i1, src), ri2 = __shfl(i2, src); const float rw = __shfl(w1, src);
            if ((F.lane >> 3) == bt) { my_e0 = ri1; my_e1 = ri2; my_g0 = rw; my_g1 = 1.f - rw; } }
        int p0 = 0, p1 = 0;
        if (F.lane < 16) { p0 = atomicAdd((int*)&lcnt[my_e0], 1); p1 = atomicAdd((int*)&lcnt[my_e1], 1); }
        __syncthreads();
        if (F.tid < 8) lbase[F.tid] = (int)__hip_atomic_fetch_add((unsigned*)(F.ctl + CW_CNT + jc * 1024 + 64 * F.tid), (unsigned)lcnt[F.tid], RLX_AGENT);
        __syncthreads();
        if (F.lane < 16) { const int tok = grp * 128 + F.wave * 16 + F.lane; const int q0 = lbase[my_e0] + p0, q1 = lbase[my_e1] + p1;
            list[(size_t)my_e0 * T + q0] = tok * 2; list[(size_t)my_e1 * T + q1] = tok * 2 + 1;
            epos[tok * 2] = (my_e0 << 20) | q0; epos[tok * 2 + 1] = (my_e1 << 20) | q1; gate[tok * 2] = my_g0; gate[tok * 2 + 1] = my_g1; }
        __syncthreads();
        if (F.tid < 8) lcnt[F.tid] = 0;
        __syncthreads();
    }
}
struct TileBase { int tb[9]; int cnt[8]; };
__device__ __forceinline__ void load_tilebase(Frame& F, int j, TileBase& B) {
    int run = 0;
#pragma unroll
    for (int e = 0; e < 8; ++e) { const int c = (int)__hip_atomic_load((unsigned*)(F.ctl + CW_CNT + j * 1024 + 64 * e), RLX_AGENT); B.cnt[e] = c; B.tb[e] = run; run += (c + 255) >> 8; }
    B.tb[8] = run;
}
__device__ __forceinline__ void gather_phase(Frame& F, int j) {
    TileBase B; load_tilebase(F, j, B);
    const bf16* XB = (const bf16*)(F.ws + WS_XB); unsigned char* XS = F.ws + WS_ACT + A_XS; const float* ssq = (const float*)(F.ws + WS_SSQ);
    const int* list = (const int*)(F.ws + WS_MISC + MISC_LIST); int* yrow = (int*)(F.ws + WS_MISC + MISC_YROW);
    const int gw = F.bid * NWAVES + F.wave, NGW = F.G * NWAVES, nrows = B.tb[8] * 256;
    const int my_rr = 2 * gw + 2 * NGW * (F.lane >> 1) + (F.lane & 1); int my_tk = -1; float my_rs = 0.f;
    if (my_rr < nrows) { const int gt = my_rr >> 8; int e = 0, tbe = 0, ce = B.cnt[0];
#pragma unroll
        for (int k = 1; k < 8; ++k) if (gt >= B.tb[k]) { e = k; tbe = B.tb[k]; ce = B.cnt[k]; }
        const int posr = my_rr - tbe * 256;
        if (posr < ce) { my_tk = list[(size_t)e * T + posr]; const f32x4* sp = (const f32x4*)(ssq + (size_t)(my_tk >> 1) * 16);
            const f32x4 s0 = sp[0], s1 = sp[1], s2 = sp[2], s3 = sp[3];
            const float pp = ((s0[0] + s0[1]) + (s0[2] + s0[3])) + ((s1[0] + s1[1]) + (s1[2] + s1[3])) + ((s2[0] + s2[1]) + (s2[2] + s2[3])) + ((s3[0] + s3[1]) + (s3[2] + s3[3]));
            my_rs = rsqrtf(pp * (1.f / D) + EPS); yrow[my_tk] = my_rr; } }
#define GA_LOAD(V0, V1, RS, k_) do { _Pragma("unroll") for (int s = 0; s < 4; ++s) { const int li = 2 * (k_) + s; const int tks = __builtin_amdgcn_readlane(my_tk, li & 63); \
            RS[s] = __builtin_bit_cast(float, __builtin_amdgcn_readlane(__builtin_bit_cast(int, my_rs), li & 63)); \
            const u32x4* src = (const u32x4*)(XB + (size_t)((tks < 0 ? 0 : tks) >> 1) * D) + F.lane; V0[s] = src[0]; V1[s] = src[64]; } } while (0)
#define BFLO(w) (__builtin_bit_cast(float, (w) << 16) * rsx)
#define BFHI(w) (__builtin_bit_cast(float, (w) & 0xffff0000u) * rsx)
#define GA_PROC(V0, V1, RS, k_) do { _Pragma("unroll") for (int s = 0; s < 4; ++s) { const int rr = 2 * gw + 2 * NGW * ((k_) + (s >> 1)) + (s & 1); if (rr < nrows) { const float rsx = RS[s]; u32x2 o0, o1; \
                o0.x = pg8::pack_fp8x4(BFLO(V0[s].x), BFHI(V0[s].x), BFLO(V0[s].y), BFHI(V0[s].y)); o0.y = pg8::pack_fp8x4(BFLO(V0[s].z), BFHI(V0[s].z), BFLO(V0[s].w), BFHI(V0[s].w)); \
                o1.x = pg8::pack_fp8x4(BFLO(V1[s].x), BFHI(V1[s].x), BFLO(V1[s].y), BFHI(V1[s].y)); o1.y = pg8::pack_fp8x4(BFLO(V1[s].z), BFHI(V1[s].z), BFLO(V1[s].w), BFHI(V1[s].w)); \
                u32x2* dst = (u32x2*)(XS + (size_t)rr * D) + F.lane; dst[0] = o0; dst[64] = o1; } } } while (0)
    { u32x4 a0[4], a1[4], b0[4], b1[4]; float ars[4], brs[4];
      GA_LOAD(a0, a1, ars, 0);
#pragma unroll 1
      for (int k = 0; 2 * gw + 2 * NGW * k < nrows; k += 4) {
        GA_LOAD(b0, b1, brs, k + 2);
        GA_PROC(a0, a1, ars, k);
        GA_LOAD(a0, a1, ars, k + 4);
        GA_PROC(b0, b1, brs, k + 2); } }
#undef GA_PROC
#undef GA_LOAD
#undef BFHI
#undef BFLO
}
__device__ __forceinline__ void combine_phase(Frame& F, const Args& A, bool last, int dry = 0) {
    const bf16* Y = (const bf16*)(F.ws + WS_ACT + A_Y); const int* yrow = (const int*)(F.ws + WS_MISC + MISC_YROW); const float* gate = (const float*)(F.ws + WS_MISC + MISC_GATE);
    const int gw = F.bid * NWAVES + F.wave, NGW = F.G * NWAVES;
    const bool h5 = (F.lane & 32) != 0, h4 = (F.lane & 16) != 0;
    for (int base = gw * 16; base < T; base += NGW * 16) {
        u32x2 yr = {0u, 0u}, gg = {0u, 0u};
        if (F.lane < 16) { yr = *(const u32x2*)(yrow + 2 * (base + F.lane)); gg = *(const u32x2*)(gate + 2 * (base + F.lane)); }
#pragma unroll 1
        for (int b4 = 0; b4 < 4; ++b4) { const int m0 = base + b4 * 4;
            u32x2 xw[4][4], ya[4][4], yb[4][4]; float g0[4], g1[4];
#pragma unroll
            for (int s = 0; s < 4; ++s) { const int tl = b4 * 4 + s; const int r0 = __builtin_amdgcn_readlane((int)yr.x, tl), r1 = __builtin_amdgcn_readlane((int)yr.y, tl);
                g0[s] = __builtin_bit_cast(float, __builtin_amdgcn_readlane((int)gg.x, tl)); g1[s] = __builtin_bit_cast(float, __builtin_amdgcn_readlane((int)gg.y, tl));
                const u32x2* xr = (const u32x2*)((const bf16*)(F.ws + WS_XB) + (size_t)(m0 + s) * D) + F.lane; const u32x2* y0 = (const u32x2*)(Y + (size_t)r0 * D) + F.lane; const u32x2* y1 = (const u32x2*)(Y + (size_t)r1 * D) + F.lane;
#pragma unroll
                for (int q = 0; q < 4; ++q) { xw[s][q] = xr[64 * q]; ya[s][q] = y0[64 * q]; yb[s][q] = y1[64 * q]; } }
            f32x4 v[4][4]; float sq[4];
#pragma unroll
            for (int s = 0; s < 4; ++s) { sq[s] = 0.f;
#pragma unroll
                for (int q = 0; q < 4; ++q) { const u32x2 x = xw[s][q], a = ya[s][q], b = yb[s][q];
                    v[s][q][0] = __builtin_bit_cast(float, x.x << 16) + g0[s] * __builtin_bit_cast(float, a.x << 16) + g1[s] * __builtin_bit_cast(float, b.x << 16);
                    v[s][q][1] = __builtin_bit_cast(float, x.x & 0xffff0000u) + g0[s] * __builtin_bit_cast(float, a.x & 0xffff0000u) + g1[s] * __builtin_bit_cast(float, b.x & 0xffff0000u);
                    v[s][q][2] = __builtin_bit_cast(float, x.y << 16) + g0[s] * __builtin_bit_cast(float, a.y << 16) + g1[s] * __builtin_bit_cast(float, b.y << 16);
                    v[s][q][3] = __builtin_bit_cast(float, x.y & 0xffff0000u) + g0[s] * __builtin_bit_cast(float, a.y & 0xffff0000u) + g1[s] * __builtin_bit_cast(float, b.y & 0xffff0000u);
                    if (!last) {
#pragma unroll
                        for (int e = 0; e < 4; ++e) v[s][q][e] = bf2f((bf16)f2bf(v[s][q][e])); }
                    sq[s] += (v[s][q][0] * v[s][q][0] + v[s][q][1] * v[s][q][1]) + (v[s][q][2] * v[s][q][2] + v[s][q][3] * v[s][q][3]); } }
            const float t0 = (h5 ? sq[2] : sq[0]) + __shfl_xor(h5 ? sq[0] : sq[2], 32), t1 = (h5 ? sq[3] : sq[1]) + __shfl_xor(h5 ? sq[1] : sq[3], 32);
            float tt = (h4 ? t1 : t0) + __shfl_xor(h4 ? t0 : t1, 16);
            tt += __shfl_xor(tt, 8); tt += __shfl_xor(tt, 4); tt += __shfl_xor(tt, 2); tt += __shfl_xor(tt, 1);
#pragma unroll
            for (int s = 0; s < 4; ++s) { const int m = m0 + s; const float ssum = __builtin_bit_cast(float, __builtin_amdgcn_readlane(__builtin_bit_cast(int, tt), 16 * s));
                if (last && !dry) { const float rs = rsqrtf(ssum * (1.f / D) + EPS); const f32x4* gr = (const f32x4*)A.fin_g + F.lane;
                    f32x4* orow = (f32x4*)(A.out + (size_t)m * D) + F.lane;
#pragma unroll
                    for (int q = 0; q < 4; ++q) { const f32x4 g = gr[64 * q]; f32x4 o; o[0] = v[s][q][0] * rs * g[0]; o[1] = v[s][q][1] * rs * g[1]; o[2] = v[s][q][2] * rs * g[2]; o[3] = v[s][q][3] * rs * g[3]; orow[64 * q] = o; } }
                else { u32x2* xo = dry ? (u32x2*)((bf16*)(F.ws + WS_ACT) + (size_t)m * D) + F.lane : (u32x2*)((bf16*)(F.ws + WS_XB) + (size_t)m * D) + F.lane; float* sw = dry ? (float*)(F.ws + WS_ACT + 64 * MiB) : (float*)(F.ws + WS_SSQ);
#pragma unroll
                    for (int q = 0; q < 4; ++q) { u32x2 wv; wv.x = pk2(v[s][q][0], v[s][q][1]); wv.y = pk2(v[s][q][2], v[s][q][3]); xo[64 * q] = wv; }
                    if (F.lane < 16) sw[(size_t)m * 16 + F.lane] = (F.lane == 0) ? ssum : 0.f; } }
        }
    }
}

#if DBG
struct Ck { float num, den; };
__device__ __forceinline__ float f8tof(unsigned char b) { const int s = b >> 7, e = (b >> 3) & 15, m = b & 7; float v = (e == 0) ? (float)m * 0.001953125f : (1.f + (float)m * 0.125f) * exp2f((float)(e - 7)); return s ? -v : v; }
__device__ __forceinline__ unsigned hsh(unsigned x) { x ^= x >> 16; x *= 0x7feb352dU; x ^= x >> 15; x *= 0x846ca68bU; x ^= x >> 16; return x; }
__device__ __forceinline__ void ck_acc(Ck& c, float got, float ref) { const float d = got - ref; c.num += (d == d && fabsf(d) < 1e18f) ? d * d : 1e30f; c.den += ref * ref; }
__device__ __forceinline__ void ck_flush(Frame& F, int stage, Ck c) { const float n = wave_sum(c.num), d = wave_sum(c.den);
    if (F.lane == 0) { atomicAdd((float*)(F.ctl + CW_CHK) + stage * 2, n); atomicAdd((float*)(F.ctl + CW_CHK) + stage * 2 + 1, d); } }
__device__ __forceinline__ float rs_naive(const bf16* X, int t) { float s = 0.f; for (int k = 0; k < D; ++k) { const float v = bf2f(X[(size_t)t * D + k]); s += v * v; } return rsqrtf(s * (1.f / D) + EPS); }
__device__ __forceinline__ float dotx(const bf16* X, int t, const float* gk, const float* W, int ldw, int wc) { float s = 0.f; for (int k = 0; k < D; ++k) s += bf2f(X[(size_t)t * D + k]) * gk[k] * W[(size_t)k * ldw + wc]; return s; }
__device__ __forceinline__ void sc_acc(int pos, float invf, float& sn, float& cs) { double rv = (double)pos * (double)invf * 0.15915494309189535; rv -= floor(rv); sn = __builtin_amdgcn_sinf((float)rv); cs = __builtin_amdgcn_cosf((float)rv); }
#define CK_LOOP(NS) for (unsigned s_ = (unsigned)(F.bid * NTHR + F.tid); s_ < (unsigned)(NS); s_ += (unsigned)(F.G * NTHR))

__device__ __forceinline__ void ck_proj(Frame& F, const Args& A, int stage, int mode, int i, int j) {
    Ck c = {0.f, 0.f}; const bf16* X = (const bf16*)(F.ws + WS_XB);
    CK_LOOP(4096) { const unsigned h1 = hsh(s_ * 2u + 1u + 977u * (unsigned)stage), h2 = hsh(h1 + 12345u); const int t = (int)(h1 % T); float got, ref;
        const float rs = rs_naive(X, t); const int pos = A.pos[t];
        if (mode == 1) { const int cn = (int)(h2 % 4096); const float* W = A.ev_w_in + (size_t)j * D * 3584; const float* g = A.mix_g + i * D; got = bf2f(((const bf16*)(F.ws + WS_ACT + A_PE))[(size_t)t * PEW + cn]);
            if (cn < 1536) ref = rs * dotx(X, t, g, W, 3584, cn);
            else if (cn >= 2560 && cn < 3072) ref = rs * dotx(X, t, g, W, 3584, cn + 512);
            else { const bool bcopy = cn >= 3072; const int cf_ = bcopy ? cn - 1536 : cn; const int base = cf_ & ~63, cp = cf_ & 63, gg = cp >> 3, s = cp & 7, jj = 4 * gg + (s & 3);
                const float x1 = rs * dotx(X, t, g, W, 3584, base + jj), x2 = rs * dotx(X, t, g, W, 3584, base + 32 + jj); float sn, cs; sc_acc(pos, exp2f(-(float)jj * (13.287712379549449f / 32.f)), sn, cs);
                const bool isk = cf_ >= 2048; const int head = (cf_ & 511) >> 6, l = t & (SL - 1), lm = isk ? (l & 63) : (l & 31);
                const float lgf = -__expf(A.ev_df[j * 8 + head]), lgb = -__expf(A.ev_db[j * 8 + head]);
                const float dec = bcopy ? __expf(lgb * (float)(isk ? lm : -lm)) : __expf(lgf * (float)(isk ? -lm : lm));
                ref = ((s < 4) ? x1 * cs - x2 * sn : x1 * sn + x2 * cs) * (isk ? 0.125f : 1.f) * dec; } }
        else if (mode == 2) { const int cn = (int)(h2 % 2048); const float* W = A.od_w_in + (size_t)j * D * 3072; const float* g = A.mix_g + i * D; got = bf2f(((const bf16*)(F.ws + WS_ACT + A_QK))[(size_t)t * QKP + cn]);
            const int base = cn & ~63, cp = cn & 63; const float sc = (cn < 1024) ? 0.125f * LOG2E : 1.f;
            if (cp < 16) { const int gg = cp >> 3, s = cp & 7, jj = 4 * gg + (s & 3);
                const float x1 = rs * dotx(X, t, g, W, 3072, base + jj), x2 = rs * dotx(X, t, g, W, 3072, base + 8 + jj); float sn, cs; sc_acc(pos, exp2f(-(float)jj * (18.931568569324174f / 8.f)), sn, cs);
                ref = ((s < 4) ? x1 * cs - x2 * sn : x1 * sn + x2 * cs) * sc; }
            else ref = rs * dotx(X, t, g, W, 3072, cn) * sc; }
        else if (mode == 3) { const int cn = (int)(h2 % 1024); got = bf2f(((const bf16*)(F.ws + WS_ACT + A_QX))[(size_t)t * 1024 + cn]);
            ref = rs * dotx(X, t, A.xa_g + i * D, A.xa_wq + (size_t)i * D * D, D, cn) * (LOG2E / 16.f); }
        else { const int cn = (int)(h2 % FF); got = f8tof((F.ws + WS_ACT + A_H)[(size_t)t * FF + cn]) * (1.f / MOE_HSCALE); const float* g = A.ffn_g + i * D;
            const float a = rs * dotx(X, t, g, A.ffd_g + (size_t)j * D * FF, FF, cn), b = rs * dotx(X, t, g, A.ffd_u + (size_t)j * D * FF, FF, cn); ref = a / (1.f + __expf(-a)) * b; }
        ck_acc(c, got, ref); }
    ck_flush(F, stage, c);
}
__device__ __forceinline__ void ck_swapped(Frame& F, const Args& A, int stage, int mode, int i, int j) {
    Ck c = {0.f, 0.f}; const bf16* X = (const bf16*)(F.ws + WS_XB);
    CK_LOOP(4096) { const unsigned h1 = hsh(s_ * 2u + 7u + 977u * (unsigned)stage), h2 = hsh(h1 + 999u); const int t = (int)(h1 % T), R = (int)(h2 % 1024);
        const float rs = rs_naive(X, t); const float* g = A.mix_g + i * D;
        if (mode == 0) { const float ref = rs * dotx(X, t, g, A.od_w_in + (size_t)j * D * 3072, 3072, 2048 + R); ck_acc(c, bf2f(((const bf16*)(F.ws + WS_ACT + A_VTD))[(size_t)R * VTP + t]), ref); }
        else { const float* W = A.ev_w_in + (size_t)j * D * 3584; const int Rv = R & 511;
            const float ref = rs * dotx(X, t, g, W, 3584, 2560 + Rv); ck_acc(c, bf2f(((const bf16*)(F.ws + WS_ACT + A_VTE))[(size_t)Rv * T + t]), ref); } }
    ck_flush(F, stage, c);
}
__device__ __forceinline__ void ck_res(Frame& F, const Args& A, int stage, const bf16* act, int K, const float* W, const bf16* xprev, bool f8act = false) {
    Ck c = {0.f, 0.f}, c2 = {0.f, 0.f};
    CK_LOOP(4096) { const unsigned h1 = hsh(s_ * 2u + 3u + 977u * (unsigned)stage), h2 = hsh(h1 + 4242u); const int t = (int)(h1 % T), cn = (int)(h2 % D);
        float s = 0.f; for (int k = 0; k < K; ++k) s += (f8act ? f8tof(((const unsigned char*)act)[(size_t)t * K + k]) * (1.f / MOE_HSCALE) : bf2f(act[(size_t)t * K + k])) * W[(size_t)k * D + cn];
        const float ref = bf2f(xprev[(size_t)t * D + cn]) + s, got = bf2f(((const bf16*)(F.ws + WS_XB))[(size_t)t * D + cn]); ck_acc(c, got, ref);
        float ss = 0.f; for (int k = 0; k < D; ++k) { const float v = bf2f(((const bf16*)(F.ws + WS_XB))[(size_t)t * D + k]); ss += v * v; }
        float sp = 0.f; for (int k = 0; k < 16; ++k) sp += ((const float*)(F.ws + WS_SSQ))[(size_t)t * 16 + k];
        ck_acc(c2, sp, ss); }
    ck_flush(F, stage, c); ck_flush(F, stage + 1, c2);
}
__device__ __forceinline__ void ck_memkv(Frame& F, const Args& A, int stage) {
    Ck c = {0.f, 0.f};
    CK_LOOP(4096) { const unsigned h1 = hsh(s_ * 2u + 5u), h2 = hsh(h1 + 77u); const int r = (int)(h1 % MT), cn = (int)(h2 % 4096), l = cn >> 10, n = cn & 1023; const int which = (int)((h2 >> 16) & 1);
        float ss = 0.f; for (int k = 0; k < D; ++k) { const float v = A.mem[(size_t)r * D + k]; ss += v * v; } const float rs = rsqrtf(ss * (1.f / D) + EPS);
        float s = 0.f; for (int k = 0; k < D; ++k) s += A.mem[(size_t)r * D + k] * rs * A.mem_g[k] * A.xa_wkv[((size_t)l * D + k) * 2 * D + which * D + n];
        const float got = which ? bf2f(((const bf16*)(F.ws + WS_VTX))[(size_t)cn * 4096 + r]) : bf2f(((const bf16*)(F.ws + WS_KX))[(size_t)r * 4096 + cn]);
        ck_acc(c, got, s); }
    ck_flush(F, stage, c);
}
__device__ __forceinline__ void ck_xattn(Frame& F, const Args& A, int stage, int l) {
    Ck c = {0.f, 0.f}; const bf16* Q = (const bf16*)(F.ws + WS_ACT + A_QX); const bf16* KX = (const bf16*)(F.ws + WS_KX); const bf16* VTX = (const bf16*)(F.ws + WS_VTX);
    CK_LOOP(2048) { const unsigned h1 = hsh(s_ * 2u + 9u + 977u * (unsigned)stage), h2 = hsh(h1 + 31u); const int t = (int)(h1 % T), cn = (int)(h2 % D), hd = cn >> 8, b = t >> 11;
        float m = -3e38f, lsum = 0.f, o = 0.f;
        for (int mm = 0; mm < 256; ++mm) { float s = 0.f; for (int d = 0; d < 256; ++d) s += bf2f(Q[(size_t)t * D + hd * 256 + d]) * bf2f(KX[(size_t)(b * 256 + mm) * 4096 + l * 1024 + hd * 256 + d]);
            const float mn = fmaxf(m, s), al = exp2f(m - mn), p = exp2f(s - mn); lsum = lsum * al + p; o = o * al + p * bf2f(VTX[(size_t)(l * 1024 + cn) * 4096 + b * 256 + mm]); m = mn; }
        ck_acc(c, bf2f(((const bf16*)(F.ws + WS_ACT + A_OX))[(size_t)t * D + cn]), o / lsum); }
    ck_flush(F, stage, c);
}
__device__ __forceinline__ void ck_dattn(Frame& F, const Args& A, int stage, int j, float lambda_init) {
    Ck c = {0.f, 0.f}; const bf16* QK = (const bf16*)(F.ws + WS_ACT + A_QK); const bf16* VT = (const bf16*)(F.ws + WS_ACT + A_VTD); const bf16* AO = (const bf16*)(F.ws + WS_ACT + A_AO);
    LAS float* sc = (LAS float*)(F.lds) + F.wave * 4096;
    float lam; { float s1 = 0.f, s2 = 0.f; for (int e = 0; e < 64; ++e) { s1 += A.lq1[j * 64 + e] * A.lk1[j * 64 + e]; s2 += A.lq2[j * 64 + e] * A.lk2[j * 64 + e]; } lam = __expf(s1) - __expf(s2) + lambda_init; }
    const int gw = F.bid * NWAVES + F.wave;
    for (int smp = gw; smp < 512; smp += F.G * NWAVES) { const unsigned h1 = hsh((unsigned)smp * 2u + 11u + 977u * (unsigned)stage); const int t = (int)(h1 % T), h = (int)((h1 >> 20) & 7), b = t >> 11; const size_t kb = (size_t)b * SL;
        float mx[2] = {-3e38f, -3e38f};
        for (int kk = 0; kk < 32; ++kk) { const int key = F.lane + 64 * kk;
#pragma unroll
            for (int mp = 0; mp < 2; ++mp) { float s = 0.f; for (int d = 0; d < 64; ++d) s += bf2f(QK[(size_t)t * QKP + (2 * h + mp) * 64 + d]) * bf2f(QK[(kb + key) * QKP + 1024 + (2 * h + mp) * 64 + d]);
                sc[mp * 2048 + key] = s; mx[mp] = fmaxf(mx[mp], s); } }
        LDS_WAIT(); const float m0 = wave_max(mx[0]), m1 = wave_max(mx[1]); float l0 = 0.f, l1 = 0.f;
        for (int kk = 0; kk < 32; ++kk) { const int key = F.lane + 64 * kk; const float p0 = exp2f(sc[key] - m0), p1 = exp2f(sc[2048 + key] - m1); sc[key] = p0; sc[2048 + key] = p1; l0 += p0; l1 += p1; }
        LDS_WAIT(); l0 = wave_sum(l0); l1 = wave_sum(l1);
        float v[2], ss = 0.f;
#pragma unroll
        for (int e = 0; e < 2; ++e) { const int dv = F.lane + 64 * e; float o0 = 0.f, o1 = 0.f;
            for (int key = 0; key < 2048; ++key) { const float vv = bf2f(VT[(size_t)(h * 128 + dv) * VTP + kb + key]); o0 += sc[key] * vv; o1 += sc[2048 + key] * vv; }
            v[e] = o0 / l0 - lam * o1 / l1; ss += v[e] * v[e]; }
        ss = wave_sum(ss); const float rms = rsqrtf(ss * (1.f / 128.f) + EPS) * (1.f - lambda_init);
#pragma unroll
        for (int e = 0; e < 2; ++e) { const int dv = F.lane + 64 * e; ck_acc(c, bf2f(AO[(size_t)t * D + h * 128 + dv]), v[e] * rms * A.od_gn[j * 1024 + h * 128 + dv]); }
        LDS_WAIT(); }
    ck_flush(F, stage, c);
}
__device__ __forceinline__ void ck_ret(Frame& F, const Args& A, int stage, int j) {
    Ck c = {0.f, 0.f}, c2 = {0.f, 0.f}; const bf16* PE = (const bf16*)(F.ws + WS_ACT + A_PE); const bf16* VT = (const bf16*)(F.ws + WS_ACT + A_VTE); const bf16* R = (const bf16*)(F.ws + WS_ACT + A_R);
    LAS float* sc = (LAS float*)(F.lds) + F.wave * 2048;
    const int gw = F.bid * NWAVES + F.wave;
    for (int smp = gw; smp < 1024; smp += F.G * NWAVES) { const unsigned h1 = hsh((unsigned)smp * 2u + 13u + 977u * (unsigned)stage); const int t = (int)(h1 % T), h = (int)((h1 >> 20) & 7), b = t >> 11, n = t & (SL - 1); const size_t kb = (size_t)b * SL;
        const float lgf = -__expf(A.ev_df[j * 8 + h]), lgb = -__expf(A.ev_db[j * 8 + h]);
        for (int kk = 0; kk < 32; ++kk) { const int m = F.lane + 64 * kk; float s = 0.f; for (int d = 0; d < 64; ++d) s += bf2f(PE[(size_t)t * PEW + 1536 + h * 64 + d]) * bf2f(PE[(kb + m) * PEW + 2048 + h * 64 + d]);
            s *= __expf(-lgf * (float)(n & 31)) * __expf(lgf * (float)(m & 63));
            sc[m] = s * ((m <= n) ? __expf(lgf * (float)(n - m)) : __expf(lgb * (float)(m - n))); }
        LDS_WAIT(); const int dv = F.lane; float o = 0.f; for (int m = 0; m < 2048; ++m) o += sc[m] * bf2f(VT[(size_t)(h * 64 + dv) * T + kb + m]);
        const float ss = wave_sum(o * o), rms = rsqrtf(ss * (1.f / 64.f) + EPS); const float g = bf2f(PE[(size_t)t * PEW + 2560 + h * 64 + dv]);
        ck_acc(c, bf2f(R[(size_t)t * D + 512 + h * 64 + dv]), o * rms * A.ev_gn[j * 512 + h * 64 + dv] * g / (1.f + __expf(-g)));
        LDS_WAIT(); }
    CK_LOOP(4096) { const unsigned h1 = hsh(s_ * 2u + 15u + 977u * (unsigned)stage), h2 = hsh(h1 + 5u); const int t = (int)(h1 % T), cc = (int)(h2 % 512), l = t & (SL - 1); const float* cw = A.ev_conv + (size_t)j * 1536;
        float acc = 0.f; for (int d = 0; d < 3; ++d) { const int tt = t + d - 1; const bool ok = (d == 0) ? (l > 0) : (d == 2) ? (l < SL - 1) : true;
            if (ok) acc += cw[d * 512 + cc] * bf2f(PE[(size_t)tt * PEW + 512 + cc]) * bf2f(PE[(size_t)tt * PEW + 1024 + cc]); }
        ck_acc(c2, bf2f(R[(size_t)t * D + cc]), acc * bf2f(PE[(size_t)t * PEW + cc])); }
    ck_flush(F, stage, c); ck_flush(F, stage + 1, c2);
}
__device__ __forceinline__ void ck_route(Frame& F, const Args& A, int stage, int i, int j) {
    Ck c = {0.f, 0.f}, c2 = {0.f, 0.f}; const bf16* X = (const bf16*)(F.ws + WS_XB); TileBase B; load_tilebase(F, j, B);
    const int* epos = (const int*)(F.ws + WS_MISC + MISC_EPOS); const float* gate = (const float*)(F.ws + WS_MISC + MISC_GATE); const int* yrow = (const int*)(F.ws + WS_MISC + MISC_YROW);
    CK_LOOP(2048) { const unsigned h1 = hsh(s_ * 2u + 17u + 977u * (unsigned)stage); const int t = (int)(h1 % T); const float rs = rs_naive(X, t);
        float lg[8];
#pragma unroll
        for (int e = 0; e < 8; ++e) lg[e] = rs * dotx(X, t, A.ffn_g + i * D, A.router + (size_t)j * D * NE, NE, e);
        int i1 = 0; float m1 = lg[0];
#pragma unroll
        for (int e = 1; e < 8; ++e) if (lg[e] > m1) { m1 = lg[e]; i1 = e; }
        int i2 = -1; float m2 = -3e38f;
#pragma unroll
        for (int e = 0; e < 8; ++e) if (e != i1 && lg[e] > m2) { m2 = lg[e]; i2 = e; }
        const float w1 = 1.f / (1.f + __expf(m2 - m1));
        const int e0 = epos[2 * t] >> 20, e1 = epos[2 * t + 1] >> 20;
        ck_acc(c, (e0 == i1 && e1 == i2) ? 1.f : 0.f, 1.f); ck_acc(c, gate[2 * t], w1); ck_acc(c, gate[2 * t + 1], 1.f - w1);
        const int r0 = yrow[2 * t]; int tbe = 0;
#pragma unroll
        for (int k = 0; k < 8; ++k) if (k == e0) tbe = B.tb[k];
        ck_acc(c2, (float)r0, (float)(tbe * 256 + (epos[2 * t] & 0xfffff)));
        const int cc = (int)(hsh(h1) % D); ck_acc(c2, f8tof((F.ws + WS_ACT + A_XS)[(size_t)r0 * D + cc]) + 8.f, bf2f(((const bf16*)(F.ws + WS_XB))[(size_t)t * D + cc]) * rs + 8.f); }
    ck_flush(F, stage, c); ck_flush(F, stage + 1, c2);
}
__device__ __forceinline__ void ck_moe(Frame& F, const Args& A, int stage, int which, int i, int j, int lo, int hi) {
    Ck c = {0.f, 0.f}; const bf16* X = (const bf16*)(F.ws + WS_XB); const int* epos = (const int*)(F.ws + WS_MISC + MISC_EPOS); const int* yrow = (const int*)(F.ws + WS_MISC + MISC_YROW);
    const unsigned char* HID = F.ws + WS_ACT + A_HID; const bf16* Y = (const bf16*)(F.ws + WS_ACT + A_Y);
    CK_LOOP(4096) { const unsigned h1 = hsh(s_ * 2u + 19u + 977u * (unsigned)stage), h2 = hsh(h1 + 3u); const int tk = (int)(h1 % (2 * T)), t = tk >> 1, e = epos[tk] >> 20, r = yrow[tk];
        if (r < lo * 256 || r >= hi * 256) continue;
        const size_t wo = ((size_t)j * NE + e) * (size_t)D * FE;
        if (which == 0) { const int cc = (int)(h2 % FE); const float rs = rs_naive(X, t); const float a = rs * dotx(X, t, A.ffn_g + i * D, A.moe_g + wo, FE, cc), b = rs * dotx(X, t, A.ffn_g + i * D, A.moe_u + wo, FE, cc);
            ck_acc(c, f8tof(HID[(size_t)(r - lo * 256) * FE + cc]) * (1.f / MOE_HSCALE), a / (1.f + __expf(-a)) * b); }
        else { const int cc = (int)(h2 % D); float s = 0.f; for (int k = 0; k < FE; ++k) s += f8tof(HID[(size_t)(r - lo * 256) * FE + k]) * (1.f / MOE_HSCALE) * A.moe_d[wo + (size_t)k * D + cc];
            ck_acc(c, bf2f(Y[(size_t)r * D + cc]), s); } }
    ck_flush(F, stage, c);
}
__device__ __forceinline__ void ck_comb(Frame& F, const Args& A, int stage, const bf16* xprev, bool last) {
    Ck c = {0.f, 0.f}; const bf16* Y = (const bf16*)(F.ws + WS_ACT + A_Y); const int* yrow = (const int*)(F.ws + WS_MISC + MISC_YROW); const float* gate = (const float*)(F.ws + WS_MISC + MISC_GATE);
    CK_LOOP(2048) { const unsigned h1 = hsh(s_ * 2u + 23u + 977u * (unsigned)stage), h2 = hsh(h1 + 1u); const int t = (int)(h1 % T), cc = (int)(h2 % D); const int r0 = yrow[2 * t], r1 = yrow[2 * t + 1]; const float g0 = gate[2 * t], g1 = gate[2 * t + 1];
        float ss = 0.f, vc = 0.f; for (int k = 0; k < D; ++k) { const float v = bf2f(xprev[(size_t)t * D + k]) + g0 * bf2f(Y[(size_t)r0 * D + k]) + g1 * bf2f(Y[(size_t)r1 * D + k]); ss += v * v; if (k == cc) vc = v; }
        const float ref = last ? vc * rsqrtf(ss * (1.f / D) + EPS) * A.fin_g[cc] : vc; ck_acc(c, last ? A.out[(size_t)t * D + cc] : bf2f(((const bf16*)(F.ws + WS_XB))[(size_t)t * D + cc]), ref); }
    ck_flush(F, stage, c);
}
__device__ __forceinline__ void copy_x(Frame& F, const Args& A, float* dst) {
    for (size_t it = (size_t)F.bid * NTHR + F.tid; it < (size_t)T * D / 4; it += (size_t)F.G * NTHR) ((f32x4*)dst)[it] = ((const f32x4*)A.out)[it];
}
#endif

enum { PH_PRO = 0, PH_MEMKV, PH_E1, PH_RETKV, PH_RETSCAN, PH_RETOUT, PH_D1, PH_DATTN, PH_OUTRES, PH_X1, PH_XATTN, PH_X3, PH_F1, PH_F2, PH_ROUTER, PH_GATHER, PH_M1, PH_M2, PH_COMB, PH_COUNT };
#define XB ((bf16*)(F.ws + WS_XB))
#define SSQ ((float*)(F.ws + WS_SSQ))
#define ACT (F.ws + WS_ACT)
__device__ __forceinline__ float lambda_init_of(int i) { return 0.8f - 0.6f * __expf(-0.3f * (float)i); }
template <int PH> __device__ __forceinline__ void run_phase(Frame& F, const Args& A, int i, int half, int vcu) {
    const int j = i >> 1; PG8_LAS unsigned char* const ring = (PG8_LAS unsigned char*)F.lds;
    if constexpr (PH == PH_PRO) { prologue_phase(F, A); moe_convert(F, A, 0); moe_convert(F, A, 1); }
    if constexpr (PH == PH_MEMKV) {
        { pg8::Gemm g{(const bf16*)(F.ws + WS_MEMN), (const bf16*)(F.ws + WS_WK), MT, 4096, D}; pg8::StaticOrder S; S.init(MT, 4096, F.G, F.bid);
          pg8::EpiRow<0> E{(bf16*)(F.ws + WS_KX), 4096, nullptr, nullptr, 1.f}; pg8::gemm_phase<pg8::EpiRow<0>, pg8::StaticOrder, true, true>(ring, g, S, E, F.tid); }
        { pg8::Gemm g{(const bf16*)(F.ws + WS_WV), (const bf16*)(F.ws + WS_MEMN), 4096, MT, D}; pg8::StaticOrder S; S.init(4096, MT, F.G, F.bid);
          pg8::EpiRow<0> E{(bf16*)(F.ws + WS_VTX), 4096, nullptr, nullptr, 1.f}; pg8::gemm_phase<pg8::EpiRow<0>, pg8::StaticOrder, true, true>(ring, g, S, E, F.tid); }
    }
    if constexpr (PH == PH_E1) { unsigned char* eb = F.ws + WS_EV + j * EV_STRIDE;
        { pg8::Gemm g{XB, (const bf16*)(eb + EV_INN), T, 3072, D}; pg8::StaticOrder S; S.init(T, 3072, F.G, F.bid);
          pg8::EpiRow<1> E{(bf16*)(ACT + A_PE), PEW, SSQ, A.pos, 1.f, A.ev_df + j * 8, A.ev_db + j * 8}; pg8::gemm_phase<pg8::EpiRow<1>, pg8::StaticOrder, true, true>(ring, g, S, E, F.tid); }
        { pg8::Gemm g{(const bf16*)(eb + EV_INS), XB, 512, T, D}; pg8::StaticOrder S; S.init(512, T, F.G, F.bid);
          pg8::EpiCol<0> E{(bf16*)(ACT + A_VTE), nullptr, nullptr, (size_t)T, SSQ, nullptr, nullptr, nullptr};
          pg8::gemm_phase<pg8::EpiCol<0>, pg8::StaticOrder, true, true>(ring, g, S, E, F.tid); }
    }
    if constexpr (PH == PH_RETKV) { Frame P = F; P.bid = vcu; fret_phase(P, A, j); }
    if constexpr (PH == PH_D1) { unsigned char* ob = F.ws + WS_OD + j * OD_STRIDE;
        { pg8::Gemm g{XB, (const bf16*)(ob + OD_INN), T, 2048, D}; pg8::StaticOrder S; S.init(T, 2048, F.G, F.bid);
          pg8::EpiRow<2> E{(bf16*)(ACT + A_QK), QKP, SSQ, A.pos, 1.f}; pg8::gemm_phase<pg8::EpiRow<2>, pg8::StaticOrder, true, true>(ring, g, S, E, F.tid); }
        { pg8::Gemm g{(const bf16*)(ob + OD_INS), XB, 1024, T, D}; pg8::StaticOrder S; S.init(1024, T, F.G, F.bid);
          pg8::EpiCol<0> E{(bf16*)(ACT + A_VTD), nullptr, nullptr, (size_t)VTP, SSQ, nullptr, nullptr, nullptr};
          pg8::gemm_phase<pg8::EpiCol<0>, pg8::StaticOrder, true, true>(ring, g, S, E, F.tid); }
    }
    if constexpr (PH == PH_DATTN) { Frame P = F; P.bid = vcu; dattn_phase(P, A, j, lambda_init_of(i)); }
    if constexpr (PH == PH_OUTRES) {
        const bf16* mixA = (i & 1) ? (const bf16*)(ACT + A_AO) : (const bf16*)(ACT + A_R);
        const bf16* mixB = (i & 1) ? (const bf16*)(F.ws + WS_OD + j * OD_STRIDE + OD_OUT) : (const bf16*)(F.ws + WS_EV + j * EV_STRIDE + EV_OUT);
        pg8::Gemm g{mixA, mixB, T, D, D}; pg8::StaticOrder S; S.init(T, D, F.G, F.bid);
        if (half) { pg8::EpiRes E{(bf16*)(ACT + 256 * MiB), (float*)(ACT + 320 * MiB), 1.f}; pg8::gemm_phase<pg8::EpiRes, pg8::StaticOrder, true, true>(ring, g, S, E, F.tid); }
        else { typedef pg8::EpiResT<(long long)(WS_ACT + A_XB8) - (long long)WS_XB> EpiRes8; EpiRes8 E{XB, SSQ, 1.f}; pg8::gemm_phase<EpiRes8, pg8::StaticOrder, true, true>(ring, g, S, E, F.tid); }
    }
    if constexpr (PH == PH_X1) { pg8::Gemm g{(const bf16*)(ACT + A_XB8), (const bf16*)(F.ws + WS_WQ + (size_t)i * D * D), T, D, D / 2}; pg8::StaticOrder S; S.init(T, D, F.G, F.bid);
        pg8::EpiRow<0> E{(bf16*)(ACT + A_QX), 1024, SSQ, nullptr, LOG2E / 16.f / MOE_WSCALE}; pg8::gemm_phase<pg8::EpiRow<0>, pg8::StaticOrder, true, true, true>(ring, g, S, E, F.tid); }
    if constexpr (PH == PH_XATTN) { Frame P = F; P.bid = vcu; xattn_phase(P, i); }
    if constexpr (PH == PH_X3) { pg8::Gemm g{(const bf16*)(ACT + A_OX), (const bf16*)(F.ws + WS_WO + (size_t)i * D * D), T, D, D / 2};
        pg8::StaticOrder S; S.init(T, D, F.G, F.bid); if (half) { pg8::EpiRes E{(bf16*)(ACT + 256 * MiB), (float*)(ACT + 320 * MiB), 1.f / (MOE_WSCALE * 4.f)}; pg8::gemm_phase<pg8::EpiRes, pg8::StaticOrder, true, true, true>(ring, g, S, E, F.tid); }
        else if (i & 1) { pg8::EpiRes E{XB, SSQ, 1.f / (MOE_WSCALE * 4.f)}; pg8::gemm_phase<pg8::EpiRes, pg8::StaticOrder, true, true, true>(ring, g, S, E, F.tid); }
        else { typedef pg8::EpiResT<(long long)(WS_ACT + A_XB8) - (long long)WS_XB> EpiRes8; EpiRes8 E{XB, SSQ, 1.f / (MOE_WSCALE * 4.f)}; pg8::gemm_phase<EpiRes8, pg8::StaticOrder, true, true, true>(ring, g, S, E, F.tid); } }
    if constexpr (PH == PH_F1) { pg8::Gemm g{(const bf16*)(ACT + A_XB8), (const bf16*)(F.ws + WS_EV + j * EV_STRIDE + EV_GU), T, 2 * FF, D / 2}; pg8::StaticOrder S; S.init(T, 2 * FF, F.G, F.bid);
        pg8::EpiSwiT<true> E{(void*)(ACT + A_H), FF, SSQ, 22, 1.f / MOE_WSCALE, MOE_HSCALE}; pg8::gemm_phase<pg8::EpiSwiT<true>, pg8::StaticOrder, true, true, true>(ring, g, S, E, F.tid); }
    if constexpr (PH == PH_F2) { pg8::Gemm g{(const bf16*)(ACT + A_H), (const bf16*)(F.ws + WS_EV + j * EV_STRIDE + EV_DN), T, D, FF / 2}; pg8::StaticOrder S; S.init(T, D, F.G, F.bid);
        pg8::EpiRes E{half ? (bf16*)(ACT + 304 * MiB) : XB, half ? (float*)(ACT + 368 * MiB) : SSQ, 1.f / (MOE_WSCALE * MOE_HSCALE)}; pg8::gemm_phase<pg8::EpiRes, pg8::StaticOrder, true, true, true>(ring, g, S, E, F.tid); }
    if constexpr (PH == PH_ROUTER) router_phase(F, A, i, j, j + 2 * half);
    if constexpr (PH == PH_GATHER) gather_phase(F, j);
    if constexpr (PH == PH_M1 || PH == PH_M2) {
        pg8::MoeOrder S; TileBase B; load_tilebase(F, j, B);
#pragma unroll
        for (int k = 0; k < 9; ++k) S.tb[k] = B.tb[k];
        S.nM = B.tb[8]; S.G = F.G; S.c = F.bid; S.lo = 0;
        if constexpr (PH == PH_M1) { S.nN = 28; S.nwg = S.nM * 28;
            pg8::Gemm g{(const bf16*)(ACT + A_XS), (const bf16*)(F.ws + WS_MOE + (size_t)j * MOE_STRIDE), 0, 0, D / 2};
            pg8::EpiSwiT<true> E{(void*)(ACT + A_HID), FE, nullptr, 28, 1.f / MOE_WSCALE, MOE_HSCALE};
            pg8::gemm_phase<pg8::EpiSwiT<true>, pg8::MoeOrder, true, true, true>(ring, g, S, E, F.tid); }
        else { S.nN = 4; S.nwg = S.nM * 4;
            pg8::Gemm g{(const bf16*)(ACT + A_HID), (const bf16*)(F.ws + WS_MOE + (size_t)j * MOE_STRIDE + MOE_DN), 0, 0, FE / 2};
            pg8::EpiY E{(bf16*)(ACT + A_Y), 1024, 4, 1.f / (MOE_WSCALE * MOE_HSCALE)};
            pg8::gemm_phase<pg8::EpiY, pg8::MoeOrder, true, true, true>(ring, g, S, E, F.tid); }
    }
    if constexpr (PH == PH_COMB) combine_phase(F, A, i == 3, half);
}
__device__ __forceinline__ void make_frame(Frame& F, const Args& A, unsigned char* lds_raw, int& vcu) {
    F.lds = (LAS unsigned char*)lds_raw; F.tid = threadIdx.x; F.lane = F.tid & 63; F.wave = __builtin_amdgcn_readfirstlane(F.tid >> 6);
    F.G = gridDim.x; F.bid = blockIdx.x; F.ws = A.ws; F.ctl = (gu32*)(A.ws + WS_CTL);
    vcu = (F.G % 8 == 0) ? (F.bid % 8) * (F.G / 8) + F.bid / 8 : F.bid;
}


constexpr int NPHASES = 48;
__global__ void __launch_bounds__(NTHR, 2) fwd(Args A_) {
#if defined(__HIP_DEVICE_COMPILE__)
    extern __shared__ __attribute__((aligned(16))) unsigned char lds_raw[];
    typedef const Args __attribute__((address_space(4))) * KArgsP;
    KArgsP ap = (KArgsP)__builtin_amdgcn_kernarg_segment_ptr();
    { LAS unsigned char* lds = (LAS unsigned char*)lds_raw;
      for (int u = threadIdx.x; u < (LDS_BYTES - LDSCTL_OFF) / 4; u += NTHR) ((LAS unsigned*)(lds + LDSCTL_OFF))[u] = 0u; }
    int wave_s = __builtin_amdgcn_readfirstlane((int)threadIdx.x >> 6); asm volatile("" : "+s"(wave_s));
    __syncthreads();
    (void)xcd_barrier_post((unsigned*)(A_.ws + WS_CTL) + CW_BAR, (volatile LAS unsigned*)((LAS unsigned char*)lds_raw + LDSCTL_OFF));
#define RUN(PH, i, half) do { { unsigned lo_ = (unsigned)(unsigned long long)ap, hi_ = (unsigned)((unsigned long long)ap >> 32); asm volatile("" : "+v"(lo_), "+v"(hi_)); \
          ap = (KArgsP)(((unsigned long long)(unsigned)__builtin_amdgcn_readfirstlane((int)hi_) << 32) | (unsigned long long)(unsigned)__builtin_amdgcn_readfirstlane((int)lo_)); } Frame P; int vcu_; const Args AL = *ap; \
        { P.lds = (LAS unsigned char*)lds_raw; unsigned z_ = 0u; asm volatile("" : "+v"(z_)); int t_ = wave_s * 64 + (int)__builtin_amdgcn_mbcnt_hi(~0u, __builtin_amdgcn_mbcnt_lo(~0u, z_)); P.tid = t_; P.lane = t_ & 63; P.wave = __builtin_amdgcn_readfirstlane(t_ >> 6); \
          P.G = gridDim.x; P.bid = blockIdx.x; P.ws = AL.ws; P.ctl = (gu32*)(P.ws + WS_CTL); vcu_ = (P.G % 8 == 0) ? (P.bid % 8) * (P.G / 8) + P.bid / 8 : P.bid; } \
        run_phase<PH>(P, AL, (i), (half), vcu_); } while (0)
#define SEAM() do { XcdBarrier b_; b_.bar = (unsigned*)(ap->ws + WS_CTL) + CW_BAR; b_.x = xb_xcc_id(); b_.st = (volatile LAS unsigned*)((LAS unsigned char*)lds_raw + LDSCTL_OFF); { unsigned zb_ = 0u; asm volatile("" : "+v"(zb_)); b_.t0 = (wave_s == 0) && (__builtin_amdgcn_mbcnt_hi(~0u, __builtin_amdgcn_mbcnt_lo(~0u, zb_)) == 0u); } xcd_barrier(b_); } while (0)
#ifndef DUPMASK
#define DUPMASK 0u
#endif
#define RUNS(PH, i, half) do { if ((DUPMASK >> PH) & 1u) { RUN(PH, i, 1); SEAM(); } RUN(PH, i, 0); SEAM(); } while (0)
    RUNS(PH_PRO, 0, 0); RUN(PH_MEMKV, 0, 0);
    for (int i = 0; i < 4; ++i) {
        if ((i & 1) == 0) { RUNS(PH_E1, i, 0); RUNS(PH_RETKV, i, 0); }
        else { RUNS(PH_D1, i, 0); RUNS(PH_DATTN, i, 0); }
        RUNS(PH_OUTRES, i, 0); RUNS(PH_X1, i, 0); RUNS(PH_XATTN, i, 0); RUNS(PH_X3, i, 0);
        if ((i & 1) == 0) { RUNS(PH_F1, i, 0); RUNS(PH_F2, i, 0); }
        else { RUNS(PH_ROUTER, i, 0); RUNS(PH_GATHER, i, 0);
            RUNS(PH_M1, i, 0); RUNS(PH_M2, i, 0);
            if ((DUPMASK >> PH_COMB) & 1u) { RUN(PH_COMB, i, 1); SEAM(); } RUN(PH_COMB, i, 0); if (i != 3) SEAM(); }
    }
#undef RUN
#undef SEAM
#endif
}
#undef XB
#undef SSQ
#undef ACT
extern "C" void kernel_launch(void* const* d_in, const int* in_sizes, int n_in, void* d_out, int out_size, void* d_ws, size_t ws_size, hipStream_t stream) {
    static int grid = 0;
    if (grid == 0) {
        if (n_in != 31 || out_size != T * D || ws_size < WS_END) { fprintf(stderr, "kernel_launch: unexpected shapes (n_in %d, out %d, ws %zu < %zu)\n", n_in, out_size, ws_size, (size_t)WS_END); grid = -1; return; }
        int dev = 0, cus = 0, per_cu = 0;
        if (hipGetDevice(&dev) != hipSuccess || hipDeviceGetAttribute(&cus, hipDeviceAttributeMultiprocessorCount, dev) != hipSuccess) { grid = -1; return; }
        if (hipFuncSetAttribute((const void*)fwd, hipFuncAttributeMaxDynamicSharedMemorySize, LDS_BYTES) != hipSuccess) { fprintf(stderr, "kernel_launch: hipFuncSetAttribute failed\n"); grid = -1; return; }
        if (hipOccupancyMaxActiveBlocksPerMultiprocessor(&per_cu, (const void*)fwd, NTHR, LDS_BYTES) != hipSuccess || per_cu < 1) fprintf(stderr, "kernel_launch: occupancy query reports %d\n", per_cu);
        (void)hipGetLastError();
        grid = cus;
    }
    if (grid < 0) return;
    if (hipMemsetAsync((char*)d_ws + WS_CTL, 0, CTL_BYTES, stream) != hipSuccess) return;
    Args a{};
    const float** fp = (const float**)&a;
    for (int k = 0; k < 31; ++k) fp[k] = (const float*)d_in[k];
    a.out = (float*)d_out; a.ws = (unsigned char*)d_ws; a.ph_lo = 0; a.ph_hi = NPHASES;
    hipLaunchKernelGGL(fwd, dim3(grid), dim3(NTHR), LDS_BYTES, stream, a);
}
```

```cpp
#include <hip/hip_runtime.h>
#include <cstdio>
#include <cstdint>
#define DBG 0
namespace pg8 {
#define PG8_LAS __attribute__((address_space(3)))
typedef unsigned short bf16_t;
typedef short bf16x8 __attribute__((ext_vector_type(8)));
typedef float f32x4 __attribute__((ext_vector_type(4)));
typedef unsigned u32x4 __attribute__((ext_vector_type(4)));
constexpr int BM = 256, BK = 64, HALF = 128, HTB = HALF * BK * 2  , STAGE_BYTES = 8 * HTB, NXCD = 8, WGM = 8;

__host__ __device__ __forceinline__ int lds_byte(int r, int c) { const int st = (r >> 4) * 2 + (c >> 5), rr = r & 15, cc = c & 31, ob = rr * 64 + cc * 2; return st * 1024 + (ob ^ (((ob >> 9) & 1) << 5)); }
__host__ __device__ __forceinline__ void stage_rc(int b, int& R, int& C) { const int st = b / 1024, sb = b % 1024, swz = sb ^ (((sb >> 9) & 1) << 5); R = (st >> 1) * 16 + swz / 64; C = (st & 1) * 32 + (swz % 64) / 2; }
__host__ __device__ __forceinline__ int perm32(int rho) { const int n = rho >> 4, i = rho & 15; return 8 * (i >> 2) + 4 * n + (i & 3); }

struct Unit { int pm, pn; };
#ifdef GPROBE_ID
__device__ unsigned gp_buf[4];
#endif
struct Gemm { const bf16_t* A; const bf16_t* Bt; int M, N, K; };

struct StaticOrder {
    int nM, nN, nwg, G, c;
    __host__ __device__ void init(int M, int N, int G_, int c_) { nM = M / BM; nN = N / BM; nwg = nM * nN; G = G_; c = c_; }
    __host__ __device__ bool next(int i, Unit& u) const {
        const long L = (long)i * G + c; if (L >= nwg) return false;
        int wgid = (int)L; { const int q = nwg / NXCD, r = nwg % NXCD, xcd = wgid % NXCD, off = wgid / NXCD; wgid = (xcd < r ? xcd * (q + 1) : r * (q + 1) + (xcd - r) * q) + off; }
        const int nig = WGM * nN, gid = wgid / nig, fm = gid * WGM, gsz = (nM - fm) < WGM ? (nM - fm) : WGM;
        u.pm = fm + ((wgid % nig) % gsz); u.pn = (wgid % nig) / gsz; return true;
    }
    __device__ __forceinline__ void a_ready(const Unit&) const {}
    __device__ __forceinline__ void done(const Unit&) const {}
};

typedef float f32x2 __attribute__((ext_vector_type(2)));
typedef int v4i_t __attribute__((ext_vector_type(4)));
typedef int v8i_t __attribute__((ext_vector_type(8)));
__device__ __forceinline__ v8i_t cat8(bf16x8 a, bf16x8 b) { const v4i_t x = __builtin_bit_cast(v4i_t, a), y = __builtin_bit_cast(v4i_t, b); return __builtin_shufflevector(x, y, 0, 1, 2, 3, 4, 5, 6, 7); }
__device__ __forceinline__ unsigned pack_fp8x4(float a, float b, float c, float d) {
    a = fminf(fmaxf(a, -440.f), 440.f); b = fminf(fmaxf(b, -440.f), 440.f); c = fminf(fmaxf(c, -440.f), 440.f); d = fminf(fmaxf(d, -440.f), 440.f);
    int w = 0; w = __builtin_amdgcn_cvt_pk_fp8_f32(a, b, w, false); w = __builtin_amdgcn_cvt_pk_fp8_f32(c, d, w, true); return (unsigned)w; }
__device__ __forceinline__ unsigned cvt_pk_bf16(float lo, float hi) { unsigned r; asm volatile("v_cvt_pk_bf16_f32 %0, %1, %2" : "=v"(r) : "v"(lo), "v"(hi)); return r; }
__device__ __forceinline__ u32x4 pack8(const f32x4 a, const f32x4 b) { u32x4 w; w.x = cvt_pk_bf16(a[0], a[1]); w.y = cvt_pk_bf16(a[2], a[3]); w.z = cvt_pk_bf16(b[0], b[1]); w.w = cvt_pk_bf16(b[2], b[3]); return w; }
constexpr float RMS_EPS = 1e-6f, INV_D = 1.f / 1024.f, INV_2PI = 0.15915494309189535f, LOG2E = 1.4426950408889634f;
constexpr float L2_RET_THETA_32 = 13.287712379549449f / 32.f;
constexpr float L2_ROPE_THETA_8 = 18.931568569324174f / 8.f;
__device__ __forceinline__ float rs_row4(const float* ssq, int row, int fq) {
    const f32x4 p = *(const f32x4*)(ssq + (size_t)row * 16 + 4 * fq);
    float s = (p[0] + p[1]) + (p[2] + p[3]);
    s += __shfl_xor(s, 16); s += __shfl_xor(s, 32);
    return rsqrtf(s * INV_D + RMS_EPS);
}
__device__ __forceinline__ void sincos_rev(float rev, float& sn, float& cs) { rev -= floorf(rev); sn = __builtin_amdgcn_sinf(rev); cs = __builtin_amdgcn_cosf(rev); }

template <int MODE> struct EpiRow {
    static constexpr bool PERM = true, AFTER_DRAIN = false;
    bf16_t* O; int ldc; const float* ssq; const int* pos; float sc; const float* decf; const float* decb;
    __device__ __forceinline__ void operator()(const f32x4 (&acc)[2][2][4][2], const Unit& u, int wr, int wc, int fr, int fq) const {
        const int row0 = u.pm * BM + wr * 64 + fr, col0 = u.pn * BM + wc * 32 + 8 * fq;
        bool rope = false; float cf[4] = {0.f, 0.f, 0.f, 0.f}; float csc = sc;
        float lgf[2] = {0.f, 0.f}, lgb[2] = {0.f, 0.f};
        if (MODE == 1) { rope = (u.pn >= 6 && u.pn < 10); csc = (u.pn == 8 || u.pn == 9) ? 0.125f : 1.f; const int g = (wc & 1) * 4 + fq;
#pragma unroll
            for (int j = 0; j < 4; ++j) cf[j] = __builtin_amdgcn_exp2f(-(float)(4 * g + j) * L2_RET_THETA_32) * INV_2PI;
            if (rope) {
#pragma unroll
                for (int bj = 0; bj < 2; ++bj) { const int head = 4 * (u.pn & 1) + 2 * bj + (wc >> 1); lgf[bj] = -__expf(decf[head]) * LOG2E; lgb[bj] = -__expf(decb[head]) * LOG2E; } } }
        if (MODE == 2) { rope = ((wc & 1) == 0) && (fq < 2); csc = (u.pn < 4) ? 0.125f * LOG2E : 1.f;
#pragma unroll
            for (int j = 0; j < 4; ++j) cf[j] = __builtin_amdgcn_exp2f(-(float)(4 * fq + j) * L2_ROPE_THETA_8) * INV_2PI; }
        float rsv[8], posv[8];
#pragma unroll
        for (int k = 0; k < 8; ++k) { const int row = row0 + (k >> 2) * HALF + (k & 3) * 16; rsv[k] = ssq ? rs_row4(ssq, row, fq) : 1.f; posv[k] = (MODE != 0) ? (float)pos[row] : 0.f; }
#pragma unroll
        for (int k = 0; k < 8; ++k) asm volatile("" : "+v"(rsv[k]), "+v"(posv[k]));
#pragma unroll
        for (int ai = 0; ai < 2; ++ai)
#pragma unroll
            for (int m = 0; m < 4; ++m) { const int row = row0 + ai * HALF + m * 16;
                const float s = rsv[ai * 4 + m] * csc;
                float sn[4], cs[4];
                if (MODE == 2 || (MODE == 1 && rope)) { const float posf = posv[ai * 4 + m];
#pragma unroll
                    for (int j = 0; j < 4; ++j) sincos_rev(posf * cf[j], sn[j], cs[j]); }
                else {
#pragma unroll
                    for (int j = 0; j < 4; ++j) { sn[j] = 0.f; cs[j] = 1.f; } }
#pragma unroll
                for (int bj = 0; bj < 2; ++bj) { f32x4 v0 = acc[ai][bj][m][0] * s, v1 = acc[ai][bj][m][1] * s;
                    if (MODE != 0) { if (rope) {
#pragma unroll
                        for (int j = 0; j < 4; ++j) { const float x1 = v0[j], x2 = v1[j]; v0[j] = x1 * cs[j] - x2 * sn[j]; v1[j] = x1 * sn[j] + x2 * cs[j]; } } }
                    if (MODE == 1 && rope) {
                        const bool isk = u.pn >= 8; const int lm = isk ? (row & 63) : (row & 31);
                        const float ff = __builtin_amdgcn_exp2f(lgf[bj] * (float)(isk ? -lm : lm)), fb = __builtin_amdgcn_exp2f(lgb[bj] * (float)(isk ? lm : -lm));
                        *(u32x4*)(O + (size_t)row * ldc + col0 + bj * HALF) = pack8(v0 * ff, v1 * ff);
                        *(u32x4*)(O + (size_t)row * ldc + col0 + bj * HALF + 1536) = pack8(v0 * fb, v1 * fb); }
                    else *(u32x4*)(O + (size_t)row * ldc + col0 + bj * HALF) = pack8(v0, v1); } }
    }
};

template <int MODE> struct EpiCol {
    static constexpr bool PERM = true, AFTER_DRAIN = false;
    bf16_t* O; bf16_t* KF; bf16_t* KB; size_t ldc; const float* ssq; const int* pos; const float* decf; const float* decb;
    __device__ __forceinline__ float rs_tok(int tok, int fr) const { float p = ssq[(size_t)tok * 16 + fr]; p += __shfl_xor(p, 1); p += __shfl_xor(p, 2); p += __shfl_xor(p, 4); p += __shfl_xor(p, 8); return rsqrtf(p * INV_D + RMS_EPS); }
    __device__ __forceinline__ void operator()(const f32x4 (&acc)[2][2][4][2], const Unit& u, int wr, int wc, int fr, int fq) const {
        const int R0 = u.pm * BM + wr * 64 + fr, tok0 = u.pn * BM + wc * 32 + 8 * fq;
        typedef unsigned u32x2v __attribute__((ext_vector_type(2)));
        float rs16[16];
        if (ssq) { const int tkm = tok0 + (fr >> 3) * HALF + (fr & 7); const f32x4* sp = (const f32x4*)(ssq + (size_t)tkm * 16); const f32x4 s0 = sp[0], s1 = sp[1], s2 = sp[2], s3 = sp[3];
            const float pp = ((s0[0] + s0[1]) + (s0[2] + s0[3])) + ((s1[0] + s1[1]) + (s1[2] + s1[3])) + ((s2[0] + s2[1]) + (s2[2] + s2[3])) + ((s3[0] + s3[1]) + (s3[2] + s3[3]));
            const float myrs = rsqrtf(pp * INV_D + RMS_EPS); const int lb = (fq << 4);
#pragma unroll
            for (int t = 0; t < 16; ++t) rs16[t] = __shfl(myrs, lb + t); }
        else {
#pragma unroll
            for (int t = 0; t < 16; ++t) rs16[t] = 1.f; }
#pragma unroll
        for (int bj = 0; bj < 2; ++bj)
#pragma unroll
            for (int n = 0; n < 2; ++n) { const int tk = tok0 + bj * HALF + 4 * n;
                f32x4 rs;
#pragma unroll
                for (int j = 0; j < 4; ++j) rs[j] = rs16[bj * 8 + n * 4 + j];
                if (MODE == 1 && u.pm < 2) {
                    f32x4 posf;
#pragma unroll
                    for (int j = 0; j < 4; ++j) posf[j] = (float)pos[tk + j];
#pragma unroll
                    for (int mm = 0; mm < 2; ++mm) { const float cfm = __builtin_amdgcn_exp2f(-(float)(16 * mm + fr) * L2_RET_THETA_32) * INV_2PI;
                        f32x4 sn, cs;
#pragma unroll
                        for (int j = 0; j < 4; ++j) { float a, b; sincos_rev(posf[j] * cfm, a, b); sn[j] = a; cs[j] = b; }
#pragma unroll
                        for (int ai = 0; ai < 2; ++ai) { const int head = u.pm * 4 + ai * 2 + wr;
                            const float lgf = -__expf(decf[head]) * LOG2E, lgb = -__expf(decb[head]) * LOG2E;
                            const f32x4 x1 = acc[ai][bj][mm][n] * (rs * 0.125f), x2 = acc[ai][bj][mm + 2][n] * (rs * 0.125f);
                            const f32x4 y1 = x1 * cs - x2 * sn, y2 = x1 * sn + x2 * cs;
                            f32x4 wf, wb;
#pragma unroll
                            for (int j = 0; j < 4; ++j) { const int ci = (tk + j) & 127; wf[j] = __builtin_amdgcn_exp2f(lgf * (float)(127 - ci)); wb[j] = __builtin_amdgcn_exp2f(lgb * (float)ci); }
                            const size_t o1 = (size_t)(R0 + ai * HALF + mm * 16) * ldc + tk, o2 = o1 + (size_t)32 * ldc;
                            f32x4 t; u32x2v w;
                            t = y1 * wf; w.x = cvt_pk_bf16(t[0], t[1]); w.y = cvt_pk_bf16(t[2], t[3]); *(u32x2v*)(KF + o1) = w;
                            t = y2 * wf; w.x = cvt_pk_bf16(t[0], t[1]); w.y = cvt_pk_bf16(t[2], t[3]); *(u32x2v*)(KF + o2) = w;
                            t = y1 * wb; w.x = cvt_pk_bf16(t[0], t[1]); w.y = cvt_pk_bf16(t[2], t[3]); *(u32x2v*)(KB + o1) = w;
                            t = y2 * wb; w.x = cvt_pk_bf16(t[0], t[1]); w.y = cvt_pk_bf16(t[2], t[3]); *(u32x2v*)(KB + o2) = w; } }
                } else {
                    const int Roff = (MODE == 1) ? -512 : 0;
#pragma unroll
                    for (int ai = 0; ai < 2; ++ai)
#pragma unroll
                        for (int m = 0; m < 4; ++m) { const f32x4 t = acc[ai][bj][m][n] * rs; u32x2v w; w.x = cvt_pk_bf16(t[0], t[1]); w.y = cvt_pk_bf16(t[2], t[3]);
                            *(u32x2v*)(O + (size_t)(R0 + Roff + ai * HALF + m * 16) * ldc + tk) = w; }
                } }
    }
};

template <long long X8OFF = 0> struct EpiResT {
    static constexpr bool PERM = true, AFTER_DRAIN = false;
    bf16_t* XB; float* ssq; float sc;
    __device__ __forceinline__ void operator()(const f32x4 (&acc)[2][2][4][2], const Unit& u, int wr, int wc, int fr, int fq) const {
        const int row0 = u.pm * BM + wr * 64 + fr, col0 = u.pn * BM + wc * 32 + 8 * fq;
        u32x4 xv[4][2];
#pragma unroll
        for (int m = 0; m < 4; ++m)
#pragma unroll
            for (int bj = 0; bj < 2; ++bj) xv[m][bj] = *(const u32x4*)(XB + (size_t)(row0 + m * 16) * 1024 + col0 + bj * HALF);
#pragma unroll
        for (int ai = 0; ai < 2; ++ai) {
            float ss[4];
#pragma unroll
            for (int m = 0; m < 4; ++m) { bf16_t* xr = XB + (size_t)(row0 + ai * HALF + m * 16) * 1024 + col0; ss[m] = 0.f;
#pragma unroll
                for (int bj = 0; bj < 2; ++bj) { const u32x4 x = xv[m][bj]; f32x4 a, b;
                    if (ai == 0) xv[m][bj] = *(const u32x4*)(XB + (size_t)(row0 + HALF + m * 16) * 1024 + col0 + bj * HALF);
                    a[0] = __builtin_bit_cast(float, x.x << 16); a[1] = __builtin_bit_cast(float, x.x & 0xffff0000u); a[2] = __builtin_bit_cast(float, x.y << 16); a[3] = __builtin_bit_cast(float, x.y & 0xffff0000u);
                    b[0] = __builtin_bit_cast(float, x.z << 16); b[1] = __builtin_bit_cast(float, x.z & 0xffff0000u); b[2] = __builtin_bit_cast(float, x.w << 16); b[3] = __builtin_bit_cast(float, x.w & 0xffff0000u);
                    a = a + acc[ai][bj][m][0] * sc; b = b + acc[ai][bj][m][1] * sc;
                    const u32x4 w = pack8(a, b); *(u32x4*)(xr + bj * HALF) = w;
                    a[0] = __builtin_bit_cast(float, w.x << 16); a[1] = __builtin_bit_cast(float, w.x & 0xffff0000u); a[2] = __builtin_bit_cast(float, w.y << 16); a[3] = __builtin_bit_cast(float, w.y & 0xffff0000u);
                    b[0] = __builtin_bit_cast(float, w.z << 16); b[1] = __builtin_bit_cast(float, w.z & 0xffff0000u); b[2] = __builtin_bit_cast(float, w.w << 16); b[3] = __builtin_bit_cast(float, w.w & 0xffff0000u);
                    if constexpr (X8OFF != 0) { typedef unsigned u32x2v __attribute__((ext_vector_type(2))); u32x2v o; o.x = pack_fp8x4(a[0], a[1], a[2], a[3]); o.y = pack_fp8x4(b[0], b[1], b[2], b[3]);
                        *(u32x2v*)((unsigned char*)XB + X8OFF + (size_t)(row0 + ai * HALF + m * 16) * 1024 + col0 + bj * HALF) = o; }
                    ss[m] += (a[0] * a[0] + a[1] * a[1]) + (a[2] * a[2] + a[3] * a[3]) + (b[0] * b[0] + b[1] * b[1]) + (b[2] * b[2] + b[3] * b[3]); } }
#pragma unroll
            for (int m = 0; m < 4; ++m) ss[m] += __shfl_xor(ss[m], 16);
#pragma unroll
            for (int m = 0; m < 4; ++m) ss[m] += __shfl_xor(ss[m], 32);
            if (fq == 0) {
#pragma unroll
                for (int m = 0; m < 4; ++m) ssq[(size_t)(row0 + ai * HALF + m * 16) * 16 + u.pn * 4 + wc] = ss[m]; }
        }
    }
};

typedef EpiResT<0> EpiRes;

template <bool F8OUT> struct EpiSwiT {
    static constexpr bool PERM = true, AFTER_DRAIN = false;
    void* O; int ldc; const float* ssq; int nN; float asc, osc;
    __device__ __forceinline__ void operator()(const f32x4 (&acc)[2][2][4][2], const Unit& u, int wr, int wc, int fr, int fq) const {
        const int row0 = u.pm * BM + wr * 64 + fr, col0 = (u.pn % nN) * HALF + wc * 32 + 8 * fq;
        float rsv[8];
#pragma unroll
        for (int k = 0; k < 8; ++k) { const int row = row0 + (k >> 2) * HALF + (k & 3) * 16; rsv[k] = F8OUT ? (ssq ? rs_row4(ssq, row, fq) * asc : asc) : rs_row4(ssq, row, fq); }
        if (ssq) {
#pragma unroll
            for (int k = 0; k < 8; ++k) asm volatile("" : "+v"(rsv[k])); }
        if constexpr (F8OUT) {
            typedef unsigned u32x2v __attribute__((ext_vector_type(2)));
            const int colw = (u.pn % nN) * HALF + wc * 32 + 16 * (fq >> 1);
#pragma unroll
            for (int ai = 0; ai < 2; ++ai)
#pragma unroll
                for (int mp = 0; mp < 2; ++mp) { u32x2v wv[2];
#pragma unroll
                    for (int mm = 0; mm < 2; ++mm) { const int m = 2 * mp + mm; const float rs = rsv[ai * 4 + m], kneg = -rs * LOG2E, c2 = rs * rs * osc; f32x4 h[2];
#pragma unroll
                        for (int n = 0; n < 2; ++n) { const f32x4 a = acc[ai][0][m][n], b = acc[ai][1][m][n]; const f32x4 tt = a * kneg; f32x4 d;
#pragma unroll
                            for (int j = 0; j < 4; ++j) d[j] = __builtin_amdgcn_exp2f(tt[j]);
                            d = d + 1.f;
#pragma unroll
                            for (int j = 0; j < 4; ++j) d[j] = __builtin_amdgcn_rcpf(d[j]);
                            h[n] = ((a * b) * c2) * d; }
                        wv[mm].x = pack_fp8x4(h[0][0], h[0][1], h[0][2], h[0][3]); wv[mm].y = pack_fp8x4(h[1][0], h[1][1], h[1][2], h[1][3]); }
                    const auto rx = __builtin_amdgcn_permlane16_swap(wv[0].x, wv[1].x, false, false); const auto ry = __builtin_amdgcn_permlane16_swap(wv[0].y, wv[1].y, false, false);
                    const int row = row0 + ai * HALF + (2 * mp + (fq & 1)) * 16;
                    *(u32x4*)((unsigned char*)O + (size_t)row * ldc + colw) = (u32x4){rx[0], ry[0], rx[1], ry[1]}; }
        } else {
#pragma unroll
        for (int ai = 0; ai < 2; ++ai)
#pragma unroll
            for (int m = 0; m < 4; ++m) { const int row = row0 + ai * HALF + m * 16;
                const float rs = rsv[ai * 4 + m], kneg = -rs * LOG2E, c2 = rs * rs * (F8OUT ? osc : 1.f);
                f32x4 h[2];
#pragma unroll
                for (int n = 0; n < 2; ++n) { const f32x4 a = acc[ai][0][m][n], b = acc[ai][1][m][n]; const f32x4 t = a * kneg; f32x4 d;
#pragma unroll
                    for (int j = 0; j < 4; ++j) d[j] = __builtin_amdgcn_exp2f(t[j]);
                    d = d + 1.f;
#pragma unroll
                    for (int j = 0; j < 4; ++j) d[j] = __builtin_amdgcn_rcpf(d[j]);
                    h[n] = ((a * b) * c2) * d; }
                if (F8OUT) { typedef unsigned u32x2v __attribute__((ext_vector_type(2))); u32x2v w; w.x = pack_fp8x4(h[0][0], h[0][1], h[0][2], h[0][3]); w.y = pack_fp8x4(h[1][0], h[1][1], h[1][2], h[1][3]);
                    *(u32x2v*)((unsigned char*)O + (size_t)row * ldc + col0) = w; }
                else *(u32x4*)((bf16_t*)O + (size_t)row * ldc + col0) = pack8(h[0], h[1]); }
        }
    }
};
typedef EpiSwiT<false> EpiSwi;

struct EpiY {
    static constexpr bool PERM = true, AFTER_DRAIN = false;
    bf16_t* O; int ldc; int nN; float sc;
    __device__ __forceinline__ void operator()(const f32x4 (&acc)[2][2][4][2], const Unit& u, int wr, int wc, int fr, int fq) const {
        const int row0 = u.pm * BM + wr * 64 + fr, col0 = (u.pn % nN) * BM + wc * 32 + 8 * fq;
#pragma unroll
        for (int ai = 0; ai < 2; ++ai)
#pragma unroll
            for (int m = 0; m < 4; ++m)
#pragma unroll
                for (int bj = 0; bj < 2; ++bj)
                    *(u32x4*)(O + (size_t)(row0 + ai * HALF + m * 16) * ldc + col0 + bj * HALF) = pack8(acc[ai][bj][m][0] * sc, acc[ai][bj][m][1] * sc);
    }
};

struct MoeOrder {
    int nM, nN, nwg, G, c, lo; int tb[9];
    __device__ __forceinline__ bool next(int i, Unit& u) const {
        const long L = (long)i * G + c; if (L >= nwg) return false;
        int wgid = (int)L; { const int q = nwg / NXCD, r = nwg % NXCD, xcd = wgid % NXCD, off = wgid / NXCD; wgid = (xcd < r ? xcd * (q + 1) : r * (q + 1) + (xcd - r) * q) + off; }
        const int nig = WGM * nN, gid = wgid / nig, fm = gid * WGM, gsz = (nM - fm) < WGM ? (nM - fm) : WGM;
        u.pm = fm + ((wgid % nig) % gsz); const int pn = (wgid % nig) / gsz; const int gt = lo + u.pm; int e = 0;
#pragma unroll
        for (int k = 1; k < 8; ++k) e += (gt >= tb[k]) ? 1 : 0;
        u.pn = e * nN + pn; return true;
    }
    __device__ __forceinline__ void a_ready(const Unit&) const {}
    __device__ __forceinline__ void done(const Unit&) const {}
};
template <class Epi, class Sched, bool ALIGN_EPI = false, bool SP2 = false, bool F8 = false>
__device__ __forceinline__ void gemm_phase(PG8_LAS unsigned char* lds, const Gemm g, const Sched& S, const Epi& E, int tid_in) {
    int tid_ = tid_in; asm volatile("" : "+v"(tid_));
    const int tid = tid_, wid = __builtin_amdgcn_readfirstlane(tid >> 6), lane = tid & 63, wr = wid >> 2, wc = wid & 3, fr = lane & 15, fq = lane >> 4;
    int Kv_ = g.K; asm volatile("" : "+v"(Kv_)); const int K = __builtin_amdgcn_readfirstlane(Kv_), nt = K / BK;
    unsigned voffA[2], voffB[2];
#pragma unroll
    for (int i = 0; i < 2; ++i) { int R, C; stage_rc(tid * 16 + i * 8192, R, C); const int Rb = Epi::PERM ? ((R & ~31) + perm32(R & 31)) : R;
        voffA[i] = (unsigned)(R * K + C) * 2u; voffB[i] = (unsigned)(Rb * K + C) * 2u; }
    const size_t kstep = (size_t)(BK * 2);
    const size_t hstep = (size_t)HALF * K * 2;
    const size_t tstep = 2 * hstep;
    const unsigned ldsw = (unsigned)wid * 1024u;
    const int aoff = lds_byte(wr * 64 + fr, fq * 8), boff = lds_byte(wc * 32 + fr, fq * 8);
#define PG8_SA(b, h) (((b) * 2 + (h)) * HTB)
#define PG8_SB(b, h) ((4 + (b) * 2 + (h)) * HTB)
#define PG8_STAGE(bufoff, gbase, voff) do { _Pragma("unroll") for (int _i = 0; _i < 2; ++_i) \
        __builtin_amdgcn_global_load_lds((const unsigned*)((const char*)(gbase) + (voff)[_i]), (PG8_LAS unsigned*)(lds + (bufoff) + ldsw + _i * 8192), 16, 0, 0); } while (0)
#define PG8_LDA(dst, b, h) do { _Pragma("unroll") for (int m = 0; m < 4; ++m) _Pragma("unroll") for (int k = 0; k < 2; ++k) dst[m][k] = *(const PG8_LAS bf16x8*)(lds + PG8_SA(b, h) + aoff + m * 2048 + k * 1024); } while (0)
#define PG8_LDB(dst, b, h) do { _Pragma("unroll") for (int n = 0; n < 2; ++n) _Pragma("unroll") for (int k = 0; k < 2; ++k) dst[n][k] = *(const PG8_LAS bf16x8*)(lds + PG8_SB(b, h) + boff + n * 2048 + k * 1024); } while (0)
#define PG8_MMA(ai, bj, At, Bt) do { __builtin_amdgcn_s_setprio(1); if constexpr (F8) { _Pragma("unroll") for (int m = 0; m < 4; ++m) _Pragma("unroll") for (int n = 0; n < 2; ++n) \
        asm volatile("v_mfma_scale_f32_16x16x128_f8f6f4 %0, %1, %2, %0, %3, %3 op_sel_hi:[0,0,0]" : "+v"(acc[ai][bj][m][n]) : "v"(cat8(Bt[n][0], Bt[n][1])), "v"(cat8(At[m][0], At[m][1])), "v"(f8scale)); } \
        else { _Pragma("unroll") for (int m = 0; m < 4; ++m) _Pragma("unroll") for (int n = 0; n < 2; ++n) _Pragma("unroll") for (int k = 0; k < 2; ++k) \
        acc[ai][bj][m][n] = __builtin_amdgcn_mfma_f32_16x16x32_bf16(Bt[n][k], At[m][k], acc[ai][bj][m][n], 0, 0, 0); } __builtin_amdgcn_s_setprio(0); } while (0)
#define PG8_WAIT_V(n) asm volatile("s_waitcnt vmcnt(" #n ")" ::: "memory")
#define PG8_WAIT_L(n) asm volatile("s_waitcnt lgkmcnt(" #n ")" ::: "memory")
#define PG8_BAR __builtin_amdgcn_s_barrier()
#define PG8_SCHED __builtin_amdgcn_sched_barrier(0)
    const int f8scale = 0x7f7f7f7f;
    Unit cur, nxt; int ui = 0;
    if (!S.next(0, cur)) return;
    f32x4 acc[2][2][4][2];
#pragma unroll
    for (int a = 0; a < 2; ++a)
#pragma unroll
        for (int b = 0; b < 2; ++b)
#pragma unroll
            for (int m = 0; m < 4; ++m)
#pragma unroll
                for (int n = 0; n < 2; ++n) { acc[a][b][m][n] = (f32x4){0.f, 0.f, 0.f, 0.f}; if constexpr (F8) asm volatile("" : "+v"(acc[a][b][m][n])); }
    bf16x8 At[4][2], B0[2][2], B1[2][2];
    const char* cA = (const char*)g.A + (size_t)cur.pm * tstep; const char* cB = (const char*)g.Bt + (size_t)cur.pn * tstep;
    S.a_ready(cur);
    if constexpr (SP2) {
        PG8_STAGE(PG8_SB(0, 0), cB, voffB); PG8_STAGE(PG8_SB(0, 1), cB + hstep, voffB); PG8_STAGE(PG8_SA(0, 0), cA, voffA); PG8_STAGE(PG8_SA(0, 1), cA + hstep, voffA);
        if (wr == 1) PG8_BAR;
        PG8_WAIT_V(2); PG8_BAR;
        PG8_STAGE(PG8_SB(1, 0), cB + kstep, voffB); PG8_STAGE(PG8_SA(1, 0), cA + kstep, voffA); PG8_STAGE(PG8_SB(1, 1), cB + hstep + kstep, voffB);
        PG8_WAIT_V(6); PG8_BAR;
    } else {
        PG8_STAGE(PG8_SB(0, 0), cB, voffB); PG8_STAGE(PG8_SA(0, 0), cA, voffA); PG8_STAGE(PG8_SB(0, 1), cB + hstep, voffB); PG8_STAGE(PG8_SA(0, 1), cA + hstep, voffA);
        if (wr == 1) PG8_BAR;
        PG8_WAIT_V(4); PG8_BAR;
        PG8_STAGE(PG8_SB(1, 0), cB + kstep, voffB); PG8_STAGE(PG8_SA(1, 0), cA + kstep, voffA); PG8_STAGE(PG8_SB(1, 1), cB + hstep + kstep, voffB);
        PG8_WAIT_V(6); PG8_BAR;
    }
    for (;;) {
        const bool has_next = S.next(ui + 1, nxt);
        const char* nA = has_next ? (const char*)g.A + (size_t)nxt.pm * tstep : cA; const char* nB = has_next ? (const char*)g.Bt + (size_t)nxt.pn * tstep : cB;
        int t = 0;
#pragma unroll 1
        do {
            const bool last = (t == nt - 2);
            const char* a1 = cA + (size_t)(t + 1) * kstep;
            const char* a2 = last ? nA : cA + (size_t)(t + 2) * kstep; const char* b2 = last ? nB : cB + (size_t)(t + 2) * kstep;
            const char* a3 = a2 + kstep; const char* b3 = b2 + kstep;
            if (last && has_next) S.a_ready(nxt);
            if constexpr (SP2) {
            PG8_LDB(B0, 0, 0); PG8_LDB(B1, 0, 1); PG8_SCHED; PG8_LDA(At, 0, 0); PG8_STAGE(PG8_SA(1, 1), a1 + hstep, voffA);
            PG8_WAIT_V(8); PG8_WAIT_L(0); PG8_BAR; PG8_MMA(0, 0, At, B0); PG8_MMA(0, 1, At, B1); PG8_BAR; PG8_SCHED;
            PG8_LDA(At, 0, 1); PG8_STAGE(PG8_SB(0, 0), b2, voffB); PG8_STAGE(PG8_SB(0, 1), b2 + hstep, voffB); PG8_STAGE(PG8_SA(0, 0), a2, voffA);
            PG8_WAIT_V(8); PG8_WAIT_L(0); PG8_BAR; PG8_MMA(1, 0, At, B0); PG8_MMA(1, 1, At, B1); PG8_BAR; PG8_SCHED;
            PG8_LDB(B0, 1, 0); PG8_LDB(B1, 1, 1); PG8_SCHED; PG8_LDA(At, 1, 0); PG8_STAGE(PG8_SA(0, 1), a2 + hstep, voffA);
            PG8_WAIT_V(8); PG8_WAIT_L(0); PG8_BAR; PG8_MMA(0, 0, At, B0); PG8_MMA(0, 1, At, B1); PG8_BAR; PG8_SCHED;
            PG8_LDA(At, 1, 1); PG8_STAGE(PG8_SB(1, 0), b3, voffB); PG8_STAGE(PG8_SB(1, 1), b3 + hstep, voffB); PG8_STAGE(PG8_SA(1, 0), a3, voffA);
            PG8_WAIT_V(8); PG8_WAIT_L(0); PG8_BAR; PG8_MMA(1, 0, At, B0); PG8_MMA(1, 1, At, B1); PG8_BAR; PG8_SCHED;
            } else {
            PG8_LDB(B0, 0, 0); PG8_SCHED; PG8_LDA(At, 0, 0); PG8_STAGE(PG8_SA(1, 1), a1 + hstep, voffA);
            PG8_WAIT_L(8); PG8_BAR; PG8_WAIT_L(0); PG8_MMA(0, 0, At, B0); PG8_BAR; PG8_SCHED;
            PG8_LDB(B1, 0, 1); PG8_STAGE(PG8_SB(0, 0), b2, voffB);
            PG8_BAR; PG8_WAIT_L(0); PG8_MMA(0, 1, At, B1); PG8_BAR;
            PG8_LDA(At, 0, 1); PG8_STAGE(PG8_SA(0, 0), a2, voffA);
            PG8_BAR; PG8_WAIT_L(0); PG8_MMA(1, 0, At, B0); PG8_BAR; PG8_SCHED;
            PG8_STAGE(PG8_SB(0, 1), b2 + hstep, voffB);
            PG8_WAIT_V(6); PG8_BAR; PG8_MMA(1, 1, At, B1); PG8_BAR;
            PG8_LDB(B0, 1, 0); PG8_SCHED; PG8_LDA(At, 1, 0); PG8_STAGE(PG8_SA(0, 1), a2 + hstep, voffA);
            PG8_WAIT_L(8); PG8_BAR; PG8_WAIT_L(0); PG8_MMA(0, 0, At, B0); PG8_BAR; PG8_SCHED;
            PG8_LDB(B1, 1, 1); PG8_STAGE(PG8_SB(1, 0), b3, voffB);
            PG8_BAR; PG8_WAIT_L(0); PG8_MMA(0, 1, At, B1); PG8_BAR;
            PG8_LDA(At, 1, 1); PG8_STAGE(PG8_SA(1, 0), a3, voffA);
            PG8_BAR; PG8_WAIT_L(0); PG8_MMA(1, 0, At, B0); PG8_BAR; PG8_SCHED;
            PG8_STAGE(PG8_SB(1, 1), b3 + hstep, voffB);
            PG8_WAIT_V(6); PG8_BAR; PG8_MMA(1, 1, At, B1); PG8_BAR;
            }
            t += 2;
        } while (t < nt);
        if constexpr (ALIGN_EPI) { if (wr == 0) PG8_BAR; }
        if constexpr (F8) asm volatile("s_nop 15\n\ts_nop 15" ::: "memory");
        if constexpr (!Epi::AFTER_DRAIN) { E(acc, cur, wr, wc, fr, fq); S.done(cur); }
        if (!has_next) break;
#pragma unroll
        for (int a = 0; a < 2; ++a)
#pragma unroll
            for (int b = 0; b < 2; ++b)
#pragma unroll
                for (int m = 0; m < 4; ++m)
#pragma unroll
                    for (int n = 0; n < 2; ++n) { acc[a][b][m][n] = (f32x4){0.f, 0.f, 0.f, 0.f}; if constexpr (F8) asm volatile("" : "+v"(acc[a][b][m][n])); }
        cur = nxt; cA = nA; cB = nB; ++ui;
        if constexpr (ALIGN_EPI) { if (wr == 1) PG8_BAR; }
    }
    PG8_WAIT_V(0);
    if constexpr (!ALIGN_EPI) { if (wr == 0) PG8_BAR; }
    PG8_BAR;
    if constexpr (Epi::AFTER_DRAIN) { E.fused(acc, cur, wr, wc, fr, fq, lds, wid, lane); S.done(cur); }
#undef PG8_SA
#undef PG8_SB
#undef PG8_STAGE
#undef PG8_LDA
#undef PG8_LDB
#undef PG8_MMA
#undef PG8_WAIT_V
#undef PG8_WAIT_L
#undef PG8_BAR
#undef PG8_SCHED
}
}

#define GAS __attribute__((address_space(1)))
#define LAS __attribute__((address_space(3)))
typedef unsigned short bf16;
typedef unsigned u32x4 __attribute__((ext_vector_type(4)));
typedef unsigned u32x2 __attribute__((ext_vector_type(2)));
typedef float f32x4 __attribute__((ext_vector_type(4)));
typedef float f32x16 __attribute__((ext_vector_type(16)));
typedef short bf16x8 __attribute__((ext_vector_type(8)));
typedef GAS unsigned gu32;
#define RLX_AGENT __ATOMIC_RELAXED, __HIP_MEMORY_SCOPE_AGENT

#ifndef DBG
#define DBG 0
#endif
#ifndef N_LAUNCH_SPLIT
#define N_LAUNCH_SPLIT 0
#endif

constexpr int NB = 16, SL = 2048, T = NB * SL, D = 1024, ML = 256, MT = NB * ML;
constexpr int FF = 2816, FE = 3584, NE = 8, RMAXT = 264;
constexpr float EPS = 1e-6f, LOG2E = 1.4426950408889634f, INV_2PI = 0.15915494309189535f;
constexpr int NWAVES = 8, NTHR = 512;

constexpr size_t MiB = 1u << 20;
constexpr size_t WS_CTL = 0, CTL_BYTES = 1 * MiB;
constexpr size_t WS_WQ = 1 * MiB;
constexpr size_t WS_WO = WS_WQ + 8 * MiB;
constexpr size_t WS_WK = WS_WO + 8 * MiB;
constexpr size_t WS_WV = WS_WK + 8 * MiB;
constexpr size_t WS_EV = WS_WV + 8 * MiB;
constexpr size_t EV_STRIDE = 27 * MiB, EV_INN = 0, EV_INS = 6 * MiB, EV_OUT = 8 * MiB, EV_GU = 10 * MiB, EV_DN = 21 * MiB;
constexpr size_t WS_OD = WS_EV + 2 * EV_STRIDE;
constexpr size_t OD_STRIDE = 8 * MiB, OD_INN = 0, OD_INS = 4 * MiB, OD_OUT = 6 * MiB;
constexpr size_t WS_MOE = WS_OD + 2 * OD_STRIDE;
constexpr size_t MOE_STRIDE = 84 * MiB, MOE_DN = 56 * MiB;
constexpr float MOE_WSCALE = 64.f, MOE_HSCALE = 4.f;
constexpr size_t WS_XB = WS_MOE + 168 * MiB;
constexpr size_t WS_SSQ = WS_XB + 64 * MiB;
constexpr size_t WS_MEMN = WS_SSQ + 2 * MiB;
constexpr size_t WS_KX = WS_MEMN + 8 * MiB;
constexpr size_t WS_VTX = WS_KX + 32 * MiB;
constexpr size_t WS_MISC = WS_VTX + 32 * MiB;
constexpr size_t MISC_LIST = 0, MISC_YROW = 1 * MiB, MISC_GATE = MISC_YROW + 256 * 1024, MISC_EPOS = MISC_GATE + 256 * 1024, MISC_RSS = MISC_EPOS + 256 * 1024;
constexpr size_t WS_ACT = WS_MISC + 3 * MiB;
constexpr size_t A_PE = 0, A_VTE = 256 * MiB, A_R = 352 * MiB;
constexpr int PEW = 4096;
constexpr size_t A_QK = 0, A_VTD = 128 * MiB, A_AO = 192 * MiB;
constexpr int QKP = 2048, VTP = T;
constexpr size_t A_QX = 0, A_OX = 64 * MiB;
constexpr size_t A_H = 0, A_XB8 = 432 * MiB;
constexpr size_t A_XS = 0, A_HID = 66 * MiB, A_Y = 297 * MiB;
constexpr size_t ACT_BYTES = 495 * MiB, WS_END = WS_ACT + ACT_BYTES;
constexpr int CW_TMO = 0, CW_BAR = 4096, CW_CNT = 8192  , CW_CHK = 16384  , CHK_NSTAGE = 96;
constexpr int PH_BYTES = 135168, LDSCTL_OFF = PH_BYTES, LDS_BYTES = PH_BYTES + 1024;

__device__ __forceinline__ float bf2f(bf16 b) { return __builtin_bit_cast(float, (unsigned)b << 16); }
__device__ __forceinline__ unsigned f2bf(float f) { unsigned u = __builtin_bit_cast(unsigned, f); return (u + 0x7fffu + ((u >> 16) & 1u)) >> 16; }
__device__ __forceinline__ unsigned pk2(float lo, float hi) { return f2bf(lo) | (f2bf(hi) << 16); }
__device__ __forceinline__ int crow(int r, int hi) { return (r & 3) + 8 * (r >> 2) + 4 * hi; }
#define LDS_WAIT() asm volatile("s_waitcnt lgkmcnt(0)" ::: "memory")
#define VM_WAIT() asm volatile("s_waitcnt vmcnt(0)" ::: "memory")
__device__ __forceinline__ float wave_sum(float v) {
#pragma unroll
    for (int o = 1; o < 64; o <<= 1) v += __shfl_xor(v, o);
    return v;
}
__device__ __forceinline__ float wave_max(float v) {
#pragma unroll
    for (int o = 1; o < 64; o <<= 1) v = fmaxf(v, __shfl_xor(v, o));
    return v;
}
#define MFMA32(a, b, c) __builtin_amdgcn_mfma_f32_32x32x16_bf16((a), (b), (c), 0, 0, 0)
__device__ __forceinline__ bf16x8 pack_frag(float a0, float a1, float a2, float a3, float a4, float a5, float a6, float a7) {
    u32x4 w; w.x = pg8::cvt_pk_bf16(a0, a1); w.y = pg8::cvt_pk_bf16(a2, a3); w.z = pg8::cvt_pk_bf16(a4, a5); w.w = pg8::cvt_pk_bf16(a6, a7); return __builtin_bit_cast(bf16x8, w);
}
__device__ __forceinline__ bf16x8 join8(u32x2 lo, u32x2 hi) { u32x4 w; w.x = lo.x; w.y = lo.y; w.z = hi.x; w.w = hi.y; return __builtin_bit_cast(bf16x8, w); }

struct Args {
    const float* x; const float* mem; const int* pos; const float* mem_g; const float* fin_g; const float* mix_g; const float* xa_g; const float* ffn_g;
    const float* xa_wq; const float* xa_wkv; const float* xa_wo; const float* ev_w_in; const float* ev_conv; const float* ev_df; const float* ev_db; const float* ev_gn;
    const float* ev_w_out; const float* ffd_g; const float* ffd_u; const float* ffd_d; const float* od_w_in; const float* lq1; const float* lk1; const float* lq2; const float* lk2;
    const float* od_gn; const float* od_w_out; const float* router; const float* moe_g; const float* moe_u; const float* moe_d;
    float* out; unsigned char* ws; int ph_lo, ph_hi;
};
struct Frame {
    LAS unsigned char* lds; gu32* ctl; unsigned char* ws; int tid, lane, wave, G, bid;
};
#define XB_TMO      128
#define XB_XCNT(j)  (256  + 64 * (j))
#define XB_XSUB(j)  (1280 + 64 * (j))
#define XB_XGEN(j)  (2304 + 64 * (j))
#define XB_TOP      3328
#define XB_TOPGEN   3392
#define XCD_BAR_WORDS 3456
#define XB_SPIN_CAP (1u << 18)

__device__ __forceinline__ unsigned xb_ld(unsigned* p)              { return __hip_atomic_load(p, __ATOMIC_RELAXED, __HIP_MEMORY_SCOPE_AGENT); }
__device__ __forceinline__ unsigned xb_add(unsigned* p, unsigned v) { return __hip_atomic_fetch_add(p, v, __ATOMIC_RELAXED, __HIP_MEMORY_SCOPE_AGENT); }
__device__ __forceinline__ unsigned xb_xcc_id() { return (unsigned)__builtin_amdgcn_s_getreg((3 << 11) | 20) & 0xFu; }
#define XB_SPIN(cond, bar) do { unsigned _sp = 0; while (cond) { __builtin_amdgcn_s_sleep(1); \
    if ((++_sp & 255u) == 0u) { if (xb_ld(&(bar)[XB_TMO])) break; if (_sp > XB_SPIN_CAP) { atomicAdd(&(bar)[XB_TMO], 1u); break; } } } } while (0)

struct XcdBarrier {
    unsigned* bar; unsigned x;
    bool t0;
    volatile LAS unsigned* st;
};

__device__ __forceinline__ XcdBarrier xcd_barrier_post(unsigned* bar, volatile LAS unsigned* st) {
    XcdBarrier b; b.bar = bar; b.x = xb_xcc_id(); b.st = st; b.t0 = (threadIdx.x == 0);
    if (threadIdx.x == 0) (void)xb_add(&bar[XB_XCNT(b.x)], 1u);
    return b;
}
__device__ __forceinline__ void xcd_barrier_complete(unsigned* bar, unsigned x, unsigned& nloc, unsigned& nx) {
    const unsigned G = gridDim.x * gridDim.y * gridDim.z;
    unsigned sum, cnt, mine, sp = 0u;
    for (;;) {
        sum = 0u; cnt = 0u; mine = 0u;
#pragma unroll
        for (unsigned j = 0; j < 16; ++j) { const unsigned c = xb_ld(&bar[XB_XCNT(j)]); sum += c; cnt += (c > 0u) ? 1u : 0u; mine = (j == x) ? c : mine; }
        if (sum == G) break;
        __builtin_amdgcn_s_sleep(1);
        if ((++sp & 255u) == 0u) { if (xb_ld(&bar[XB_TMO])) break; if (sp > XB_SPIN_CAP) { atomicAdd(&bar[XB_TMO], 1u); break; } }
    }
    nloc = mine > 0u ? mine : 1u; nx = cnt > 0u ? cnt : 1u;
}

__device__ __forceinline__ void xcd_barrier(const XcdBarrier& b) {
    asm volatile("s_waitcnt vmcnt(0)" ::: "memory");
    __syncthreads();
    if (b.t0) {
        unsigned* bar = b.bar;
        __builtin_amdgcn_s_waitcnt(0);
        unsigned nloc = b.st[0], nx = b.st[1];
        if (nloc == 0u) { xcd_barrier_complete(bar, b.x, nloc, nx); b.st[0] = nloc; b.st[1] = nx; }
        const unsigned old = xb_add(&bar[XB_XSUB(b.x)], 1u);
        const unsigned gen = old / nloc;
        if (old + 1u == (gen + 1u) * nloc) {
            __builtin_amdgcn_fence(__ATOMIC_RELEASE, "agent");
            asm volatile("s_waitcnt vmcnt(0)" ::: "memory");
            const unsigned og = xb_add(&bar[XB_TOP], 1u);
            const unsigned tg = og / nx;
            if (og + 1u == (tg + 1u) * nx) xb_add(&bar[XB_TOPGEN], 1u);
            else XB_SPIN(xb_ld(&bar[XB_TOPGEN]) == tg, bar);
            __builtin_amdgcn_fence(__ATOMIC_ACQUIRE, "agent");
            xb_add(&bar[XB_XGEN(b.x)], 1u);
            asm volatile("s_waitcnt vmcnt(0)" ::: "memory");
        } else {
            XB_SPIN(xb_ld(&bar[XB_XGEN(b.x)]) == gen, bar);
            __builtin_amdgcn_fence(__ATOMIC_ACQUIRE, "agent");
            asm volatile("s_waitcnt vmcnt(0)" ::: "memory");
        }
    }
    __syncthreads();
}

template <bool F8W = false> __device__ __forceinline__ void tr_item(const float* W0, const float* W1, int ldw, int K, int cm, int coff, const float* gk, bf16* WT, int item, int nblk, LAS float* scr, int lane, float wsc = 1.f) {
    const int kb = item / nblk, nb = item % nblk, k0 = 64 * kb, n0 = 64 * nb;
    const int np = n0 + 4 * (lane & 15);
    const float* W = W0; int sc;
    if (cm == 0) sc = np + coff;
    else if (cm == 1) { if (np < 1536) sc = np; else if (np < 2560) { const int c = np & 63, g = c >> 3, s = c & 7; sc = (np & ~63) + ((s < 4) ? 4 * g + s : 32 + 4 * g + (s - 4)); } else sc = np + 512; }
    else if (cm == 2) { const int c = np & 63; if (c < 16) { const int g = c >> 3, s = c & 7; sc = (np & ~63) + ((s < 4) ? 4 * g + s : 8 + 4 * g + (s - 4)); } else sc = np; }
    else { const int t = np >> 8, r = np & 255; if (r < 128) sc = 128 * t + r; else { sc = 128 * t + r - 128; W = W1; } }
#pragma unroll 4
    for (int i = 0; i < 16; ++i) { const int kk = 4 * i + (lane >> 4); const f32x4 v = *(const f32x4*)(W + (size_t)(k0 + kk) * ldw + sc); const float g = (gk ? gk[k0 + kk] : 1.f) * wsc;
        LAS float* d = scr + kk * 65 + 4 * (lane & 15); d[0] = v[0] * g; d[1] = v[1] * g; d[2] = v[2] * g; d[3] = v[3] * g; }
    LDS_WAIT(); asm volatile("" ::: "memory");
    const int c = lane & 7;
#pragma unroll
    for (int j = 0; j < 8; ++j) { const int n = (lane >> 3) + 8 * j; const LAS float* s = scr + (8 * c) * 65 + n;
        if constexpr (F8W) { u32x2 o; o.x = pg8::pack_fp8x4(s[0 * 65], s[1 * 65], s[2 * 65], s[3 * 65]); o.y = pg8::pack_fp8x4(s[4 * 65], s[5 * 65], s[6 * 65], s[7 * 65]);
            *(u32x2*)((unsigned char*)WT + (size_t)(n0 + n) * K + k0 + 8 * c) = o; }
        else { u32x4 o; o.x = pk2(s[0 * 65], s[1 * 65]); o.y = pk2(s[2 * 65], s[3 * 65]); o.z = pk2(s[4 * 65], s[5 * 65]); o.w = pk2(s[6 * 65], s[7 * 65]);
            *(u32x4*)(WT + (size_t)(n0 + n) * K + k0 + 8 * c) = o; } }
    LDS_WAIT(); asm volatile("" ::: "memory");
}
#define TRMAT(W0_, W1_, ldw_, K_, N_, cm_, coff_, gk_, WT_) do { const int nblk_ = (N_) / 64, ni_ = ((K_) / 64) * nblk_; \
    for (int it_ = (int)(((long)gw - ib + (long)NGW * 1024) % NGW); it_ < ni_; it_ += NGW) tr_item((W0_), (W1_), (ldw_), (K_), (cm_), (coff_), (gk_), (WT_), it_, nblk_, scr, F.lane); \
    ib = (ib + ni_) % NGW; } while (0)
#define TRMAT8(W0_, W1_, ldw_, K_, N_, cm_, coff_, gk_, WT_) do { const int nblk_ = (N_) / 64, ni_ = ((K_) / 64) * nblk_; \
    for (int it_ = (int)(((long)gw - ib + (long)NGW * 1024) % NGW); it_ < ni_; it_ += NGW) tr_item<true>((W0_), (W1_), (ldw_), (K_), (cm_), (coff_), (gk_), (bf16*)(WT_), it_, nblk_, scr, F.lane, MOE_WSCALE); \
    ib = (ib + ni_) % NGW; } while (0)

__device__ __forceinline__ void moe_convert(Frame& F, const Args& A, int j) {
    LAS float* scr = (LAS float*)(F.lds) + F.wave * (64 * 65);
    const int gw = F.bid * NWAVES + F.wave, NGW = F.G * NWAVES; long ib = 0;
    unsigned char* gu = F.ws + WS_MOE + (size_t)j * MOE_STRIDE; unsigned char* dn = gu + MOE_DN;
    for (int e = 0; e < NE; ++e) {
        const size_t wo = ((size_t)j * NE + e) * (size_t)D * FE;
        TRMAT8(A.moe_g + wo, A.moe_u + wo, FE, D, 2 * FE, 3, 0, A.ffn_g + (2 * j + 1) * D, gu + (size_t)e * 2 * FE * D);
        TRMAT8(A.moe_d + wo, nullptr, D, FE, D, 0, 0, nullptr, dn + (size_t)e * D * FE);
    }
}

__device__ __forceinline__ void prologue_phase(Frame& F, const Args& A) {
    LAS float* scr = (LAS float*)(F.lds) + F.wave * (64 * 65);
    const int gw = F.bid * NWAVES + F.wave, NGW = F.G * NWAVES; long ib = 0;
    { const bool h5 = (F.lane & 32) != 0, h4 = (F.lane & 16) != 0;
      for (int m0 = 4 * gw; m0 < T; m0 += 4 * NGW) {
        f32x4 v[4][4]; float sq[4];
#pragma unroll
        for (int s = 0; s < 4; ++s) { const f32x4* xr = (const f32x4*)(A.x + (size_t)(m0 + s) * D) + F.lane;
#pragma unroll
            for (int q = 0; q < 4; ++q) v[s][q] = xr[64 * q]; }
#pragma unroll
        for (int s = 0; s < 4; ++s) { sq[s] = 0.f;
#pragma unroll
            for (int q = 0; q < 4; ++q) {
#pragma unroll
                for (int e = 0; e < 4; ++e) v[s][q][e] = bf2f((bf16)f2bf(v[s][q][e]));
                sq[s] += (v[s][q][0] * v[s][q][0] + v[s][q][1] * v[s][q][1]) + (v[s][q][2] * v[s][q][2] + v[s][q][3] * v[s][q][3]); } }
        const float t0 = (h5 ? sq[2] : sq[0]) + __shfl_xor(h5 ? sq[0] : sq[2], 32), t1 = (h5 ? sq[3] : sq[1]) + __shfl_xor(h5 ? sq[1] : sq[3], 32);
        float tt = (h4 ? t1 : t0) + __shfl_xor(h4 ? t0 : t1, 16);
        tt += __shfl_xor(tt, 8); tt += __shfl_xor(tt, 4); tt += __shfl_xor(tt, 2); tt += __shfl_xor(tt, 1);
#pragma unroll
        for (int s = 0; s < 4; ++s) { const int m = m0 + s; const float ssum = __builtin_bit_cast(float, __builtin_amdgcn_readlane(__builtin_bit_cast(int, tt), 16 * s));
            u32x2* brow = (u32x2*)((bf16*)(F.ws + WS_XB) + (size_t)m * D) + F.lane;
#pragma unroll
            for (int q = 0; q < 4; ++q) { u32x2 w; w.x = pk2(v[s][q][0], v[s][q][1]); w.y = pk2(v[s][q][2], v[s][q][3]); brow[64 * q] = w; }
            if (F.lane < 16) ((float*)(F.ws + WS_SSQ))[(size_t)m * 16 + F.lane] = (F.lane == 0) ? ssum : 0.f; }
      } }
    for (int m = gw; m < MT; m += NGW) {
        const f32x4* xr = (const f32x4*)(A.mem + (size_t)m * D) + F.lane; const f32x4* gr = (const f32x4*)A.mem_g + F.lane; f32x4 v[4]; float s = 0.f;
#pragma unroll
        for (int q = 0; q < 4; ++q) { v[q] = xr[64 * q]; s += (v[q][0] * v[q][0] + v[q][1] * v[q][1]) + (v[q][2] * v[q][2] + v[q][3] * v[q][3]); }
        const float rs = rsqrtf(wave_sum(s) * (1.f / D) + EPS);
        u32x2* brow = (u32x2*)((bf16*)(F.ws + WS_MEMN) + (size_t)m * D) + F.lane;
#pragma unroll
        for (int q = 0; q < 4; ++q) { const f32x4 g = gr[64 * q]; u32x2 w; w.x = pk2(v[q][0] * rs * g[0], v[q][1] * rs * g[1]); w.y = pk2(v[q][2] * rs * g[2], v[q][3] * rs * g[3]); brow[64 * q] = w; }
    }
    for (int l = 0; l < 4; ++l) {
        TRMAT8(A.xa_wq + (size_t)l * D * D, nullptr, D, D, D, 0, 0, A.xa_g + l * D, F.ws + WS_WQ + (size_t)l * D * D);
        TRMAT8(A.xa_wo + (size_t)l * D * D, nullptr, D, D, D, 0, 0, nullptr, F.ws + WS_WO + (size_t)l * D * D);
        TRMAT(A.xa_wkv + (size_t)l * D * 2 * D, nullptr, 2 * D, D, D, 0, 0, nullptr, (bf16*)(F.ws + WS_WK) + (size_t)l * D * D);
        TRMAT(A.xa_wkv + (size_t)l * D * 2 * D, nullptr, 2 * D, D, D, 0, D, nullptr, (bf16*)(F.ws + WS_WV) + (size_t)l * D * D);
    }
    for (int j = 0; j < 2; ++j) {
        unsigned char* eb = F.ws + WS_EV + j * EV_STRIDE; const float* win = A.ev_w_in + (size_t)j * D * 3584;
        TRMAT(win, nullptr, 3584, D, 3072, 1, 0, A.mix_g + (2 * j) * D, (bf16*)(eb + EV_INN));
        TRMAT(win, nullptr, 3584, D, 512, 0, 2560, A.mix_g + (2 * j) * D, (bf16*)(eb + EV_INS));
        TRMAT(A.ev_w_out + (size_t)j * D * D, nullptr, D, D, D, 0, 0, nullptr, (bf16*)(eb + EV_OUT));
        TRMAT8(A.ffd_g + (size_t)j * D * FF, A.ffd_u + (size_t)j * D * FF, FF, D, 2 * FF, 3, 0, A.ffn_g + (2 * j) * D, eb + EV_GU);
        TRMAT8(A.ffd_d + (size_t)j * FF * D, nullptr, D, FF, D, 0, 0, nullptr, eb + EV_DN);
        unsigned char* ob = F.ws + WS_OD + j * OD_STRIDE; const float* oin = A.od_w_in + (size_t)j * D * 3072;
        TRMAT(oin, nullptr, 3072, D, 2048, 2, 0, A.mix_g + (2 * j + 1) * D, (bf16*)(ob + OD_INN));
        TRMAT(oin, nullptr, 3072, D, 1024, 0, 2048, A.mix_g + (2 * j + 1) * D, (bf16*)(ob + OD_INS));
        TRMAT(A.od_w_out + (size_t)j * D * D, nullptr, D, D, D, 0, 0, nullptr, (bf16*)(ob + OD_OUT));
    }
}

__device__ __forceinline__ void fret_phase(Frame& F, const Args& A, int j) {
    const bf16* PE = (const bf16*)(F.ws + WS_ACT + A_PE); bf16* R = (bf16*)(F.ws + WS_ACT + A_R); const bf16* VT = (const bf16*)(F.ws + WS_ACT + A_VTE);
    { const float* cw = A.ev_conv + (size_t)j * 3 * 512;
      const int c0 = (F.tid & 63) * 8;
      float cwv[3][8];
#pragma unroll
      for (int d = 0; d < 3; ++d) { const f32x4 a = *(const f32x4*)(cw + d * 512 + c0), bq = *(const f32x4*)(cw + d * 512 + c0 + 4);
#pragma unroll
          for (int e = 0; e < 4; ++e) { cwv[d][e] = a[e]; cwv[d][4 + e] = bq[e]; } }
      const int tstr = (F.G * NTHR) >> 6;
      for (int t0 = (F.bid * NTHR + F.tid) >> 6; t0 < T; t0 += 4 * tstr) {
        bf16x8 gcv[4][3], hcv[4][3], gbv[4];
#pragma unroll
        for (int s = 0; s < 4; ++s) { const int t = t0 + s * tstr; const bool tv = t < T; const int l = t & (SL - 1); const bf16* row = PE + (size_t)(tv ? t : 0) * PEW;
#pragma unroll
            for (int d = 0; d < 3; ++d) { const bool ok = tv && ((d == 0) ? (l > 0) : (d == 2) ? (l < SL - 1) : true); const bf16* rr = row + (ok ? (d - 1) * PEW : 0);
                gcv[s][d] = *(const bf16x8*)(rr + 512 + c0); hcv[s][d] = *(const bf16x8*)(rr + 1024 + c0); }
            gbv[s] = *(const bf16x8*)(row + c0); }
#pragma unroll
        for (int s = 0; s < 4; ++s) { const int t = t0 + s * tstr; if (t < T) { const int l = t & (SL - 1); float o[8];
#pragma unroll
            for (int e = 0; e < 8; ++e) { float acc = cwv[1][e] * (bf2f((bf16)gcv[s][1][e]) * bf2f((bf16)hcv[s][1][e]));
                if (l > 0) acc += cwv[0][e] * (bf2f((bf16)gcv[s][0][e]) * bf2f((bf16)hcv[s][0][e]));
                if (l < SL - 1) acc += cwv[2][e] * (bf2f((bf16)gcv[s][2][e]) * bf2f((bf16)hcv[s][2][e]));
                o[e] = bf2f((bf16)gbv[s][e]) * acc; }
            u32x4 wq; wq.x = pk2(o[0], o[1]); wq.y = pk2(o[2], o[3]); wq.z = pk2(o[4], o[5]); wq.w = pk2(o[6], o[7]);
            *(u32x4*)(R + (size_t)t * 1024 + c0) = wq; } } } }
    const int w = F.wave, lane = F.lane, r = lane & 31, hh = lane >> 5, tid = F.tid;
    LAS unsigned char* lds = F.lds;
    const float* gng = A.ev_gn + j * 512;
    const int srow = tid >> 3, sch = tid & 7;
    const int kfo = r * 144 + 16 * hh;
    const int vfo = 36864 + r * 144 + 16 * hh;
    const int sto = srow * 144 + sch * 16;
    const int stv = 36864 + srow * 144 + (sch >> 1) * 32 + (sch & 1) * 8;
    LAS float* gnl = (LAS float*)(lds + 57344);
    if (tid < 128) *(LAS f32x4*)(gnl + 4 * tid) = *(const f32x4*)(gng + 4 * tid);
    const unsigned kof = (unsigned)(srow * PEW + sch * 8) * 2u, vof = (unsigned)(srow * T + sch * 8) * 2u;
    int u = F.bid; if (u >= 1024) { __syncthreads(); return; }
    int b = u >> 6, h = (u >> 3) & 7, qt = u & 7; size_t tok0 = (size_t)b * SL + 256 * qt, kb = (size_t)b * SL;
    bf16x8 qff[4], qfb[4]; u32x4 rk0, rk1, rv0, rk2, rk3, rv1;
    const char* kbase = (const char*)(PE + kb * PEW + 2048 + h * 64); const char* vbase = (const char*)(VT + (size_t)(h * 64) * T + kb);
    { const bf16* qp = PE + (tok0 + 32 * w + r) * PEW + h * 64 + 8 * hh;
#pragma unroll
      for (int s = 0; s < 4; ++s) { qff[s] = *(const bf16x8*)(qp + 1536 + 16 * s); qfb[s] = *(const bf16x8*)(qp + 3072 + 16 * s); }
      rk0 = *(const u32x4*)(kbase + kof); rk1 = *(const u32x4*)(kbase + kof + 3072); rv0 = *(const u32x4*)(vbase + vof);
      rk2 = *(const u32x4*)(kbase + (size_t)(64 * PEW * 2) + kof); rk3 = *(const u32x4*)(kbase + (size_t)(64 * PEW * 2) + kof + 3072); rv1 = *(const u32x4*)(vbase + 128 + vof); }
    for (;;) {
        const float lgf = __builtin_bit_cast(float, __builtin_amdgcn_readfirstlane(__builtin_bit_cast(int, -__expf(A.ev_df[j * 8 + h]) * LOG2E))), lgb = __builtin_bit_cast(float, __builtin_amdgcn_readfirstlane(__builtin_bit_cast(int, -__expf(A.ev_db[j * 8 + h]) * LOG2E)));
        const int nw0 = 256 * qt + 32 * w, tmix = nw0 >> 6;
#define FR_LDK(t) do { const char* kt_ = kbase + (size_t)(t) * (64 * PEW * 2); rk0 = *(const u32x4*)(kt_ + kof); rk1 = *(const u32x4*)(kt_ + kof + 3072); } while (0)
#define FR_LDV(t) do { rv0 = *(const u32x4*)(vbase + (size_t)(t) * 128 + vof); } while (0)
#define FR_STK(bf) do { *(LAS u32x4*)(lds + (bf) * 18432 + sto) = rk0; *(LAS u32x4*)(lds + (bf) * 18432 + 9216 + sto) = rk1; } while (0)
#define FR_STV(bf) do { LAS unsigned char* vd_ = lds + (bf) * 9216 + stv; *(LAS u32x2*)(vd_) = (u32x2){rv0.x, rv0.y}; *(LAS u32x2*)(vd_ + 16) = (u32x2){rv0.z, rv0.w}; } while (0)
#define FR_KF(kbn, cb, kt2, s) (*(const LAS bf16x8*)(lds + (kbn) * 18432 + (cb) * 9216 + kfo + (kt2) * 4608 + 32 * (s)))
#define FR_VF(vbc, dvt, k2, s2) (*(const LAS bf16x8*)(lds + (vbc) * 9216 + vfo + 4608 * (dvt) + 64 * (k2) + 32 * (s2)))
#define FR_QKH(N, NC, tt, kbn, kt2) do { const int m0_ = 64 * (tt); N = zero16; \
        if ((tt) < tmix) { _Pragma("unroll") for (int s = 0; s < 4; ++s) N = MFMA32(FR_KF(kbn, 0, kt2, s), qff[s], N); NC = __builtin_amdgcn_exp2f(lgf * (float)(nw0 - m0_)); } \
        else if ((tt) > tmix) { _Pragma("unroll") for (int s = 0; s < 4; ++s) N = MFMA32(FR_KF(kbn, 1, kt2, s), qfb[s], N); NC = __builtin_amdgcn_exp2f(lgb * (float)(m0_ - nw0)); } \
        else { f32x16 b_ = zero16; \
            _Pragma("unroll") for (int s = 0; s < 4; ++s) { N = MFMA32(FR_KF(kbn, 0, kt2, s), qff[s], N); b_ = MFMA32(FR_KF(kbn, 1, kt2, s), qfb[s], b_); } \
            const float cf_ = __builtin_amdgcn_exp2f(lgf * (float)(nw0 - m0_)), cb_ = __builtin_amdgcn_exp2f(lgb * (float)(m0_ - nw0)); const int n_ = nw0 + r; \
            _Pragma("unroll") for (int q = 0; q < 16; ++q) { const int m_ = m0_ + 32 * (kt2) + crow(q, hh); N[q] = (m_ <= n_) ? N[q] * cf_ : b_[q] * cb_; } \
            NC = 1.f; } } while (0)
#define FR_PACK(P, B, c) pack_frag(P[B] * (c), P[B + 1] * (c), P[B + 2] * (c), P[B + 3] * (c), P[B + 4] * (c), P[B + 5] * (c), P[B + 6] * (c), P[B + 7] * (c))
        FR_STK(0); FR_STV(0); rk0 = rk2; rk1 = rk3; rv0 = rv1;
        __syncthreads();
        const f32x16 zero16 = {};
        f32x16 o[2] = {{}, {}};
#pragma unroll 1
        for (int t = 0; t < 32; ++t) { const int bc = t & 1;
            if (t + 1 < 32) { FR_STK(bc ^ 1); FR_STV(bc ^ 1); }
            if (t + 2 < 32) { FR_LDK(t + 2); FR_LDV(t + 2); }
            f32x16 s0_, s1_; float c0_, c1_;
            if (__builtin_expect(t != tmix, 1)) { const bool below_ = t < tmix; const int cbo_ = below_ ? 0 : 9216; s0_ = zero16; s1_ = zero16;
#pragma unroll
                for (int s = 0; s < 4; ++s) { const bf16x8 qs_ = below_ ? qff[s] : qfb[s];
                    s0_ = MFMA32(*(const LAS bf16x8*)(lds + bc * 18432 + cbo_ + kfo + 32 * s), qs_, s0_); s1_ = MFMA32(*(const LAS bf16x8*)(lds + bc * 18432 + cbo_ + kfo + 4608 + 32 * s), qs_, s1_); }
                c0_ = below_ ? __builtin_amdgcn_exp2f(lgf * (float)(nw0 - 64 * t)) : __builtin_amdgcn_exp2f(lgb * (float)(64 * t - nw0)); c1_ = c0_; }
            else { FR_QKH(s0_, c0_, t, bc, 0); FR_QKH(s1_, c1_, t, bc, 1); }
            const bf16x8 p0l = FR_PACK(s0_, 0, c0_), p0h = FR_PACK(s0_, 8, c0_), p1l = FR_PACK(s1_, 0, c1_), p1h = FR_PACK(s1_, 8, c1_);
            o[0] = MFMA32(FR_VF(bc, 0, 0, 0), p0l, o[0]); o[1] = MFMA32(FR_VF(bc, 1, 0, 0), p0l, o[1]); o[0] = MFMA32(FR_VF(bc, 0, 0, 1), p0h, o[0]); o[1] = MFMA32(FR_VF(bc, 1, 0, 1), p0h, o[1]);
            o[0] = MFMA32(FR_VF(bc, 0, 1, 0), p1l, o[0]); o[1] = MFMA32(FR_VF(bc, 1, 1, 0), p1l, o[1]); o[0] = MFMA32(FR_VF(bc, 0, 1, 1), p1h, o[0]); o[1] = MFMA32(FR_VF(bc, 1, 1, 1), p1h, o[1]);
            __syncthreads(); }
#undef FR_QKH
#undef FR_PACK
#undef FR_VF
#undef FR_KF
#undef FR_STV
#undef FR_STK
#undef FR_LDV
#undef FR_LDK
        const size_t tok = tok0 + 32 * w + r;
        u32x2 gwl[2][4];
#pragma unroll
        for (int dvt = 0; dvt < 2; ++dvt)
#pragma unroll
            for (int q4 = 0; q4 < 4; ++q4) gwl[dvt][q4] = *(const u32x2*)(PE + tok * PEW + 2560 + h * 64 + 32 * dvt + 8 * q4 + 4 * hh);
        const int un = u + F.G; const bool has_next = un < 1024;
        const int nb = un >> 6, nh = (un >> 3) & 7, nqt = un & 7; const size_t ntok0 = (size_t)nb * SL + 256 * nqt, nkb = (size_t)nb * SL;
        const char* nkbase = (const char*)(PE + nkb * PEW + 2048 + nh * 64); const char* nvbase = (const char*)(VT + (size_t)(nh * 64) * T + nkb);
        if (has_next) { const bf16* qp = PE + (ntok0 + 32 * w + r) * PEW + nh * 64 + 8 * hh;
#pragma unroll
            for (int s = 0; s < 4; ++s) { qff[s] = *(const bf16x8*)(qp + 1536 + 16 * s); qfb[s] = *(const bf16x8*)(qp + 3072 + 16 * s); }
            rk0 = *(const u32x4*)(nkbase + kof); rk1 = *(const u32x4*)(nkbase + kof + 3072); rv0 = *(const u32x4*)(nvbase + vof);
            rk2 = *(const u32x4*)(nkbase + (size_t)(64 * PEW * 2) + kof); rk3 = *(const u32x4*)(nkbase + (size_t)(64 * PEW * 2) + kof + 3072); rv1 = *(const u32x4*)(nvbase + 128 + vof); }
        float ss = 0.f;
#pragma unroll
        for (int dvt = 0; dvt < 2; ++dvt)
#pragma unroll
            for (int q = 0; q < 16; ++q) ss += o[dvt][q] * o[dvt][q];
        ss += __shfl_xor(ss, 32); const float rms = rsqrtf(ss * (1.f / 64.f) + EPS);
#pragma unroll
        for (int dvt = 0; dvt < 2; ++dvt) { u32x2 wq[4];
#pragma unroll
            for (int q4 = 0; q4 < 4; ++q4) { const int dv0 = 32 * dvt + 8 * q4 + 4 * hh;
                const u32x2 gwv = gwl[dvt][q4]; const f32x4 gn = *(const LAS f32x4*)(gnl + h * 64 + dv0);
                const float gg[4] = {__builtin_bit_cast(float, gwv.x << 16), __builtin_bit_cast(float, gwv.x & 0xffff0000u), __builtin_bit_cast(float, gwv.y << 16), __builtin_bit_cast(float, gwv.y & 0xffff0000u)}; float ov[4];
#pragma unroll
                for (int e = 0; e < 4; ++e) ov[e] = o[dvt][4 * q4 + e] * rms * gn[e] * gg[e] * __builtin_amdgcn_rcpf(1.f + __builtin_amdgcn_exp2f(-gg[e] * LOG2E));
                wq[q4].x = pk2(ov[0], ov[1]); wq[q4].y = pk2(ov[2], ov[3]); }
#pragma unroll
            for (int qp = 0; qp < 2; ++qp) {
                const auto rx = __builtin_amdgcn_permlane32_swap(wq[2 * qp].x, wq[2 * qp + 1].x, false, false); const auto ry = __builtin_amdgcn_permlane32_swap(wq[2 * qp].y, wq[2 * qp + 1].y, false, false);
                *(u32x4*)(R + tok * 1024 + 512 + h * 64 + 32 * dvt + 8 * (2 * qp + hh)) = (u32x4){rx[0], ry[0], rx[1], ry[1]}; } }
        if (!has_next) break;
        u = un; b = nb; h = nh; qt = nqt; tok0 = ntok0; kb = nkb; kbase = nkbase; vbase = nvbase;
    }
}

__device__ __forceinline__ void xattn_phase(Frame& F, int l) {
    const bf16* Q = (const bf16*)(F.ws + WS_ACT + A_QX); bf16* OX = (bf16*)(F.ws + WS_ACT + A_OX);
    const bf16* KX = (const bf16*)(F.ws + WS_KX); const bf16* VTX = (const bf16*)(F.ws + WS_VTX);
    const int w = F.wave, lane = F.lane, r = lane & 31, hh = lane >> 5, tid = F.tid;
    LAS unsigned char* lds = F.lds;
    for (int u = F.bid; u < 512; u += F.G) { const int b = u >> 5, hd = (u >> 3) & 3, qt = u & 7; const size_t tok0 = (size_t)b * SL + 256 * qt;
        { const bf16* src = KX + (size_t)(b * 256) * 4096 + l * 1024 + hd * 256;
          u32x4 stg[16];
#pragma unroll
          for (int i = 0; i < 16; ++i) { const int idx = tid + 512 * i, m = idx >> 5, ch = idx & 31; stg[i] = *(const u32x4*)(src + (size_t)m * 4096 + ch * 8); }
#pragma unroll
          for (int i = 0; i < 16; ++i) { const int idx = tid + 512 * i, m = idx >> 5, ch = idx & 31; *(LAS u32x4*)(lds + m * 528 + ch * 16) = stg[i]; } }
        const bf16* qp = Q + (tok0 + 32 * w + r) * 1024 + hd * 256 + 8 * hh; bf16x8 qa[4], qb[4];
#pragma unroll
        for (int s = 0; s < 4; ++s) qa[s] = *(const bf16x8*)(qp + 16 * s);
        __syncthreads();
        f32x16 st[8];
#pragma unroll
        for (int mt = 0; mt < 8; ++mt) st[mt] = (f32x16){};
#pragma unroll
        for (int sg = 0; sg < 4; ++sg) {
            if (sg < 3) {
#pragma unroll
                for (int s = 0; s < 4; ++s) qb[s] = *(const bf16x8*)(qp + 16 * (4 * (sg + 1) + s)); }
#pragma unroll
            for (int s = 0; s < 4; ++s)
#pragma unroll
                for (int mt = 0; mt < 8; ++mt) st[mt] = MFMA32(*(const LAS bf16x8*)(lds + (32 * mt + r) * 528 + (16 * (4 * sg + s) + 8 * hh) * 2), qa[s], st[mt]);
#pragma unroll
            for (int s = 0; s < 4; ++s) qa[s] = qb[s];
        }
        float mx = -3.0e38f;
#pragma unroll
        for (int mt = 0; mt < 8; ++mt)
#pragma unroll
            for (int q = 0; q < 16; ++q) mx = fmaxf(mx, st[mt][q]);
        mx = fmaxf(mx, __shfl_xor(mx, 32)); float sum = 0.f;
#pragma unroll
        for (int mt = 0; mt < 8; ++mt)
#pragma unroll
            for (int q = 0; q < 16; ++q) { st[mt][q] = __builtin_amdgcn_exp2f(st[mt][q] - mx); sum += st[mt][q]; }
        sum += __shfl_xor(sum, 32); const float inv = __builtin_amdgcn_rcpf(sum);
        bf16x8 pf[8][2];
#pragma unroll
        for (int mt = 0; mt < 8; ++mt)
#pragma unroll
            for (int s2 = 0; s2 < 2; ++s2) pf[mt][s2] = pack_frag(st[mt][8 * s2 + 0], st[mt][8 * s2 + 1], st[mt][8 * s2 + 2], st[mt][8 * s2 + 3], st[mt][8 * s2 + 4], st[mt][8 * s2 + 5], st[mt][8 * s2 + 6], st[mt][8 * s2 + 7]);
        __syncthreads();
        { const bf16* src = VTX + (size_t)(l * 1024 + hd * 256) * 4096 + b * 256;
#pragma unroll 1
          for (int hb = 0; hb < 2; ++hb) { u32x4 stg[8];
#pragma unroll
            for (int i = 0; i < 8; ++i) { const int idx = tid + 512 * (8 * hb + i), d = idx >> 5, ch = idx & 31; stg[i] = *(const u32x4*)(src + (size_t)d * 4096 + ch * 8); }
#pragma unroll
            for (int i = 0; i < 8; ++i) { const int idx = tid + 512 * (8 * hb + i), d = idx >> 5, ch = idx & 31;
                LAS unsigned char* vd_ = lds + d * 528 + (ch >> 1) * 32 + (ch & 1) * 8; *(LAS u32x2*)(vd_) = (u32x2){stg[i].x, stg[i].y}; *(LAS u32x2*)(vd_ + 16) = (u32x2){stg[i].z, stg[i].w}; } } }
        __syncthreads();
        unsigned char* op = (unsigned char*)OX + (tok0 + 32 * w + r) * 1024 + hd * 256; const float inv4 = inv * 4.f;
#pragma unroll 1
        for (int dp = 0; dp < 4; ++dp) { f32x16 o0 = {}, o1 = {};
#pragma unroll
            for (int mt = 0; mt < 8; ++mt)
#pragma unroll
                for (int s2 = 0; s2 < 2; ++s2) { const int mo = (32 * mt + 16 * s2) * 2 + 16 * hh;
                    const LAS unsigned char* a0 = lds + (64 * dp + r) * 528 + mo; const LAS unsigned char* a1 = a0 + 32 * 528;
                    o0 = MFMA32(*(const LAS bf16x8*)a0, pf[mt][s2], o0);
                    o1 = MFMA32(*(const LAS bf16x8*)a1, pf[mt][s2], o1); }
#pragma unroll
            for (int qp = 0; qp < 2; ++qp) {
                const int qa = 2 * qp, qb = 2 * qp + 1;
                const unsigned a0 = pg8::pack_fp8x4(o0[4 * qa] * inv4, o0[4 * qa + 1] * inv4, o0[4 * qa + 2] * inv4, o0[4 * qa + 3] * inv4), b0 = pg8::pack_fp8x4(o0[4 * qb] * inv4, o0[4 * qb + 1] * inv4, o0[4 * qb + 2] * inv4, o0[4 * qb + 3] * inv4);
                const unsigned a1 = pg8::pack_fp8x4(o1[4 * qa] * inv4, o1[4 * qa + 1] * inv4, o1[4 * qa + 2] * inv4, o1[4 * qa + 3] * inv4), b1 = pg8::pack_fp8x4(o1[4 * qb] * inv4, o1[4 * qb + 1] * inv4, o1[4 * qb + 2] * inv4, o1[4 * qb + 3] * inv4);
                const auto r0 = __builtin_amdgcn_permlane32_swap(a0, b0, false, false); const auto r1 = __builtin_amdgcn_permlane32_swap(a1, b1, false, false);
                *(u32x2*)(op + 64 * dp + 8 * (qa + hh)) = (u32x2){r0[0], r0[1]}; *(u32x2*)(op + 64 * dp + 32 + 8 * (qa + hh)) = (u32x2){r1[0], r1[1]}; } }
        __syncthreads();
    }
}

#define DA_SB() __builtin_amdgcn_sched_barrier(0)
__device__ __forceinline__ float da_max3(float a, float b, float c) { return fmaxf(fmaxf(a, b), c); }
__device__ __forceinline__ void dattn_phase(Frame& F, const Args& A, int j, float lambda_init) {
    const bf16* QK = (const bf16*)(F.ws + WS_ACT + A_QK); const bf16* VT = (const bf16*)(F.ws + WS_ACT + A_VTD); bf16* AO = (bf16*)(F.ws + WS_ACT + A_AO);
    const int w = F.wave, lane = F.lane, r = lane & 31, hh = lane >> 5, tid = F.tid, mp = w & 1, ig = w >> 1;
    LAS unsigned char* lds = F.lds;
    LAS float* xb = (LAS float*)(lds) + ig * 4096;
    float lam; { float s1 = 0.f, s2 = 0.f; for (int e = 0; e < 64; ++e) { s1 += A.lq1[j * 64 + e] * A.lk1[j * 64 + e]; s2 += A.lq2[j * 64 + e] * A.lk2[j * 64 + e]; } lam = __expf(s1) - __expf(s2) + lambda_init; }
    lam = __builtin_bit_cast(float, __builtin_amdgcn_readfirstlane(__builtin_bit_cast(int, lam)));
    const int li_s = __builtin_amdgcn_readfirstlane(__builtin_bit_cast(int, lambda_init)); const float* gng = A.od_gn + j * 1024;
    const int srow = tid >> 3, sch = tid & 7;
    const int kfo = mp * 9216 + r * 144 + 16 * hh;
    const int vfo = 36864 + r * 144 + 16 * hh;
    const int stv = srow * 144 + (sch >> 1) * 32 + (sch & 1) * 8;
    const int sto = srow * 144 + sch * 16;
    LAS float* gnl = (LAS float*)(lds + 77824);
    if (tid < 256) *(LAS f32x4*)(gnl + 4 * tid) = *(const f32x4*)(gng + 4 * tid);
    int u = F.bid; if (u >= 2048) { __syncthreads(); return; }
    int b = u >> 7, h = (u >> 4) & 7, qt = u & 15; size_t tok0 = (size_t)b * SL + 128 * qt, kb = (size_t)b * SL;
    bf16x8 qf[4]; u32x4 rk0, rk1, rv0, rv1, rk2, rk3;
    const bf16* k0s = QK + (kb + srow) * 2048 + 1024 + (2 * h) * 64 + sch * 8; const bf16* k1s = k0s + 64;
    const bf16* v0s = VT + (size_t)(h * 128 + srow) * T + kb + sch * 8; const bf16* v1s = v0s + (size_t)64 * T;
    { const bf16* qp = QK + (tok0 + 32 * ig + r) * 2048 + (2 * h + mp) * 64 + 8 * hh;
#pragma unroll
      for (int s = 0; s < 4; ++s) qf[s] = *(const bf16x8*)(qp + 16 * s);
      rk0 = *(const u32x4*)(k0s); rk1 = *(const u32x4*)(k1s); rv0 = *(const u32x4*)(v0s); rv1 = *(const u32x4*)(v1s); rk2 = *(const u32x4*)(k0s + (size_t)64 * 2048); rk3 = *(const u32x4*)(k1s + (size_t)64 * 2048); }
    for (;;) {
#define DA_LDK(t) do { const size_t ko_ = (size_t)(t) * 64 * 2048; rk0 = *(const u32x4*)(k0s + ko_); rk1 = *(const u32x4*)(k1s + ko_); } while (0)
#define DA_LDV(t) do { const size_t vo_ = (size_t)(t) * 64; rv0 = *(const u32x4*)(v0s + vo_); rv1 = *(const u32x4*)(v1s + vo_); } while (0)
#define DA_STK(bf) do { *(LAS u32x4*)(lds + (bf) * 18432 + sto) = rk0; *(LAS u32x4*)(lds + (bf) * 18432 + 9216 + sto) = rk1; } while (0)
#define DA_STV(bf) do { LAS unsigned char* vd_ = lds + 36864 + (bf) * 18432 + stv; *(LAS u32x2*)(vd_) = (u32x2){rv0.x, rv0.y}; *(LAS u32x2*)(vd_ + 16) = (u32x2){rv0.z, rv0.w}; \
        *(LAS u32x2*)(vd_ + 9216) = (u32x2){rv1.x, rv1.y}; *(LAS u32x2*)(vd_ + 9216 + 16) = (u32x2){rv1.z, rv1.w}; } while (0)
        DA_STK(0); DA_STV(0); *(LAS u32x4*)(lds + 18432 + sto) = rk2; *(LAS u32x4*)(lds + 18432 + 9216 + sto) = rk3; DA_LDK(2); DA_LDV(1);
        __syncthreads();
        const f32x16 zero16 = {};
        f32x16 pA0, pA1, pB0, pB1; f32x16 o[4] = {{}, {}, {}, {}}; float m_ref = 0.f, l_run = 0.f;
        { pA0 = zero16; pA1 = zero16;
#pragma unroll
          for (int s = 0; s < 4; ++s) { pA0 = MFMA32(*(const LAS bf16x8*)(lds + kfo + 32 * s), qf[s], pA0); pA1 = MFMA32(*(const LAS bf16x8*)(lds + kfo + 4608 + 32 * s), qf[s], pA1); }
          float rm = -3.0e38f;
#pragma unroll
          for (int q = 0; q < 16; ++q) rm = da_max3(rm, pA0[q], pA1[q]);
          rm = fmaxf(rm, __shfl_xor(rm, 32)); m_ref = rm; }
        __syncthreads();
        bf16x8 pb0, pb1, pb2, pb3;
#define DA_EXP4(P, B) do { P[B] = __builtin_amdgcn_exp2f(P[B] - m_ref); P[B + 1] = __builtin_amdgcn_exp2f(P[B + 1] - m_ref); P[B + 2] = __builtin_amdgcn_exp2f(P[B + 2] - m_ref); P[B + 3] = __builtin_amdgcn_exp2f(P[B + 3] - m_ref); \
        sacc += (P[B] + P[B + 1]) + (P[B + 2] + P[B + 3]); } while (0)
#define DA_PACK(P, B) pack_frag(P[B], P[B + 1], P[B + 2], P[B + 3], P[B + 4], P[B + 5], P[B + 6], P[B + 7])
#define DA_KF(kbn, kt2, s) (*(const LAS bf16x8*)(lds + (kbn) * 18432 + kfo + (kt2) * 4608 + 32 * (s)))
#define DA_VF(vbc, dvt, k2, s2) (*(const LAS bf16x8*)(lds + (vbc) * 18432 + vfo + 4608 * (dvt) + 64 * (k2) + 32 * (s2)))
#define DA_EXP2(P, B) do { P[B] = __builtin_amdgcn_exp2f(P[B] - m_ref); P[B + 1] = __builtin_amdgcn_exp2f(P[B + 1] - m_ref); sacc += P[B] + P[B + 1]; } while (0)
#define DA_STEP(C0, C1, N0, N1, t, HASN) do { const int kbn_ = ((t) + 1) & 1, vbc_ = (t) & 1; float sacc = 0.f; bf16x8 fa_, fb_; \
        if (HASN) fa_ = DA_KF(kbn_, 0, 0); else fa_ = DA_VF(vbc_, 0, 0, 0); \
        DA_SB(); \
        if (HASN) { fb_ = DA_KF(kbn_, 1, 0); N0 = MFMA32(fa_, qf[0], zero16); } DA_EXP2(C0, 0);  DA_SB(); \
        if (HASN) { fa_ = DA_KF(kbn_, 0, 1); N1 = MFMA32(fb_, qf[0], zero16); } DA_EXP2(C0, 2);  DA_SB(); \
        if (HASN) { fb_ = DA_KF(kbn_, 1, 1); N0 = MFMA32(fa_, qf[1], N0); }   DA_EXP2(C0, 4);  DA_SB(); \
        if (HASN) { fa_ = DA_KF(kbn_, 0, 2); N1 = MFMA32(fb_, qf[1], N1); }   DA_EXP2(C0, 6);  pb0 = DA_PACK(C0, 0); DA_SB(); \
        if (HASN) { fb_ = DA_KF(kbn_, 1, 2); N0 = MFMA32(fa_, qf[2], N0); }   DA_EXP2(C0, 8);  DA_SB(); \
        if (HASN) { fa_ = DA_KF(kbn_, 0, 3); N1 = MFMA32(fb_, qf[2], N1); }   DA_EXP2(C0, 10); DA_SB(); \
        if (HASN) { fb_ = DA_KF(kbn_, 1, 3); N0 = MFMA32(fa_, qf[3], N0); }   DA_EXP2(C0, 12); DA_SB(); \
        if (HASN) { fa_ = DA_VF(vbc_, 0, 0, 0); N1 = MFMA32(fb_, qf[3], N1); } DA_EXP2(C0, 14); pb1 = DA_PACK(C0, 8); DA_SB(); \
        float rm0 = -3.0e38f, rm1 = -3.0e38f; \
        fb_ = DA_VF(vbc_, 1, 0, 0); o[0] = MFMA32(fa_, pb0, o[0]); DA_EXP2(C1, 0);  if ((t) + 2 < 32) { DA_STK((t) & 1); } DA_SB(); \
        fa_ = DA_VF(vbc_, 2, 0, 0); o[1] = MFMA32(fb_, pb0, o[1]); DA_EXP2(C1, 2);  if ((t) + 3 < 32) { DA_LDK((t) + 3); } DA_SB(); \
        fb_ = DA_VF(vbc_, 3, 0, 0); o[2] = MFMA32(fa_, pb0, o[2]); DA_EXP2(C1, 4);  DA_SB(); \
        fa_ = DA_VF(vbc_, 0, 0, 1); o[3] = MFMA32(fb_, pb0, o[3]); DA_EXP2(C1, 6);  pb2 = DA_PACK(C1, 0); DA_SB(); \
        fb_ = DA_VF(vbc_, 1, 0, 1); o[0] = MFMA32(fa_, pb1, o[0]); DA_EXP2(C1, 8);  DA_SB(); \
        fa_ = DA_VF(vbc_, 2, 0, 1); o[1] = MFMA32(fb_, pb1, o[1]); DA_EXP2(C1, 10); DA_SB(); \
        fb_ = DA_VF(vbc_, 3, 0, 1); o[2] = MFMA32(fa_, pb1, o[2]); DA_EXP2(C1, 12); DA_SB(); \
        fa_ = DA_VF(vbc_, 0, 1, 0); o[3] = MFMA32(fb_, pb1, o[3]); DA_EXP2(C1, 14); pb3 = DA_PACK(C1, 8); DA_SB(); \
        l_run += sacc; \
        fb_ = DA_VF(vbc_, 1, 1, 0); o[0] = MFMA32(fa_, pb2, o[0]); if (HASN) { rm0 = da_max3(rm0, N0[0], N0[1]); rm1 = da_max3(rm1, N0[2], N0[3]); }     if ((t) + 1 < 32) { DA_STV(((t) + 1) & 1); } DA_SB(); \
        fa_ = DA_VF(vbc_, 2, 1, 0); o[1] = MFMA32(fb_, pb2, o[1]); if (HASN) { rm0 = da_max3(rm0, N0[4], N0[5]); rm1 = da_max3(rm1, N0[6], N0[7]); }     if ((t) + 2 < 32) { DA_LDV((t) + 2); } DA_SB(); \
        fb_ = DA_VF(vbc_, 3, 1, 0); o[2] = MFMA32(fa_, pb2, o[2]); if (HASN) { rm0 = da_max3(rm0, N0[8], N0[9]); rm1 = da_max3(rm1, N0[10], N0[11]); }   DA_SB(); \
        fa_ = DA_VF(vbc_, 0, 1, 1); o[3] = MFMA32(fb_, pb2, o[3]); if (HASN) { rm0 = da_max3(rm0, N0[12], N0[13]); rm1 = da_max3(rm1, N0[14], N0[15]); } DA_SB(); \
        fb_ = DA_VF(vbc_, 1, 1, 1); o[0] = MFMA32(fa_, pb3, o[0]); if (HASN) { rm0 = da_max3(rm0, N1[0], N1[1]); rm1 = da_max3(rm1, N1[2], N1[3]); }     DA_SB(); \
        fa_ = DA_VF(vbc_, 2, 1, 1); o[1] = MFMA32(fb_, pb3, o[1]); if (HASN) { rm0 = da_max3(rm0, N1[4], N1[5]); rm1 = da_max3(rm1, N1[6], N1[7]); }     DA_SB(); \
        fb_ = DA_VF(vbc_, 3, 1, 1); o[2] = MFMA32(fa_, pb3, o[2]); if (HASN) { rm0 = da_max3(rm0, N1[8], N1[9]); rm1 = da_max3(rm1, N1[10], N1[11]); }   DA_SB(); \
        o[3] = MFMA32(fb_, pb3, o[3]); if (HASN) { rm0 = da_max3(rm0, N1[12], N1[13]); rm1 = da_max3(rm1, N1[14], N1[15]); } DA_SB(); \
        if (HASN) { float rm = fmaxf(rm0, rm1); rm = fmaxf(rm, __shfl_xor(rm, 32)) - m_ref; \
            if (__builtin_expect(__any(rm > 8.f), 0)) { const float dl = fmaxf(rm, 0.f), f = __builtin_amdgcn_exp2f(-dl); m_ref += dl; l_run *= f; \
                _Pragma("unroll") for (int d_ = 0; d_ < 4; ++d_) _Pragma("unroll") for (int q = 0; q < 16; ++q) o[d_][q] *= f; } } \
        __syncthreads(); } while (0)
#pragma unroll 1
        for (int t = 0; t < 30; t += 2) { DA_STEP(pA0, pA1, pB0, pB1, t, true); DA_STEP(pB0, pB1, pA0, pA1, t + 1, true); }
        DA_STEP(pA0, pA1, pB0, pB1, 30, true); DA_STEP(pB0, pB1, pA0, pA1, 31, false);
#undef DA_STEP
#undef DA_VF
#undef DA_KF
#undef DA_PACK
#undef DA_EXP4
#undef DA_EXP2
#undef DA_LDK
#undef DA_LDV
#undef DA_STK
#undef DA_STV
        asm volatile("" ::: "memory");
        const int un = u + F.G; const bool has_next = un < 2048;
        const int nb = un >> 7, nh = (un >> 4) & 7, nqt = un & 15; const size_t ntok0 = (size_t)nb * SL + 128 * nqt, nkb = (size_t)nb * SL;
        const bf16* nk0s = QK + (nkb + srow) * 2048 + 1024 + (2 * nh) * 64 + sch * 8; const bf16* nv0s = VT + (size_t)(nh * 128 + srow) * T + nkb + sch * 8;
        if (has_next) { const bf16* qp = QK + (ntok0 + 32 * ig + r) * 2048 + (2 * nh + mp) * 64 + 8 * hh;
#pragma unroll
            for (int s = 0; s < 4; ++s) qf[s] = *(const bf16x8*)(qp + 16 * s);
            rk0 = *(const u32x4*)(nk0s); rk1 = *(const u32x4*)(nk0s + 64); rv0 = *(const u32x4*)(nv0s); rv1 = *(const u32x4*)(nv0s + (size_t)64 * T);
            rk2 = *(const u32x4*)(nk0s + (size_t)64 * 2048); rk3 = *(const u32x4*)(nk0s + 64 + (size_t)64 * 2048); }
        l_run += __shfl_xor(l_run, 32); const float inv = __builtin_amdgcn_rcpf(l_run);
        if (mp == 1) {
#pragma unroll
            for (int dvt = 0; dvt < 4; ++dvt)
#pragma unroll
                for (int q = 0; q < 16; ++q) xb[(dvt * 16 + q) * 64 + lane] = o[dvt][q] * inv; }
        __syncthreads();
        if (mp == 0) { float ss = 0.f;
#pragma unroll
            for (int dvt = 0; dvt < 4; ++dvt)
#pragma unroll
                for (int q = 0; q < 16; ++q) { o[dvt][q] = o[dvt][q] * inv - lam * xb[(dvt * 16 + q) * 64 + lane]; ss += o[dvt][q] * o[dvt][q]; }
            int lt_ = li_s; asm volatile("" : "+s"(lt_)); const float li_ = __builtin_bit_cast(float, lt_);
            ss += __shfl_xor(ss, 32); const float rms = rsqrtf(ss * (1.f / 128.f) + EPS) * (1.f - li_);
            bf16* op = AO + (tok0 + 32 * ig + r) * 1024 + h * 128;
#pragma unroll
            for (int dvt = 0; dvt < 4; ++dvt) { u32x2 wq[4];
#pragma unroll
                for (int q4 = 0; q4 < 4; ++q4) { const int dv0 = 32 * dvt + 8 * q4 + 4 * hh; const f32x4 gn = *(const LAS f32x4*)(gnl + h * 128 + dv0);
                    wq[q4].x = pk2(o[dvt][4 * q4] * rms * gn[0], o[dvt][4 * q4 + 1] * rms * gn[1]); wq[q4].y = pk2(o[dvt][4 * q4 + 2] * rms * gn[2], o[dvt][4 * q4 + 3] * rms * gn[3]); }
#pragma unroll
                for (int qp = 0; qp < 2; ++qp) {
                    const auto rx = __builtin_amdgcn_permlane32_swap(wq[2 * qp].x, wq[2 * qp + 1].x, false, false); const auto ry = __builtin_amdgcn_permlane32_swap(wq[2 * qp].y, wq[2 * qp + 1].y, false, false);
                    *(u32x4*)(op + 32 * dvt + 8 * (2 * qp + hh)) = (u32x4){rx[0], ry[0], rx[1], ry[1]}; } } }
        __syncthreads();
        if (!has_next) break;
        u = un; b = nb; h = nh; qt = nqt; tok0 = ntok0; kb = nkb; k0s = nk0s; k1s = nk0s + 64; v0s = nv0s; v1s = nv0s + (size_t)64 * T;
    }
}
#undef DA_SB

__device__ __forceinline__ void router_phase(Frame& F, const Args& A, int i  , int j, int jc) {
    LAS int* lcnt = (LAS int*)(F.lds); LAS int* lbase = lcnt + 8;
    LAS f32x4* wl = (LAS f32x4*)(F.lds + 1024);
    const bf16* X = (const bf16*)(F.ws + WS_XB); const float* ssq = (const float*)(F.ws + WS_SSQ); const float* Wr = A.router + (size_t)j * D * NE; const float* gf = A.ffn_g + i * D;
    int* list = (int*)(F.ws + WS_MISC + MISC_LIST); float* gate = (float*)(F.ws + WS_MISC + MISC_GATE); int* epos = (int*)(F.ws + WS_MISC + MISC_EPOS);
    for (int idx = F.tid; idx < 2048; idx += NTHR) { const int ln = idx & 63, kk2 = idx >> 6, k = 4 * ln + 256 * (kk2 >> 3) + ((kk2 >> 1) & 3);
        wl[idx] = *(const f32x4*)(Wr + (size_t)k * 8 + 4 * (kk2 & 1)) * gf[k]; }
    if (F.tid < 8) lcnt[F.tid] = 0;
    __syncthreads();
    const bool h5 = (F.lane & 32) != 0, h4 = (F.lane & 16) != 0, h3 = (F.lane & 8) != 0, h2 = (F.lane & 4) != 0, h1 = (F.lane & 2) != 0, h0 = (F.lane & 1) != 0;
    for (int grp = F.bid; grp < T / 128; grp += F.G) {
        int my_e0 = 0, my_e1 = 0; float my_g0 = 0.f, my_g1 = 0.f;
#pragma unroll 1
        for (int bt = 0; bt < 2; ++bt) {
            const int tok0 = grp * 128 + F.wave * 16 + bt * 8;
            asm volatile("" ::: "memory");
            u32x2 xw[8][4];
#pragma unroll
            for (int s = 0; s < 8; ++s)
#pragma unroll
                for (int q = 0; q < 4; ++q) xw[s][q] = *(const u32x2*)(X + (size_t)(tok0 + s) * D + 4 * F.lane + 256 * q);
            const u32x2 spw = *(const u32x2*)(ssq + (size_t)(tok0 + (F.lane >> 3)) * 16 + 2 * (F.lane & 7));
            f32x4 acc[8][2];
#pragma unroll
            for (int s = 0; s < 8; ++s) { acc[s][0] = f32x4{0.f, 0.f, 0.f, 0.f}; acc[s][1] = f32x4{0.f, 0.f, 0.f, 0.f}; }
#pragma unroll
            for (int q = 0; q < 4; ++q)
#pragma unroll
                for (int e4 = 0; e4 < 4; ++e4) { const f32x4 w0 = wl[((q * 4 + e4) * 2 + 0) * 64 + F.lane], w1 = wl[((q * 4 + e4) * 2 + 1) * 64 + F.lane];
#pragma unroll
                    for (int s = 0; s < 8; ++s) { const unsigned wd = (e4 < 2) ? xw[s][q].x : xw[s][q].y; const float xv = __builtin_bit_cast(float, (e4 & 1) ? (wd & 0xffff0000u) : (wd << 16));
                        acc[s][0] += w0 * xv; acc[s][1] += w1 * xv; } }
            float v32[32], v16[16], v8[8], v4[4], v2[2];
#pragma unroll
            for (int v = 0; v < 32; ++v) { const float lo = acc[v >> 3][(v >> 2) & 1][v & 3], hi = acc[(v >> 3) + 4][(v >> 2) & 1][v & 3]; v32[v] = (h5 ? hi : lo) + __shfl_xor(h5 ? lo : hi, 32); }
#pragma unroll
            for (int v = 0; v < 16; ++v) v16[v] = (h4 ? v32[v + 16] : v32[v]) + __shfl_xor(h4 ? v32[v] : v32[v + 16], 16);
#pragma unroll
            for (int v = 0; v < 8; ++v) v8[v] = (h3 ? v16[v + 8] : v16[v]) + __shfl_xor(h3 ? v16[v] : v16[v + 8], 8);
#pragma unroll
            for (int v = 0; v < 4; ++v) v4[v] = (h2 ? v8[v + 4] : v8[v]) + __shfl_xor(h2 ? v8[v] : v8[v + 4], 4);
#pragma unroll
            for (int v = 0; v < 2; ++v) v2[v] = (h1 ? v4[v + 2] : v4[v]) + __shfl_xor(h1 ? v4[v] : v4[v + 2], 2);
            const float tot = (h0 ? v2[1] : v2[0]) + __shfl_xor(h0 ? v2[0] : v2[1], 1);
            float p = __builtin_bit_cast(float, spw.x) + __builtin_bit_cast(float, spw.y); p += __shfl_xor(p, 1); p += __shfl_xor(p, 2); p += __shfl_xor(p, 4);
            float m1 = tot * rsqrtf(p * (1.f / D) + EPS), m2 = -3.0e38f; int i1 = F.lane & 7, i2 = -1;
#pragma unroll
            for (int M = 1; M < 8; M <<= 1) {
                const float pm1 = __shfl_xor(m1, M), pm2 = __shfl_xor(m2, M); const int pi1 = __shfl_xor(i1, M), pi2 = __shfl_xor(i2, M);
                const bool ab = (m1 > pm1) || (m1 == pm1 && i1 < pi1);
                const float wm = ab ? m1 : pm1, lm = ab ? pm1 : m1, sm = ab ? m2 : pm2; const int wi = ab ? i1 : pi1, li = ab ? pi1 : i1, si = ab ? i2 : pi2;
                const bool ls = (lm > sm) || (lm == sm && li < si);
                m1 = wm; i1 = wi; m2 = ls ? lm : sm; i2 = ls ? li : si; }
            const float w1 = 1.f / (1.f + __expf(m2 - m1));
            const int src = 8 * (F.lane & 7); const int ri1 = __shfl(i1, src), ri2 = __shfl(i2, src); const float rw = __shfl(w1, src);
            if ((F.lane >> 3) == bt) { my_e0 = ri1; my_e1 = ri2; my_g0 = rw; my_g1 = 1.f - rw; } }
        int p0 = 0, p1 = 0;
        if (F.lane < 16) { p0 = atomicAdd((int*)&lcnt[my_e0], 1); p1 = atomicAdd((int*)&lcnt[my_e1], 1); }
        __syncthreads();
        if (F.tid < 8) lbase[F.tid] = (int)__hip_atomic_fetch_add((unsigned*)(F.ctl + CW_CNT + jc * 1024 + 64 * F.tid), (unsigned)lcnt[F.tid], RLX_AGENT);
        __syncthreads();
        if (F.lane < 16) { const int tok = grp * 128 + F.wave * 16 + F.lane; const int q0 = lbase[my_e0] + p0, q1 = lbase[my_e1] + p1;
            list[(size_t)my_e0 * T + q0] = tok * 2; list[(size_t)my_e1 * T + q1] = tok * 2 + 1;
            epos[tok * 2] = (my_e0 << 20) | q0; epos[tok * 2 + 1] = (my_e1 << 20) | q1; gate[tok * 2] = my_g0; gate[tok * 2 + 1] = my_g1; }
        __syncthreads();
        if (F.tid < 8) lcnt[F.tid] = 0;
        __syncthreads();
    }
}
struct TileBase { int tb[9]; int cnt[8]; };
__device__ __forceinline__ void load_tilebase(Frame& F, int j, TileBase& B) {
    int run = 0;
#pragma unroll
    for (int e = 0; e < 8; ++e) { const int c = (int)__hip_atomic_load((unsigned*)(F.ctl + CW_CNT + j * 1024 + 64 * e), RLX_AGENT); B.cnt[e] = c; B.tb[e] = run; run += (c + 255) >> 8; }
    B.tb[8] = run;
}
__device__ __forceinline__ void gather_phase(Frame& F, int j) {
    TileBase B; load_tilebase(F, j, B);
    const bf16* XB = (const bf16*)(F.ws + WS_XB); unsigned char* XS = F.ws + WS_ACT + A_XS; const float* ssq = (const float*)(F.ws + WS_SSQ);
    const int* list = (const int*)(F.ws + WS_MISC + MISC_LIST); int* yrow = (int*)(F.ws + WS_MISC + MISC_YROW);
    const int gw = F.bid * NWAVES + F.wave, NGW = F.G * NWAVES, nrows = B.tb[8] * 256;
    const int my_rr = 2 * gw + 2 * NGW * (F.lane >> 1) + (F.lane & 1); int my_tk = -1; float my_rs = 0.f;
    if (my_rr < nrows) { const int gt = my_rr >> 8; int e = 0, tbe = 0, ce = B.cnt[0];
#pragma unroll
        for (int k = 1; k < 8; ++k) if (gt >= B.tb[k]) { e = k; tbe = B.tb[k]; ce = B.cnt[k]; }
        const int posr = my_rr - tbe * 256;
        if (posr < ce) { my_tk = list[(size_t)e * T + posr]; const f32x4* sp = (const f32x4*)(ssq + (size_t)(my_tk >> 1) * 16);
            const f32x4 s0 = sp[0], s1 = sp[1], s2 = sp[2], s3 = sp[3];
            const float pp = ((s0[0] + s0[1]) + (s0[2] + s0[3])) + ((s1[0] + s1[1]) + (s1[2] + s1[3])) + ((s2[0] + s2[1]) + (s2[2] + s2[3])) + ((s3[0] + s3[1]) + (s3[2] + s3[3]));
            my_rs = rsqrtf(pp * (1.f / D) + EPS); yrow[my_tk] = my_rr; } }
#define GA_LOAD(V0, V1, RS, k_) do { _Pragma("unroll") for (int s = 0; s < 4; ++s) { const int li = 2 * (k_) + s; const int tks = __builtin_amdgcn_readlane(my_tk, li & 63); \
            RS[s] = __builtin_bit_cast(float, __builtin_amdgcn_readlane(__builtin_bit_cast(int, my_rs), li & 63)); \
            const u32x4* src = (const u32x4*)(XB + (size_t)((tks < 0 ? 0 : tks) >> 1) * D) + F.lane; V0[s] = src[0]; V1[s] = src[64]; } } while (0)
#define BFLO(w) (__builtin_bit_cast(float, (w) << 16) * rsx)
#define BFHI(w) (__builtin_bit_cast(float, (w) & 0xffff0000u) * rsx)
#define GA_PROC(V0, V1, RS, k_) do { _Pragma("unroll") for (int s = 0; s < 4; ++s) { const int rr = 2 * gw + 2 * NGW * ((k_) + (s >> 1)) + (s & 1); if (rr < nrows) { const float rsx = RS[s]; u32x2 o0, o1; \
                o0.x = pg8::pack_fp8x4(BFLO(V0[s].x), BFHI(V0[s].x), BFLO(V0[s].y), BFHI(V0[s].y)); o0.y = pg8::pack_fp8x4(BFLO(V0[s].z), BFHI(V0[s].z), BFLO(V0[s].w), BFHI(V0[s].w)); \
                o1.x = pg8::pack_fp8x4(BFLO(V1[s].x), BFHI(V1[s].x), BFLO(V1[s].y), BFHI(V1[s].y)); o1.y = pg8::pack_fp8x4(BFLO(V1[s].z), BFHI(V1[s].z), BFLO(V1[s].w), BFHI(V1[s].w)); \
                u32x2* dst = (u32x2*)(XS + (size_t)rr * D) + F.lane; dst[0] = o0; dst[64] = o1; } } } while (0)
    { u32x4 a0[4], a1[4], b0[4], b1[4]; float ars[4], brs[4];
      GA_LOAD(a0, a1, ars, 0);
#pragma unroll 1
      for (int k = 0; 2 * gw + 2 * NGW * k < nrows; k += 4) {
        GA_LOAD(b0, b1, brs, k + 2);
        GA_PROC(a0, a1, ars, k);
        GA_LOAD(a0, a1, ars, k + 4);
        GA_PROC(b0, b1, brs, k + 2); } }
#undef GA_PROC
#undef GA_LOAD
#undef BFHI
#undef BFLO
}
__device__ __forceinline__ void combine_phase(Frame& F, const Args& A, bool last, int dry = 0) {
    const bf16* Y = (const bf16*)(F.ws + WS_ACT + A_Y); const int* yrow = (const int*)(F.ws + WS_MISC + MISC_YROW); const float* gate = (const float*)(F.ws + WS_MISC + MISC_GATE);
    const int gw = F.bid * NWAVES + F.wave, NGW = F.G * NWAVES;
    const bool h5 = (F.lane & 32) != 0, h4 = (F.lane & 16) != 0;
    for (int base = gw * 16; base < T; base += NGW * 16) {
        u32x2 yr = {0u, 0u}, gg = {0u, 0u};
        if (F.lane < 16) { yr = *(const u32x2*)(yrow + 2 * (base + F.lane)); gg = *(const u32x2*)(gate + 2 * (base + F.lane)); }
#pragma unroll 1
        for (int b4 = 0; b4 < 4; ++b4) { const int m0 = base + b4 * 4;
            u32x2 xw[4][4], ya[4][4], yb[4][4]; float g0[4], g1[4];
#pragma unroll
            for (int s = 0; s < 4; ++s) { const int tl = b4 * 4 + s; const int r0 = __builtin_amdgcn_readlane((int)yr.x, tl), r1 = __builtin_amdgcn_readlane((int)yr.y, tl);
                g0[s] = __builtin_bit_cast(float, __builtin_amdgcn_readlane((int)gg.x, tl)); g1[s] = __builtin_bit_cast(float, __builtin_amdgcn_readlane((int)gg.y, tl));
                const u32x2* xr = (const u32x2*)((const bf16*)(F.ws + WS_XB) + (size_t)(m0 + s) * D) + F.lane; const u32x2* y0 = (const u32x2*)(Y + (size_t)r0 * D) + F.lane; const u32x2* y1 = (const u32x2*)(Y + (size_t)r1 * D) + F.lane;
#pragma unroll
                for (int q = 0; q < 4; ++q) { xw[s][q] = xr[64 * q]; ya[s][q] = y0[64 * q]; yb[s][q] = y1[64 * q]; } }
            f32x4 v[4][4]; float sq[4];
#pragma unroll
            for (int s = 0; s < 4; ++s) { sq[s] = 0.f;
#pragma unroll
                for (int q = 0; q < 4; ++q) { const u32x2 x = xw[s][q], a = ya[s][q], b = yb[s][q];
                    v[s][q][0] = __builtin_bit_cast(float, x.x << 16) + g0[s] * __builtin_bit_cast(float, a.x << 16) + g1[s] * __builtin_bit_cast(float, b.x << 16);
                    v[s][q][1] = __builtin_bit_cast(float, x.x & 0xffff0000u) + g0[s] * __builtin_bit_cast(float, a.x & 0xffff0000u) + g1[s] * __builtin_bit_cast(float, b.x & 0xffff0000u);
                    v[s][q][2] = __builtin_bit_cast(float, x.y << 16) + g0[s] * __builtin_bit_cast(float, a.y << 16) + g1[s] * __builtin_bit_cast(float, b.y << 16);
                    v[s][q][3] = __builtin_bit_cast(float, x.y & 0xffff0000u) + g0[s] * __builtin_bit_cast(float, a.y & 0xffff0000u) + g1[s] * __builtin_bit_cast(float, b.y & 0xffff0000u);
                    if (!last) {
#pragma unroll
                        for (int e = 0; e < 4; ++e) v[s][q][e] = bf2f((bf16)f2bf(v[s][q][e])); }
                    sq[s] += (v[s][q][0] * v[s][q][0] + v[s][q][1] * v[s][q][1]) + (v[s][q][2] * v[s][q][2] + v[s][q][3] * v[s][q][3]); } }
            const float t0 = (h5 ? sq[2] : sq[0]) + __shfl_xor(h5 ? sq[0] : sq[2], 32), t1 = (h5 ? sq[3] : sq[1]) + __shfl_xor(h5 ? sq[1] : sq[3], 32);
            float tt = (h4 ? t1 : t0) + __shfl_xor(h4 ? t0 : t1, 16);
            tt += __shfl_xor(tt, 8); tt += __shfl_xor(tt, 4); tt += __shfl_xor(tt, 2); tt += __shfl_xor(tt, 1);
#pragma unroll
            for (int s = 0; s < 4; ++s) { const int m = m0 + s; const float ssum = __builtin_bit_cast(float, __builtin_amdgcn_readlane(__builtin_bit_cast(int, tt), 16 * s));
                if (last && !dry) { const float rs = rsqrtf(ssum * (1.f / D) + EPS); const f32x4* gr = (const f32x4*)A.fin_g + F.lane;
                    f32x4* orow = (f32x4*)(A.out + (size_t)m * D) + F.lane;
#pragma unroll
                    for (int q = 0; q < 4; ++q) { const f32x4 g = gr[64 * q]; f32x4 o; o[0] = v[s][q][0] * rs * g[0]; o[1] = v[s][q][1] * rs * g[1]; o[2] = v[s][q][2] * rs * g[2]; o[3] = v[s][q][3] * rs * g[3]; orow[64 * q] = o; } }
                else { u32x2* xo = dry ? (u32x2*)((bf16*)(F.ws + WS_ACT) + (size_t)m * D) + F.lane : (u32x2*)((bf16*)(F.ws + WS_XB) + (size_t)m * D) + F.lane; float* sw = dry ? (float*)(F.ws + WS_ACT + 64 * MiB) : (float*)(F.ws + WS_SSQ);
#pragma unroll
                    for (int q = 0; q < 4; ++q) { u32x2 wv; wv.x = pk2(v[s][q][0], v[s][q][1]); wv.y = pk2(v[s][q][2], v[s][q][3]); xo[64 * q] = wv; }
                    if (F.lane < 16) sw[(size_t)m * 16 + F.lane] = (F.lane == 0) ? ssum : 0.f; } }
        }
    }
}

#if DBG
struct Ck { float num, den; };
__device__ __forceinline__ float f8tof(unsigned char b) { const int s = b >> 7, e = (b >> 3) & 15, m = b & 7; float v = (e == 0) ? (float)m * 0.001953125f : (1.f + (float)m * 0.125f) * exp2f((float)(e - 7)); return s ? -v : v; }
__device__ __forceinline__ unsigned hsh(unsigned x) { x ^= x >> 16; x *= 0x7feb352dU; x ^= x >> 15; x *= 0x846ca68bU; x ^= x >> 16; return x; }
__device__ __forceinline__ void ck_acc(Ck& c, float got, float ref) { const float d = got - ref; c.num += (d == d && fabsf(d) < 1e18f) ? d * d : 1e30f; c.den += ref * ref; }
__device__ __forceinline__ void ck_flush(Frame& F, int stage, Ck c) { const float n = wave_sum(c.num), d = wave_sum(c.den);
    if (F.lane == 0) { atomicAdd((float*)(F.ctl + CW_CHK) + stage * 2, n); atomicAdd((float*)(F.ctl + CW_CHK) + stage * 2 + 1, d); } }
__device__ __forceinline__ float rs_naive(const bf16* X, int t) { float s = 0.f; for (int k = 0; k < D; ++k) { const float v = bf2f(X[(size_t)t * D + k]); s += v * v; } return rsqrtf(s * (1.f / D) + EPS); }
__device__ __forceinline__ float dotx(const bf16* X, int t, const float* gk, const float* W, int ldw, int wc) { float s = 0.f; for (int k = 0; k < D; ++k) s += bf2f(X[(size_t)t * D + k]) * gk[k] * W[(size_t)k * ldw + wc]; return s; }
__device__ __forceinline__ void sc_acc(int pos, float invf, float& sn, float& cs) { double rv = (double)pos * (double)invf * 0.15915494309189535; rv -= floor(rv); sn = __builtin_amdgcn_sinf((float)rv); cs = __builtin_amdgcn_cosf((float)rv); }
#define CK_LOOP(NS) for (unsigned s_ = (unsigned)(F.bid * NTHR + F.tid); s_ < (unsigned)(NS); s_ += (unsigned)(F.G * NTHR))

__device__ __forceinline__ void ck_proj(Frame& F, const Args& A, int stage, int mode, int i, int j) {
    Ck c = {0.f, 0.f}; const bf16* X = (const bf16*)(F.ws + WS_XB);
    CK_LOOP(4096) { const unsigned h1 = hsh(s_ * 2u + 1u + 977u * (unsigned)stage), h2 = hsh(h1 + 12345u); const int t = (int)(h1 % T); float got, ref;
        const float rs = rs_naive(X, t); const int pos = A.pos[t];
        if (mode == 1) { const int cn = (int)(h2 % 4096); const float* W = A.ev_w_in + (size_t)j * D * 3584; const float* g = A.mix_g + i * D; got = bf2f(((const bf16*)(F.ws + WS_ACT + A_PE))[(size_t)t * PEW + cn]);
            if (cn < 1536) ref = rs * dotx(X, t, g, W, 3584, cn);
            else if (cn >= 2560 && cn < 3072) ref = rs * dotx(X, t, g, W, 3584, cn + 512);
            else { const bool bcopy = cn >= 3072; const int cf_ = bcopy ? cn - 1536 : cn; const int base = cf_ & ~63, cp = cf_ & 63, gg = cp >> 3, s = cp & 7, jj = 4 * gg + (s & 3);
                const float x1 = rs * dotx(X, t, g, W, 3584, base + jj), x2 = rs * dotx(X, t, g, W, 3584, base + 32 + jj); float sn, cs; sc_acc(pos, exp2f(-(float)jj * (13.287712379549449f / 32.f)), sn, cs);
                const bool isk = cf_ >= 2048; const int head = (cf_ & 511) >> 6, l = t & (SL - 1), lm = isk ? (l & 63) : (l & 31);
                const float lgf = -__expf(A.ev_df[j * 8 + head]), lgb = -__expf(A.ev_db[j * 8 + head]);
                const float dec = bcopy ? __expf(lgb * (float)(isk ? lm : -lm)) : __expf(lgf * (float)(isk ? -lm : lm));
                ref = ((s < 4) ? x1 * cs - x2 * sn : x1 * sn + x2 * cs) * (isk ? 0.125f : 1.f) * dec; } }
        else if (mode == 2) { const int cn = (int)(h2 % 2048); const float* W = A.od_w_in + (size_t)j * D * 3072; const float* g = A.mix_g + i * D; got = bf2f(((const bf16*)(F.ws + WS_ACT + A_QK))[(size_t)t * QKP + cn]);
            const int base = cn & ~63, cp = cn & 63; const float sc = (cn < 1024) ? 0.125f * LOG2E : 1.f;
            if (cp < 16) { const int gg = cp >> 3, s = cp & 7, jj = 4 * gg + (s & 3);
                const float x1 = rs * dotx(X, t, g, W, 3072, base + jj), x2 = rs * dotx(X, t, g, W, 3072, base + 8 + jj); float sn, cs; sc_acc(pos, exp2f(-(float)jj * (18.931568569324174f / 8.f)), sn, cs);
                ref = ((s < 4) ? x1 * cs - x2 * sn : x1 * sn + x2 * cs) * sc; }
            else ref = rs * dotx(X, t, g, W, 3072, cn) * sc; }
        else if (mode == 3) { const int cn = (int)(h2 % 1024); got = bf2f(((const bf16*)(F.ws + WS_ACT + A_QX))[(size_t)t * 1024 + cn]);
            ref = rs * dotx(X, t, A.xa_g + i * D, A.xa_wq + (size_t)i * D * D, D, cn) * (LOG2E / 16.f); }
        else { const int cn = (int)(h2 % FF); got = f8tof((F.ws + WS_ACT + A_H)[(size_t)t * FF + cn]) * (1.f / MOE_HSCALE); const float* g = A.ffn_g + i * D;
            const float a = rs * dotx(X, t, g, A.ffd_g + (size_t)j * D * FF, FF, cn), b = rs * dotx(X, t, g, A.ffd_u + (size_t)j * D * FF, FF, cn); ref = a / (1.f + __expf(-a)) * b; }
        ck_acc(c, got, ref); }
    ck_flush(F, stage, c);
}
__device__ __forceinline__ void ck_swapped(Frame& F, const Args& A, int stage, int mode, int i, int j) {
    Ck c = {0.f, 0.f}; const bf16* X = (const bf16*)(F.ws + WS_XB);
    CK_LOOP(4096) { const unsigned h1 = hsh(s_ * 2u + 7u + 977u * (unsigned)stage), h2 = hsh(h1 + 999u); const int t = (int)(h1 % T), R = (int)(h2 % 1024);
        const float rs = rs_naive(X, t); const float* g = A.mix_g + i * D;
        if (mode == 0) { const float ref = rs * dotx(X, t, g, A.od_w_in + (size_t)j * D * 3072, 3072, 2048 + R); ck_acc(c, bf2f(((const bf16*)(F.ws + WS_ACT + A_VTD))[(size_t)R * VTP + t]), ref); }
        else { const float* W = A.ev_w_in + (size_t)j * D * 3584; const int Rv = R & 511;
            const float ref = rs * dotx(X, t, g, W, 3584, 2560 + Rv); ck_acc(c, bf2f(((const bf16*)(F.ws + WS_ACT + A_VTE))[(size_t)Rv * T + t]), ref); } }
    ck_flush(F, stage, c);
}
__device__ __forceinline__ void ck_res(Frame& F, const Args& A, int stage, const bf16* act, int K, const float* W, const bf16* xprev, bool f8act = false) {
    Ck c = {0.f, 0.f}, c2 = {0.f, 0.f};
    CK_LOOP(4096) { const unsigned h1 = hsh(s_ * 2u + 3u + 977u * (unsigned)stage), h2 = hsh(h1 + 4242u); const int t = (int)(h1 % T), cn = (int)(h2 % D);
        float s = 0.f; for (int k = 0; k < K; ++k) s += (f8act ? f8tof(((const unsigned char*)act)[(size_t)t * K + k]) * (1.f / MOE_HSCALE) : bf2f(act[(size_t)t * K + k])) * W[(size_t)k * D + cn];
        const float ref = bf2f(xprev[(size_t)t * D + cn]) + s, got = bf2f(((const bf16*)(F.ws + WS_XB))[(size_t)t * D + cn]); ck_acc(c, got, ref);
        float ss = 0.f; for (int k = 0; k < D; ++k) { const float v = bf2f(((const bf16*)(F.ws + WS_XB))[(size_t)t * D + k]); ss += v * v; }
        float sp = 0.f; for (int k = 0; k < 16; ++k) sp += ((const float*)(F.ws + WS_SSQ))[(size_t)t * 16 + k];
        ck_acc(c2, sp, ss); }
    ck_flush(F, stage, c); ck_flush(F, stage + 1, c2);
}
__device__ __forceinline__ void ck_memkv(Frame& F, const Args& A, int stage) {
    Ck c = {0.f, 0.f};
    CK_LOOP(4096) { const unsigned h1 = hsh(s_ * 2u + 5u), h2 = hsh(h1 + 77u); const int r = (int)(h1 % MT), cn = (int)(h2 % 4096), l = cn >> 10, n = cn & 1023; const int which = (int)((h2 >> 16) & 1);
        float ss = 0.f; for (int k = 0; k < D; ++k) { const float v = A.mem[(size_t)r * D + k]; ss += v * v; } const float rs = rsqrtf(ss * (1.f / D) + EPS);
        float s = 0.f; for (int k = 0; k < D; ++k) s += A.mem[(size_t)r * D + k] * rs * A.mem_g[k] * A.xa_wkv[((size_t)l * D + k) * 2 * D + which * D + n];
        const float got = which ? bf2f(((const bf16*)(F.ws + WS_VTX))[(size_t)cn * 4096 + r]) : bf2f(((const bf16*)(F.ws + WS_KX))[(size_t)r * 4096 + cn]);
        ck_acc(c, got, s); }
    ck_flush(F, stage, c);
}
__device__ __forceinline__ void ck_xattn(Frame& F, const Args& A, int stage, int l) {
    Ck c = {0.f, 0.f}; const bf16* Q = (const bf16*)(F.ws + WS_ACT + A_QX); const bf16* KX = (const bf16*)(F.ws + WS_KX); const bf16* VTX = (const bf16*)(F.ws + WS_VTX);
    CK_LOOP(2048) { const unsigned h1 = hsh(s_ * 2u + 9u + 977u * (unsigned)stage), h2 = hsh(h1 + 31u); const int t = (int)(h1 % T), cn = (int)(h2 % D), hd = cn >> 8, b = t >> 11;
        float m = -3e38f, lsum = 0.f, o = 0.f;
        for (int mm = 0; mm < 256; ++mm) { float s = 0.f; for (int d = 0; d < 256; ++d) s += bf2f(Q[(size_t)t * D + hd * 256 + d]) * bf2f(KX[(size_t)(b * 256 + mm) * 4096 + l * 1024 + hd * 256 + d]);
            const float mn = fmaxf(m, s), al = exp2f(m - mn), p = exp2f(s - mn); lsum = lsum * al + p; o = o * al + p * bf2f(VTX[(size_t)(l * 1024 + cn) * 4096 + b * 256 + mm]); m = mn; }
        ck_acc(c, bf2f(((const bf16*)(F.ws + WS_ACT + A_OX))[(size_t)t * D + cn]), o / lsum); }
    ck_flush(F, stage, c);
}
__device__ __forceinline__ void ck_dattn(Frame& F, const Args& A, int stage, int j, float lambda_init) {
    Ck c = {0.f, 0.f}; const bf16* QK = (const bf16*)(F.ws + WS_ACT + A_QK); const bf16* VT = (const bf16*)(F.ws + WS_ACT + A_VTD); const bf16* AO = (const bf16*)(F.ws + WS_ACT + A_AO);
    LAS float* sc = (LAS float*)(F.lds) + F.wave * 4096;
    float lam; { float s1 = 0.f, s2 = 0.f; for (int e = 0; e < 64; ++e) { s1 += A.lq1[j * 64 + e] * A.lk1[j * 64 + e]; s2 += A.lq2[j * 64 + e] * A.lk2[j * 64 + e]; } lam = __expf(s1) - __expf(s2) + lambda_init; }
    const int gw = F.bid * NWAVES + F.wave;
    for (int smp = gw; smp < 512; smp += F.G * NWAVES) { const unsigned h1 = hsh((unsigned)smp * 2u + 11u + 977u * (unsigned)stage); const int t = (int)(h1 % T), h = (int)((h1 >> 20) & 7), b = t >> 11; const size_t kb = (size_t)b * SL;
        float mx[2] = {-3e38f, -3e38f};
        for (int kk = 0; kk < 32; ++kk) { const int key = F.lane + 64 * kk;
#pragma unroll
            for (int mp = 0; mp < 2; ++mp) { float s = 0.f; for (int d = 0; d < 64; ++d) s += bf2f(QK[(size_t)t * QKP + (2 * h + mp) * 64 + d]) * bf2f(QK[(kb + key) * QKP + 1024 + (2 * h + mp) * 64 + d]);
                sc[mp * 2048 + key] = s; mx[mp] = fmaxf(mx[mp], s); } }
        LDS_WAIT(); const float m0 = wave_max(mx[0]), m1 = wave_max(mx[1]); float l0 = 0.f, l1 = 0.f;
        for (int kk = 0; kk < 32; ++kk) { const int key = F.lane + 64 * kk; const float p0 = exp2f(sc[key] - m0), p1 = exp2f(sc[2048 + key] - m1); sc[key] = p0; sc[2048 + key] = p1; l0 += p0; l1 += p1; }
        LDS_WAIT(); l0 = wave_sum(l0); l1 = wave_sum(l1);
        float v[2], ss = 0.f;
#pragma unroll
        for (int e = 0; e < 2; ++e) { const int dv = F.lane + 64 * e; float o0 = 0.f, o1 = 0.f;
            for (int key = 0; key < 2048; ++key) { const float vv = bf2f(VT[(size_t)(h * 128 + dv) * VTP + kb + key]); o0 += sc[key] * vv; o1 += sc[2048 + key] * vv; }
            v[e] = o0 / l0 - lam * o1 / l1; ss += v[e] * v[e]; }
        ss = wave_sum(ss); const float rms = rsqrtf(ss * (1.f / 128.f) + EPS) * (1.f - lambda_init);
#pragma unroll
        for (int e = 0; e < 2; ++e) { const int dv = F.lane + 64 * e; ck_acc(c, bf2f(AO[(size_t)t * D + h * 128 + dv]), v[e] * rms * A.od_gn[j * 1024 + h * 128 + dv]); }
        LDS_WAIT(); }
    ck_flush(F, stage, c);
}
__device__ __forceinline__ void ck_ret(Frame& F, const Args& A, int stage, int j) {
    Ck c = {0.f, 0.f}, c2 = {0.f, 0.f}; const bf16* PE = (const bf16*)(F.ws + WS_ACT + A_PE); const bf16* VT = (const bf16*)(F.ws + WS_ACT + A_VTE); const bf16* R = (const bf16*)(F.ws + WS_ACT + A_R);
    LAS float* sc = (LAS float*)(F.lds) + F.wave * 2048;
    const int gw = F.bid * NWAVES + F.wave;
    for (int smp = gw; smp < 1024; smp += F.G * NWAVES) { const unsigned h1 = hsh((unsigned)smp * 2u + 13u + 977u * (unsigned)stage); const int t = (int)(h1 % T), h = (int)((h1 >> 20) & 7), b = t >> 11, n = t & (SL - 1); const size_t kb = (size_t)b * SL;
        const float lgf = -__expf(A.ev_df[j * 8 + h]), lgb = -__expf(A.ev_db[j * 8 + h]);
        for (int kk = 0; kk < 32; ++kk) { const int m = F.lane + 64 * kk; float s = 0.f; for (int d = 0; d < 64; ++d) s += bf2f(PE[(size_t)t * PEW + 1536 + h * 64 + d]) * bf2f(PE[(kb + m) * PEW + 2048 + h * 64 + d]);
            s *= __expf(-lgf * (float)(n & 31)) * __expf(lgf * (float)(m & 63));
            sc[m] = s * ((m <= n) ? __expf(lgf * (float)(n - m)) : __expf(lgb * (float)(m - n))); }
        LDS_WAIT(); const int dv = F.lane; float o = 0.f; for (int m = 0; m < 2048; ++m) o += sc[m] * bf2f(VT[(size_t)(h * 64 + dv) * T + kb + m]);
        const float ss = wave_sum(o * o), rms = rsqrtf(ss * (1.f / 64.f) + EPS); const float g = bf2f(PE[(size_t)t * PEW + 2560 + h * 64 + dv]);
        ck_acc(c, bf2f(R[(size_t)t * D + 512 + h * 64 + dv]), o * rms * A.ev_gn[j * 512 + h * 64 + dv] * g / (1.f + __expf(-g)));
        LDS_WAIT(); }
    CK_LOOP(4096) { const unsigned h1 = hsh(s_ * 2u + 15u + 977u * (unsigned)stage), h2 = hsh(h1 + 5u); const int t = (int)(h1 % T), cc = (int)(h2 % 512), l = t & (SL - 1); const float* cw = A.ev_conv + (size_t)j * 1536;
        float acc = 0.f; for (int d = 0; d < 3; ++d) { const int tt = t + d - 1; const bool ok = (d == 0) ? (l > 0) : (d == 2) ? (l < SL - 1) : true;
            if (ok) acc += cw[d * 512 + cc] * bf2f(PE[(size_t)tt * PEW + 512 + cc]) * bf2f(PE[(size_t)tt * PEW + 1024 + cc]); }
        ck_acc(c2, bf2f(R[(size_t)t * D + cc]), acc * bf2f(PE[(size_t)t * PEW + cc])); }
    ck_flush(F, stage, c); ck_flush(F, stage + 1, c2);
}
__device__ __forceinline__ void ck_route(Frame& F, const Args& A, int stage, int i, int j) {
    Ck c = {0.f, 0.f}, c2 = {0.f, 0.f}; const bf16* X = (const bf16*)(F.ws + WS_XB); TileBase B; load_tilebase(F, j, B);
    const int* epos = (const int*)(F.ws + WS_MISC + MISC_EPOS); const float* gate = (const float*)(F.ws + WS_MISC + MISC_GATE); const int* yrow = (const int*)(F.ws + WS_MISC + MISC_YROW);
    CK_LOOP(2048) { const unsigned h1 = hsh(s_ * 2u + 17u + 977u * (unsigned)stage); const int t = (int)(h1 % T); const float rs = rs_naive(X, t);
        float lg[8];
#pragma unroll
        for (int e = 0; e < 8; ++e) lg[e] = rs * dotx(X, t, A.ffn_g + i * D, A.router + (size_t)j * D * NE, NE, e);
        int i1 = 0; float m1 = lg[0];
#pragma unroll
        for (int e = 1; e < 8; ++e) if (lg[e] > m1) { m1 = lg[e]; i1 = e; }
        int i2 = -1; float m2 = -3e38f;
#pragma unroll
        for (int e = 0; e < 8; ++e) if (e != i1 && lg[e] > m2) { m2 = lg[e]; i2 = e; }
        const float w1 = 1.f / (1.f + __expf(m2 - m1));
        const int e0 = epos[2 * t] >> 20, e1 = epos[2 * t + 1] >> 20;
        ck_acc(c, (e0 == i1 && e1 == i2) ? 1.f : 0.f, 1.f); ck_acc(c, gate[2 * t], w1); ck_acc(c, gate[2 * t + 1], 1.f - w1);
        const int r0 = yrow[2 * t]; int tbe = 0;
#pragma unroll
        for (int k = 0; k < 8; ++k) if (k == e0) tbe = B.tb[k];
        ck_acc(c2, (float)r0, (float)(tbe * 256 + (epos[2 * t] & 0xfffff)));
        const int cc = (int)(hsh(h1) % D); ck_acc(c2, f8tof((F.ws + WS_ACT + A_XS)[(size_t)r0 * D + cc]) + 8.f, bf2f(((const bf16*)(F.ws + WS_XB))[(size_t)t * D + cc]) * rs + 8.f); }
    ck_flush(F, stage, c); ck_flush(F, stage + 1, c2);
}
__device__ __forceinline__ void ck_moe(Frame& F, const Args& A, int stage, int which, int i, int j, int lo, int hi) {
    Ck c = {0.f, 0.f}; const bf16* X = (const bf16*)(F.ws + WS_XB); const int* epos = (const int*)(F.ws + WS_MISC + MISC_EPOS); const int* yrow = (const int*)(F.ws + WS_MISC + MISC_YROW);
    const unsigned char* HID = F.ws + WS_ACT + A_HID; const bf16* Y = (const bf16*)(F.ws + WS_ACT + A_Y);
    CK_LOOP(4096) { const unsigned h1 = hsh(s_ * 2u + 19u + 977u * (unsigned)stage), h2 = hsh(h1 + 3u); const int tk = (int)(h1 % (2 * T)), t = tk >> 1, e = epos[tk] >> 20, r = yrow[tk];
        if (r < lo * 256 || r >= hi * 256) continue;
        const size_t wo = ((size_t)j * NE + e) * (size_t)D * FE;
        if (which == 0) { const int cc = (int)(h2 % FE); const float rs = rs_naive(X, t); const float a = rs * dotx(X, t, A.ffn_g + i * D, A.moe_g + wo, FE, cc), b = rs * dotx(X, t, A.ffn_g + i * D, A.moe_u + wo, FE, cc);
            ck_acc(c, f8tof(HID[(size_t)(r - lo * 256) * FE + cc]) * (1.f / MOE_HSCALE), a / (1.f + __expf(-a)) * b); }
        else { const int cc = (int)(h2 % D); float s = 0.f; for (int k = 0; k < FE; ++k) s += f8tof(HID[(size_t)(r - lo * 256) * FE + k]) * (1.f / MOE_HSCALE) * A.moe_d[wo + (size_t)k * D + cc];
            ck_acc(c, bf2f(Y[(size_t)r * D + cc]), s); } }
    ck_flush(F, stage, c);
}
__device__ __forceinline__ void ck_comb(Frame& F, const Args& A, int stage, const bf16* xprev, bool last) {
    Ck c = {0.f, 0.f}; const bf16* Y = (const bf16*)(F.ws + WS_ACT + A_Y); const int* yrow = (const int*)(F.ws + WS_MISC + MISC_YROW); const float* gate = (const float*)(F.ws + WS_MISC + MISC_GATE);
    CK_LOOP(2048) { const unsigned h1 = hsh(s_ * 2u + 23u + 977u * (unsigned)stage), h2 = hsh(h1 + 1u); const int t = (int)(h1 % T), cc = (int)(h2 % D); const int r0 = yrow[2 * t], r1 = yrow[2 * t + 1]; const float g0 = gate[2 * t], g1 = gate[2 * t + 1];
        float ss = 0.f, vc = 0.f; for (int k = 0; k < D; ++k) { const float v = bf2f(xprev[(size_t)t * D + k]) + g0 * bf2f(Y[(size_t)r0 * D + k]) + g1 * bf2f(Y[(size_t)r1 * D + k]); ss += v * v; if (k == cc) vc = v; }
        const float ref = last ? vc * rsqrtf(ss * (1.f / D) + EPS) * A.fin_g[cc] : vc; ck_acc(c, last ? A.out[(size_t)t * D + cc] : bf2f(((const bf16*)(F.ws + WS_XB))[(size_t)t * D + cc]), ref); }
    ck_flush(F, stage, c);
}
__device__ __forceinline__ void copy_x(Frame& F, const Args& A, float* dst) {
    for (size_t it = (size_t)F.bid * NTHR + F.tid; it < (size_t)T * D / 4; it += (size_t)F.G * NTHR) ((f32x4*)dst)[it] = ((const f32x4*)A.out)[it];
}
#endif

enum { PH_PRO = 0, PH_MEMKV, PH_E1, PH_RETKV, PH_RETSCAN, PH_RETOUT, PH_D1, PH_DATTN, PH_OUTRES, PH_X1, PH_XATTN, PH_X3, PH_F1, PH_F2, PH_ROUTER, PH_GATHER, PH_M1, PH_M2, PH_COMB, PH_COUNT };
#define XB ((bf16*)(F.ws + WS_XB))
#define SSQ ((float*)(F.ws + WS_SSQ))
#define ACT (F.ws + WS_ACT)
__device__ __forceinline__ float lambda_init_of(int i) { return 0.8f - 0.6f * __expf(-0.3f * (float)i); }
template <int PH> __device__ __forceinline__ void run_phase(Frame& F, const Args& A, int i, int half, int vcu) {
    const int j = i >> 1; PG8_LAS unsigned char* const ring = (PG8_LAS unsigned char*)F.lds;
    if constexpr (PH == PH_PRO) { prologue_phase(F, A); moe_convert(F, A, 0); moe_convert(F, A, 1); }
    if constexpr (PH == PH_MEMKV) {
        { pg8::Gemm g{(const bf16*)(F.ws + WS_MEMN), (const bf16*)(F.ws + WS_WK), MT, 4096, D}; pg8::StaticOrder S; S.init(MT, 4096, F.G, F.bid);
          pg8::EpiRow<0> E{(bf16*)(F.ws + WS_KX), 4096, nullptr, nullptr, 1.f}; pg8::gemm_phase<pg8::EpiRow<0>, pg8::StaticOrder, true, true>(ring, g, S, E, F.tid); }
        { pg8::Gemm g{(const bf16*)(F.ws + WS_WV), (const bf16*)(F.ws + WS_MEMN), 4096, MT, D}; pg8::StaticOrder S; S.init(4096, MT, F.G, F.bid);
          pg8::EpiRow<0> E{(bf16*)(F.ws + WS_VTX), 4096, nullptr, nullptr, 1.f}; pg8::gemm_phase<pg8::EpiRow<0>, pg8::StaticOrder, true, true>(ring, g, S, E, F.tid); }
    }
    if constexpr (PH == PH_E1) { unsigned char* eb = F.ws + WS_EV + j * EV_STRIDE;
        { pg8::Gemm g{XB, (const bf16*)(eb + EV_INN), T, 3072, D}; pg8::StaticOrder S; S.init(T, 3072, F.G, F.bid);
          pg8::EpiRow<1> E{(bf16*)(ACT + A_PE), PEW, SSQ, A.pos, 1.f, A.ev_df + j * 8, A.ev_db + j * 8}; pg8::gemm_phase<pg8::EpiRow<1>, pg8::StaticOrder, true, true>(ring, g, S, E, F.tid); }
        { pg8::Gemm g{(const bf16*)(eb + EV_INS), XB, 512, T, D}; pg8::StaticOrder S; S.init(512, T, F.G, F.bid);
          pg8::EpiCol<0> E{(bf16*)(ACT + A_VTE), nullptr, nullptr, (size_t)T, SSQ, nullptr, nullptr, nullptr};
          pg8::gemm_phase<pg8::EpiCol<0>, pg8::StaticOrder, true, true>(ring, g, S, E, F.tid); }
    }
    if constexpr (PH == PH_RETKV) { Frame P = F; P.bid = vcu; fret_phase(P, A, j); }
    if constexpr (PH == PH_D1) { unsigned char* ob = F.ws + WS_OD + j * OD_STRIDE;
        { pg8::Gemm g{XB, (const bf16*)(ob + OD_INN), T, 2048, D}; pg8::StaticOrder S; S.init(T, 2048, F.G, F.bid);
          pg8::EpiRow<2> E{(bf16*)(ACT + A_QK), QKP, SSQ, A.pos, 1.f}; pg8::gemm_phase<pg8::EpiRow<2>, pg8::StaticOrder, true, true>(ring, g, S, E, F.tid); }
        { pg8::Gemm g{(const bf16*)(ob + OD_INS), XB, 1024, T, D}; pg8::StaticOrder S; S.init(1024, T, F.G, F.bid);
          pg8::EpiCol<0> E{(bf16*)(ACT + A_VTD), nullptr, nullptr, (size_t)VTP, SSQ, nullptr, nullptr, nullptr};
          pg8::gemm_phase<pg8::EpiCol<0>, pg8::StaticOrder, true, true>(ring, g, S, E, F.tid); }
    }
    if constexpr (PH == PH_DATTN) { Frame P = F; P.bid = vcu; dattn_phase(P, A, j, lambda_init_of(i)); }
    if constexpr (PH == PH_OUTRES) {
        const bf16* mixA = (i & 1) ? (const bf16*)(ACT + A_AO) : (const bf16*)(ACT + A_R);
        const bf16* mixB = (i & 1) ? (const bf16*)(F.ws + WS_OD + j * OD_STRIDE + OD_OUT) : (const bf16*)(F.ws + WS_EV + j * EV_STRIDE + EV_OUT);
        pg8::Gemm g{mixA, mixB, T, D, D}; pg8::StaticOrder S; S.init(T, D, F.G, F.bid);
        if (half) { pg8::EpiRes E{(bf16*)(ACT + 256 * MiB), (float*)(ACT + 320 * MiB), 1.f}; pg8::gemm_phase<pg8::EpiRes, pg8::StaticOrder, true, true>(ring, g, S, E, F.tid); }
        else { typedef pg8::EpiResT<(long long)(WS_ACT + A_XB8) - (long long)WS_XB> EpiRes8; EpiRes8 E{XB, SSQ, 1.f}; pg8::gemm_phase<EpiRes8, pg8::StaticOrder, true, true>(ring, g, S, E, F.tid); }
    }
    if constexpr (PH == PH_X1) { pg8::Gemm g{(const bf16*)(ACT + A_XB8), (const bf16*)(F.ws + WS_WQ + (size_t)i * D * D), T, D, D / 2}; pg8::StaticOrder S; S.init(T, D, F.G, F.bid);
        pg8::EpiRow<0> E{(bf16*)(ACT + A_QX), 1024, SSQ, nullptr, LOG2E / 16.f / MOE_WSCALE}; pg8::gemm_phase<pg8::EpiRow<0>, pg8::StaticOrder, true, true, true>(ring, g, S, E, F.tid); }
    if constexpr (PH == PH_XATTN) { Frame P = F; P.bid = vcu; xattn_phase(P, i); }
    if constexpr (PH == PH_X3) { pg8::Gemm g{(const bf16*)(ACT + A_OX), (const bf16*)(F.ws + WS_WO + (size_t)i * D * D), T, D, D / 2};
        pg8::StaticOrder S; S.init(T, D, F.G, F.bid); if (half) { pg8::EpiRes E{(bf16*)(ACT + 256 * MiB), (float*)(ACT + 320 * MiB), 1.f / (MOE_WSCALE * 4.f)}; pg8::gemm_phase<pg8::EpiRes, pg8::StaticOrder, true, true, true>(ring, g, S, E, F.tid); }
        else if (i & 1) { pg8::EpiRes E{XB, SSQ, 1.f / (MOE_WSCALE * 4.f)}; pg8::gemm_phase<pg8::EpiRes, pg8::StaticOrder, true, true, true>(ring, g, S, E, F.tid); }
        else { typedef pg8::EpiResT<(long long)(WS_ACT + A_XB8) - (long long)WS_XB> EpiRes8; EpiRes8 E{XB, SSQ, 1.f / (MOE_WSCALE * 4.f)}; pg8::gemm_phase<EpiRes8, pg8::StaticOrder, true, true, true>(ring, g, S, E, F.tid); } }
    if constexpr (PH == PH_F1) { pg8::Gemm g{(const bf16*)(ACT + A_XB8), (const bf16*)(F.ws + WS_EV + j * EV_STRIDE + EV_GU), T, 2 * FF, D / 2}; pg8::StaticOrder S; S.init(T, 2 * FF, F.G, F.bid);
        pg8::EpiSwiT<true> E{(void*)(ACT + A_H), FF, SSQ, 22, 1.f / MOE_WSCALE, MOE_HSCALE}; pg8::gemm_phase<pg8::EpiSwiT<true>, pg8::StaticOrder, true, true, true>(ring, g, S, E, F.tid); }
    if constexpr (PH == PH_F2) { pg8::Gemm g{(const bf16*)(ACT + A_H), (const bf16*)(F.ws + WS_EV + j * EV_STRIDE + EV_DN), T, D, FF / 2}; pg8::StaticOrder S; S.init(T, D, F.G, F.bid);
        pg8::EpiRes E{half ? (bf16*)(ACT + 304 * MiB) : XB, half ? (float*)(ACT + 368 * MiB) : SSQ, 1.f / (MOE_WSCALE * MOE_HSCALE)}; pg8::gemm_phase<pg8::EpiRes, pg8::StaticOrder, true, true, true>(ring, g, S, E, F.tid); }
    if constexpr (PH == PH_ROUTER) router_phase(F, A, i, j, j + 2 * half);
    if constexpr (PH == PH_GATHER) gather_phase(F, j);
    if constexpr (PH == PH_M1 || PH == PH_M2) {
        pg8::MoeOrder S; TileBase B; load_tilebase(F, j, B);
#pragma unroll
        for (int k = 0; k < 9; ++k) S.tb[k] = B.tb[k];
        S.nM = B.tb[8]; S.G = F.G; S.c = F.bid; S.lo = 0;
        if constexpr (PH == PH_M1) { S.nN = 28; S.nwg = S.nM * 28;
            pg8::Gemm g{(const bf16*)(ACT + A_XS), (const bf16*)(F.ws + WS_MOE + (size_t)j * MOE_STRIDE), 0, 0, D / 2};
            pg8::EpiSwiT<true> E{(void*)(ACT + A_HID), FE, nullptr, 28, 1.f / MOE_WSCALE, MOE_HSCALE};
            pg8::gemm_phase<pg8::EpiSwiT<true>, pg8::MoeOrder, true, true, true>(ring, g, S, E, F.tid); }
        else { S.nN = 4; S.nwg = S.nM * 4;
            pg8::Gemm g{(const bf16*)(ACT + A_HID), (const bf16*)(F.ws + WS_MOE + (size_t)j * MOE_STRIDE + MOE_DN), 0, 0, FE / 2};
            pg8::EpiY E{(bf16*)(ACT + A_Y), 1024, 4, 1.f / (MOE_WSCALE * MOE_HSCALE)};
            pg8::gemm_phase<pg8::EpiY, pg8::MoeOrder, true, true, true>(ring, g, S, E, F.tid); }
    }
    if constexpr (PH == PH_COMB) combine_phase(F, A, i == 3, half);
}
__device__ __forceinline__ void make_frame(Frame& F, const Args& A, unsigned char* lds_raw, int& vcu) {
    F.lds = (LAS unsigned char*)lds_raw; F.tid = threadIdx.x; F.lane = F.tid & 63; F.wave = __builtin_amdgcn_readfirstlane(F.tid >> 6);
    F.G = gridDim.x; F.bid = blockIdx.x; F.ws = A.ws; F.ctl = (gu32*)(A.ws + WS_CTL);
    vcu = (F.G % 8 == 0) ? (F.bid % 8) * (F.G / 8) + F.bid / 8 : F.bid;
}


constexpr int NPHASES = 48;
__global__ void __launch_bounds__(NTHR, 2) fwd(Args A_) {
#if defined(__HIP_DEVICE_COMPILE__)
    extern __shared__ __attribute__((aligned(16))) unsigned char lds_raw[];
    typedef const Args __attribute__((address_space(4))) * KArgsP;
    KArgsP ap = (KArgsP)__builtin_amdgcn_kernarg_segment_ptr();
    { LAS unsigned char* lds = (LAS unsigned char*)lds_raw;
      for (int u = threadIdx.x; u < (LDS_BYTES - LDSCTL_OFF) / 4; u += NTHR) ((LAS unsigned*)(lds + LDSCTL_OFF))[u] = 0u; }
    int wave_s = __builtin_amdgcn_readfirstlane((int)threadIdx.x >> 6); asm volatile("" : "+s"(wave_s));
    __syncthreads();
    (void)xcd_barrier_post((unsigned*)(A_.ws + WS_CTL) + CW_BAR, (volatile LAS unsigned*)((LAS unsigned char*)lds_raw + LDSCTL_OFF));
#define RUN(PH, i, half) do { { unsigned lo_ = (unsigned)(unsigned long long)ap, hi_ = (unsigned)((unsigned long long)ap >> 32); asm volatile("" : "+v"(lo_), "+v"(hi_)); \
          ap = (KArgsP)(((unsigned long long)(unsigned)__builtin_amdgcn_readfirstlane((int)hi_) << 32) | (unsigned long long)(unsigned)__builtin_amdgcn_readfirstlane((int)lo_)); } Frame P; int vcu_; const Args AL = *ap; \
        { P.lds = (LAS unsigned char*)lds_raw; unsigned z_ = 0u; asm volatile("" : "+v"(z_)); int t_ = wave_s * 64 + (int)__builtin_amdgcn_mbcnt_hi(~0u, __builtin_amdgcn_mbcnt_lo(~0u, z_)); P.tid = t_; P.lane = t_ & 63; P.wave = __builtin_amdgcn_readfirstlane(t_ >> 6); \
          P.G = gridDim.x; P.bid = blockIdx.x; P.ws = AL.ws; P.ctl = (gu32*)(P.ws + WS_CTL); vcu_ = (P.G % 8 == 0) ? (P.bid % 8) * (P.G / 8) + P.bid / 8 : P.bid; } \
        run_phase<PH>(P, AL, (i), (half), vcu_); } while (0)
#define SEAM() do { XcdBarrier b_; b_.bar = (unsigned*)(ap->ws + WS_CTL) + CW_BAR; b_.x = xb_xcc_id(); b_.st = (volatile LAS unsigned*)((LAS unsigned char*)lds_raw + LDSCTL_OFF); { unsigned zb_ = 0u; asm volatile("" : "+v"(zb_)); b_.t0 = (wave_s == 0) && (__builtin_amdgcn_mbcnt_hi(~0u, __builtin_amdgcn_mbcnt_lo(~0u, zb_)) == 0u); } xcd_barrier(b_); } while (0)
#ifndef DUPMASK
#define DUPMASK 0u
#endif
#define RUNS(PH, i, half) do { if ((DUPMASK >> PH) & 1u) { RUN(PH, i, 1); SEAM(); } RUN(PH, i, 0); SEAM(); } while (0)
    RUNS(PH_PRO, 0, 0); RUN(PH_MEMKV, 0, 0);
    for (int i = 0; i < 4; ++i) {
        if ((i & 1) == 0) { RUNS(PH_E1, i, 0); RUNS(PH_RETKV, i, 0); }
        else { RUNS(PH_D1, i, 0); RUNS(PH_DATTN, i, 0); }
        RUNS(PH_OUTRES, i, 0); RUNS(PH_X1, i, 0); RUNS(PH_XATTN, i, 0); RUNS(PH_X3, i, 0);
        if ((i & 1) == 0) { RUNS(PH_F1, i, 0); RUNS(PH_F2, i, 0); }
        else { RUNS(PH_ROUTER, i, 0); RUNS(PH_GATHER, i, 0);
            RUNS(PH_M1, i, 0); RUNS(PH_M2, i, 0);
            if ((DUPMASK >> PH_COMB) & 1u) { RUN(PH_COMB, i, 1); SEAM(); } RUN(PH_COMB, i, 0); if (i != 3) SEAM(); }
    }
#undef RUN
#undef SEAM
#endif
}
#undef XB
#undef SSQ
#undef ACT
extern "C" void kernel_launch(void* const* d_in, const int* in_sizes, int n_in, void* d_out, int out_size, void* d_ws, size_t ws_size, hipStream_t stream) {
    static int grid = 0;
    if (grid == 0) {
        if (n_in != 31 || out_size != T * D || ws_size < WS_END) { fprintf(stderr, "kernel_launch: unexpected shapes (n_in %d, out %d, ws %zu < %zu)\n", n_in, out_size, ws_size, (size_t)WS_END); grid = -1; return; }
        int dev = 0, cus = 0, per_cu = 0;
        if (hipGetDevice(&dev) != hipSuccess || hipDeviceGetAttribute(&cus, hipDeviceAttributeMultiprocessorCount, dev) != hipSuccess) { grid = -1; return; }
        if (hipFuncSetAttribute((const void*)fwd, hipFuncAttributeMaxDynamicSharedMemorySize, LDS_BYTES) != hipSuccess) { fprintf(stderr, "kernel_launch: hipFuncSetAttribute failed\n"); grid = -1; return; }
        if (hipOccupancyMaxActiveBlocksPerMultiprocessor(&per_cu, (const void*)fwd, NTHR, LDS_BYTES) != hipSuccess || per_cu < 1) fprintf(stderr, "kernel_launch: occupancy query reports %d\n", per_cu);
        (void)hipGetLastError();
        grid = cus;
    }
    if (grid < 0) return;
    if (hipMemsetAsync((char*)d_ws + WS_CTL, 0, CTL_BYTES, stream) != hipSuccess) return;
    Args a{};
    const float** fp = (const float**)&a;
    for (int k = 0; k < 31; ++k) fp[k] = (const float*)d_in[k];
    a.out = (float*)d_out; a.ws = (unsigned char*)d_ws; a.ph_lo = 0; a.ph_hi = NPHASES;
    hipLaunchKernelGGL(fwd, dim3(grid), dim3(NTHR), LDS_BYTES, stream, a);
}
```
